# Optimizing an MI355X kernel written in HIP

```python
import jax, jax.numpy as jnp
from jax import lax
import numpy as np

D_MODEL = 2048
BATCH = 4
SEQ = 2048
DEPTH = 1
DEC_BATCH = 128
DEC_SEQ = 8
PAST_LEN = 16384
PAGE_SIZE = 128

GLA_HEADS = 4
GLA_DK = D_MODEL // 2 // GLA_HEADS
GLA_DV = D_MODEL // GLA_HEADS
GATE_RANK = 16
GATE_TAU = 16.0
GLA_CHUNK = 64
POOL_WIDTH = D_MODEL // 2
POOL_GROUPS = 4
POOL_GROUP_W = POOL_WIDTH // POOL_GROUPS
POOL_OUT_GROUP_W = D_MODEL // POOL_GROUPS
POOL_WINDOWS = (2, 4, 8, 16)
POOL_BUF = max(POOL_WINDOWS) - 1
D_FF = 4 * D_MODEL
EPS = 1e-6

Q_W = GLA_HEADS * GLA_DK
K_W = GLA_HEADS * GLA_DK
V_W = GLA_HEADS * GLA_DV
R_W = GLA_HEADS * GLA_DV
A_W = GATE_RANK
U_W = POOL_WIDTH
GA_W = D_MODEL
GB_W = D_MODEL
IN_W = Q_W + K_W + V_W + R_W + A_W + U_W + GA_W + GB_W
IN_SPLITS = tuple(int(s) for s in np.cumsum([Q_W, K_W, V_W, R_W, A_W, U_W, GA_W]))

kernel_name = "gla_pool_gated_hybrid_step"


def rmsnorm(x, g):
    xf = x.astype(jnp.float32)
    y = xf * lax.rsqrt(jnp.mean(xf * xf, axis=-1, keepdims=True) + EPS)
    return (y * g.astype(jnp.float32)).astype(x.dtype)


def gla_scan(q, k, v, log_a, s0):
    B, T = q.shape[0], q.shape[1]
    c = min(GLA_CHUNK, T)
    n = -(-T // c)
    pad = n * c - T

    def blocks(t):
        t = jnp.pad(t.astype(jnp.float32), ((0, 0), (0, pad), (0, 0), (0, 0)))
        return t.reshape(B, n, c, GLA_HEADS, t.shape[-1]).transpose(1, 0, 3, 2, 4)

    mask = jnp.tril(jnp.ones((c, c), dtype=bool))

    def step(S, inp):
        qc, kc, vc, ac = inp
        b = jnp.cumsum(ac, axis=2)
        diff = b[:, :, :, None, :] - b[:, :, None, :, :]
        decay = jnp.exp(jnp.where(mask[:, :, None], diff, -jnp.inf))
        scores = jnp.einsum('bhtd,bhsd,bhtsd->bhts', qc, kc, decay)
        o = (jnp.einsum('bhts,bhsv->bhtv', scores, vc)
             + jnp.einsum('bhtd,bhdv->bhtv', qc * jnp.exp(b), S))
        b_last = b[:, :, -1:, :]
        S_new = (jnp.exp(b_last[:, :, 0, :])[..., None] * S
                 + jnp.einsum('bhsd,bhsv->bhdv', kc * jnp.exp(b_last - b), vc))
        return S_new, o

    S, o = lax.scan(step, s0.astype(jnp.float32),
                    (blocks(q), blocks(k), blocks(v), blocks(log_a)))
    o = o.transpose(1, 0, 3, 2, 4).reshape(B, n * c, GLA_HEADS, GLA_DV)[:, :T]
    return o, S


def multiscale_pool(u, buf, start_pos):
    T = u.shape[1]
    ext = jnp.concatenate([buf.astype(jnp.float32), u.astype(jnp.float32)], axis=1)
    csum = jnp.pad(jnp.cumsum(ext, axis=1), ((0, 0), (1, 0), (0, 0)))
    pos = start_pos + jnp.arange(T) + 1
    outs = []
    for g, w in enumerate(POOL_WINDOWS):
        lo, hi = g * POOL_GROUP_W, (g + 1) * POOL_GROUP_W
        s = (csum[:, POOL_BUF + 1:POOL_BUF + 1 + T, lo:hi]
             - csum[:, POOL_BUF + 1 - w:POOL_BUF + 1 - w + T, lo:hi])
        cnt = jnp.minimum(pos, w).astype(jnp.float32)[None, :, None]
        outs.append(s / cnt)
    pooled = jnp.concatenate(outs, axis=-1)
    return (pooled - u.astype(jnp.float32)).astype(u.dtype)


def layer(x, s_gla0, pool_buf, start_pos, norm_mix_g, w_in, w_alpha_up, b_alpha,
          gla_norm_g, pool_w, pool_scale, w_out, norm_mlp_g, w_up, w_down, norm_final_g):
    B, T, _ = x.shape
    h = rmsnorm(x, norm_mix_g)
    z = h @ w_in
    q, k, v, r, a_lr, u, ga, gb = jnp.split(z, IN_SPLITS, axis=-1)
    q = q.reshape(B, T, GLA_HEADS, GLA_DK) * (GLA_DK ** -0.5)
    k = k.reshape(B, T, GLA_HEADS, GLA_DK)
    v = v.reshape(B, T, GLA_HEADS, GLA_DV)
    a_logit = (a_lr @ w_alpha_up + b_alpha).astype(jnp.float32)
    log_a = (jax.nn.log_sigmoid(a_logit) / GATE_TAU).reshape(B, T, GLA_HEADS, GLA_DK)
    o, s_gla = gla_scan(q, k, v, log_a, s0=s_gla0)
    o = rmsnorm(o, gla_norm_g).reshape(B, T, V_W).astype(x.dtype)
    o_a = o * jax.nn.silu(r)
    p = multiscale_pool(u, pool_buf, start_pos)
    o_b = jnp.einsum('btgc,gcd->btgd', p.reshape(B, T, POOL_GROUPS, POOL_GROUP_W),
                     pool_w).reshape(B, T, D_MODEL) * pool_scale
    m = jax.nn.sigmoid(ga) * o_a + jax.nn.sigmoid(gb) * o_b
    x = x + m @ w_out
    h2 = rmsnorm(x, norm_mlp_g)
    x = x + jnp.square(jax.nn.relu(h2 @ w_up)) @ w_down
    y = rmsnorm(x, norm_final_g)
    new_buf = jnp.concatenate([pool_buf.astype(u.dtype), u], axis=1)[:, -POOL_BUF:]
    return y, s_gla, new_buf


def setup_inputs(seed: int = 0) -> dict:
    key = jax.random.key(seed)
    ks = jax.random.split(key, 16)
    f32 = jnp.float32
    nrm = lambda k, shape, scale: jax.random.normal(k, shape, f32) * scale
    return {
        "x_prompt": nrm(ks[0], (BATCH, SEQ, D_MODEL), 1.0),
        "x_sample": nrm(ks[1], (DEC_BATCH, DEC_SEQ, D_MODEL), 1.0),
        "state_gla": nrm(ks[2], (DEC_BATCH, GLA_HEADS, GLA_DK, GLA_DV), 1.0),
        "state_pool": nrm(ks[3], (DEC_BATCH, POOL_BUF, POOL_WIDTH), 1.0),
        "norm_mix_g": 1.0 + nrm(ks[4], (D_MODEL,), 0.02),
        "w_in": nrm(ks[5], (D_MODEL, IN_W), D_MODEL ** -0.5),
        "w_alpha_up": nrm(ks[6], (GATE_RANK, Q_W), GATE_RANK ** -0.5),
        "b_alpha": nrm(ks[7], (Q_W,), 0.1),
        "gla_norm_g": 1.0 + nrm(ks[8], (GLA_DV,), 0.02),
        "pool_w": nrm(ks[9], (POOL_GROUPS, POOL_GROUP_W, POOL_OUT_GROUP_W), POOL_GROUP_W ** -0.5),
        "pool_scale": 1.0 + nrm(ks[10], (D_MODEL,), 0.1),
        "w_out": nrm(ks[11], (D_MODEL, D_MODEL), D_MODEL ** -0.5),
        "norm_mlp_g": 1.0 + nrm(ks[12], (D_MODEL,), 0.02),
        "w_up": nrm(ks[13], (D_MODEL, D_FF), D_MODEL ** -0.5),
        "w_down": nrm(ks[14], (D_FF, D_MODEL), D_FF ** -0.5),
        "norm_final_g": 1.0 + nrm(ks[15], (D_MODEL,), 0.02),
    }


def reference(x_prompt, x_sample, state_gla, state_pool, norm_mix_g, w_in, w_alpha_up,
              b_alpha, gla_norm_g, pool_w, pool_scale, w_out, norm_mlp_g, w_up, w_down,
              norm_final_g):
    params = (norm_mix_g, w_in, w_alpha_up, b_alpha, gla_norm_g, pool_w, pool_scale,
              w_out, norm_mlp_g, w_up, w_down, norm_final_g)
    y_p, y_s = x_prompt, x_sample
    s_gla_p = jnp.zeros((BATCH, GLA_HEADS, GLA_DK, GLA_DV), jnp.float32)
    buf_p = jnp.zeros((BATCH, POOL_BUF, POOL_WIDTH), x_prompt.dtype)
    s_gla_s, buf_s = state_gla, state_pool
    for _ in range(DEPTH):
        y_p, s_gla_p, buf_p = layer(y_p, s_gla_p, buf_p, 0, *params)
        y_s, s_gla_s, buf_s = layer(y_s, s_gla_s, buf_s, PAST_LEN, *params)
    return (y_p, y_s, s_gla_p, buf_p, s_gla_s, buf_s)
```

```cpp
#include <hip/hip_runtime.h>
#include <cstdio>
#include <cstdint>

#ifndef PHMASK
#define PHMASK 0x1ff
#endif
#ifndef PROBE_MASK
#define PROBE_MASK 0
#endif
#ifndef PROBE_VAR
#define PROBE_VAR 0
#endif
#ifndef MK_N_LAUNCHES
#define MK_N_LAUNCHES 1
#endif

#define GAS __attribute__((address_space(1)))
#define LAS __attribute__((address_space(3)))
typedef unsigned short bf16;
typedef unsigned v4u __attribute__((ext_vector_type(4)));
typedef unsigned v2u __attribute__((ext_vector_type(2)));
typedef float f32x4 __attribute__((ext_vector_type(4)));
typedef float f32x2 __attribute__((ext_vector_type(2)));
typedef short bf16x8 __attribute__((ext_vector_type(8)));
typedef GAS unsigned gu32;
#define RLX_AGENT __ATOMIC_RELAXED, __HIP_MEMORY_SCOPE_AGENT
#define LDS_WAIT() asm volatile("s_waitcnt lgkmcnt(0)" ::: "memory")
#define VM_WAIT() asm volatile("s_waitcnt vmcnt(0)" ::: "memory")

constexpr int DM = 2048, NP = 8192, NS = 1024, M = NP + NS;
constexpr int SEQ = 2048, NBS = 128, TS = 8;
constexpr int NH = 4, DK = 256, DV = 512, QW = 1024, VW = 2048, UW = 1024;
constexpr int INW = 11280, NIN = 11520, FF = 8192;
constexpr int NCH_P = 128, NCH = 144;
constexpr float EPS = 1e-6f;
constexpr size_t OUT_Y = 0, OUT_SGP = (size_t)M * DM, OUT_BUFP = OUT_SGP + 4 * 4 * 256 * 512, OUT_SGS = OUT_BUFP + 4 * 15 * 1024, OUT_BUFS = OUT_SGS + (size_t)128 * 4 * 256 * 512, OUT_END = OUT_BUFS + 128 * 15 * 1024;
constexpr size_t MiB = 1u << 20;
constexpr size_t WS_CTL = 0, CTL_ZERO_BYTES = 1 * MiB;
constexpr size_t WS_WPOOL = 1 * MiB, WS_WOUT = 2 * MiB, WS_WUP = 10 * MiB, WS_WDN = 42 * MiB, WS_WIN = 74 * MiB, WS_H = 119 * MiB;
constexpr size_t WS_Q = 155 * MiB, WS_K = 173 * MiB, WS_U = 191 * MiB, WS_V = 209 * MiB, WS_R = 245 * MiB, WS_GA = 281 * MiB, WS_GB = 317 * MiB, WS_ALR = 353 * MiB;
constexpr size_t WS_QT = 354 * MiB, WS_KTT = 372 * MiB, WS_VT = 390 * MiB, WS_PS = 422 * MiB, WS_EBP = 427 * MiB, WS_EBS = 427 * MiB + 512 * 1024;
constexpr size_t WS_PB = 428 * MiB, WS_OB = 446 * MiB, WS_OG = 482 * MiB, WS_MB = 518 * MiB, WS_X1 = 554 * MiB, WS_X1B = 626 * MiB, WS_HID = 662 * MiB, WS_DUMMY = 806 * MiB, WS_XS = 806 * MiB + 512 * 1024, WS_XS4 = 807 * MiB, WS_SLAB = 808 * MiB, WS_END = 872 * MiB;
static_assert(WS_WIN + (size_t)NIN * DM * 2 <= WS_H && WS_H + (size_t)M * DM * 2 <= WS_Q && WS_HID + (size_t)M * FF * 2 <= WS_DUMMY && WS_X1 + (size_t)M * DM * 4 <= WS_X1B, "ws map");
constexpr int CW_TMO = 0, CW_BAR = 4096, CW_WORK = 8192, CW_SSQ = 16384, CW_SSQ1 = 65536, CW_SSQ2 = 81920, CW_CNT5 = 98304, CW_CNT6 = 102400, CW_CNTS = 106496, CW_CNTP = 110592, CW_CNT7 = 114688, CW_CNT8 = 118784;
static_assert(CW_SSQ + M * 4 <= CW_SSQ1 && CW_SSQ1 + M <= CW_SSQ2 && (CW_SSQ2 + M) * 4 <= (int)CTL_ZERO_BYTES, "ctl map");
constexpr int RING_BYTES = 131072, LDSCTL_OFF = 140 * 1024, MISC_OFF = LDSCTL_OFF + 320, PTAB_OFF = LDSCTL_OFF + 1024, LDS_BYTES = 147456;
constexpr int NWAVES = 8;
constexpr int NPHASES = 9;

__device__ __forceinline__ float bf2f(unsigned b) { return __builtin_bit_cast(float, b << 16); }
__device__ __forceinline__ unsigned cvt_pk_bf16(float lo, float hi) { unsigned r; asm volatile("v_cvt_pk_bf16_f32 %0, %1, %2" : "=v"(r) : "v"(lo), "v"(hi)); return r; }
__device__ __forceinline__ unsigned f2bf(float f) { return cvt_pk_bf16(f, 0.f) & 0xffffu; }
__device__ __forceinline__ float wave_sum(float v) {
#pragma unroll
    for (int o = 1; o < 64; o <<= 1) v += __shfl_xor(v, o);
    return v;
}
__device__ __forceinline__ float sigmoidf_(float x) { return __builtin_amdgcn_rcpf(1.f + __expf(-x)); }

namespace pg8 {
constexpr int BM = 256, BK = 64, HALF = 128, HTB = HALF * BK * 2, STAGE_BYTES = 8 * HTB, NXCD = 8, WGM = 8;
__host__ __device__ __forceinline__ int lds_byte(int r, int c) { const int st = (r >> 4) * 2 + (c >> 5), rr = r & 15, cc = c & 31, ob = rr * 64 + cc * 2; return st * 1024 + (ob ^ (((ob >> 9) & 1) << 5)); }
__host__ __device__ __forceinline__ void stage_rc(int b, int& R, int& C) { const int st = b / 1024, sb = b % 1024, swz = sb ^ (((sb >> 9) & 1) << 5); R = (st >> 1) * 16 + swz / 64; C = (st & 1) * 32 + (swz % 64) / 2; }
__host__ __device__ __forceinline__ int perm32(int rho) { const int n = rho >> 4, i = rho & 15; return 8 * (i >> 2) + 4 * n + (i & 3); }

struct Unit { int pm, pn; };
struct Gemm { const bf16* A; const bf16* Bt; int lda, ldb, K, a_div; };

struct StaticOrder {
    int nM, nN, nwg, G, c;
    __device__ void init(int M_, int N_, int G_, int c_) { nM = M_ / BM; nN = N_ / BM; nwg = nM * nN; G = G_; c = c_; }
    __device__ bool next(int i, Unit& u) const {
        const long L = (long)i * G + c; if (c < 0 || L >= nwg) return false;
        int wgid = (int)L; { const int q = nwg / NXCD, r = nwg % NXCD, xcd = wgid % NXCD, off = wgid / NXCD; wgid = (xcd < r ? xcd * (q + 1) : r * (q + 1) + (xcd - r) * q) + off; }
        const int nig = WGM * nN, gid = wgid / nig, fm = gid * WGM, gsz = (nM - fm) < WGM ? (nM - fm) : WGM;
        u.pm = fm + ((wgid % nig) % gsz); u.pn = (wgid % nig) / gsz; return true;
    }
};

template <class Epi, class Sched>
__device__ __forceinline__ void gemm_phase(LAS unsigned char* lds, const Gemm g, const Sched& S, const Epi& E) {
    const int tid = threadIdx.x, wid = __builtin_amdgcn_readfirstlane(tid >> 6), lane = tid & 63, wr = wid >> 2, wc = wid & 3, fr = lane & 15, fq = lane >> 4;
    const int K = g.K, nt = K / BK;
    unsigned voffA[2], voffB[2];
#pragma unroll
    for (int i = 0; i < 2; ++i) { int R, C; stage_rc(tid * 16 + i * 8192, R, C); const int Rb = (R & ~31) + perm32(R & 31);
        voffA[i] = (unsigned)(R * g.lda + C) * 2u; voffB[i] = (unsigned)(Rb * g.ldb + C) * 2u; }
    const size_t kstep = (size_t)(BK * 2);
    const size_t hA = (size_t)HALF * g.lda * 2, hB = (size_t)HALF * g.ldb * 2;
    const unsigned ldsw = (unsigned)wid * 1024u;
    const int aoff = lds_byte(wr * 64 + fr, fq * 8), boff = lds_byte(wc * 32 + fr, fq * 8);
#define PG8_SA(b, h) (((b) * 2 + (h)) * HTB)
#define PG8_SB(b, h) ((4 + (b) * 2 + (h)) * HTB)
#define PG8_STAGE(bufoff, gbase, voff) do { _Pragma("unroll") for (int _i = 0; _i < 2; ++_i) \
        __builtin_amdgcn_global_load_lds((const unsigned*)((const char*)(gbase) + (voff)[_i]), (LAS unsigned*)(lds + (bufoff) + ldsw + _i * 8192), 16, 0, 0); } while (0)
#define PG8_LDA(dst, b, h) do { _Pragma("unroll") for (int m = 0; m < 4; ++m) _Pragma("unroll") for (int k = 0; k < 2; ++k) dst[m][k] = *(const LAS bf16x8*)(lds + PG8_SA(b, h) + aoff + m * 2048 + k * 1024); } while (0)
#define PG8_LDB(dst, b, h) do { _Pragma("unroll") for (int n = 0; n < 2; ++n) _Pragma("unroll") for (int k = 0; k < 2; ++k) dst[n][k] = *(const LAS bf16x8*)(lds + PG8_SB(b, h) + boff + n * 2048 + k * 1024); } while (0)
#define PG8_MMA(ai, bj, At, Bt) do { __builtin_amdgcn_s_setprio(1); _Pragma("unroll") for (int m = 0; m < 4; ++m) _Pragma("unroll") for (int n = 0; n < 2; ++n) _Pragma("unroll") for (int k = 0; k < 2; ++k) \
        acc[ai][bj][m][n] = __builtin_amdgcn_mfma_f32_16x16x32_bf16(Bt[n][k], At[m][k], acc[ai][bj][m][n], 0, 0, 0); __builtin_amdgcn_s_setprio(0); } while (0)
#define PG8_WAIT_V(n) asm volatile("s_waitcnt vmcnt(" #n ")" ::: "memory")
#define PG8_WAIT_L(n) asm volatile("s_waitcnt lgkmcnt(" #n ")" ::: "memory")
#define PG8_BAR __builtin_amdgcn_s_barrier()
#define PG8_SCHED __builtin_amdgcn_sched_barrier(0)
#define PG8_ACOL(u) ((size_t)(g.a_div ? ((u).pn / g.a_div) * K * 2 : 0))
    Unit cur, nxt; int ui = 0;
    if (!S.next(0, cur)) return;
    f32x4 acc[2][2][4][2];
#pragma unroll
    for (int a = 0; a < 2; ++a)
#pragma unroll
        for (int b = 0; b < 2; ++b)
#pragma unroll
            for (int m = 0; m < 4; ++m)
#pragma unroll
                for (int n = 0; n < 2; ++n) acc[a][b][m][n] = (f32x4){0.f, 0.f, 0.f, 0.f};
    bf16x8 At[4][2], B0[2][2], B1[2][2];
    const char* cA = (const char*)g.A + (size_t)cur.pm * 2 * hA + PG8_ACOL(cur); const char* cB = (const char*)g.Bt + (size_t)cur.pn * 2 * hB;
    PG8_STAGE(PG8_SB(0, 0), cB, voffB); PG8_STAGE(PG8_SB(0, 1), cB + hB, voffB); PG8_STAGE(PG8_SA(0, 0), cA, voffA); PG8_STAGE(PG8_SA(0, 1), cA + hA, voffA);
    if (wr == 1) PG8_BAR;
    PG8_WAIT_V(2); PG8_BAR;
    PG8_STAGE(PG8_SB(1, 0), cB + kstep, voffB); PG8_STAGE(PG8_SA(1, 0), cA + kstep, voffA); PG8_STAGE(PG8_SB(1, 1), cB + hB + kstep, voffB);
    PG8_WAIT_V(6); PG8_BAR;
    for (;;) {
        const bool has_next = S.next(ui + 1, nxt);
        const char* nA = has_next ? (const char*)g.A + (size_t)nxt.pm * 2 * hA + PG8_ACOL(nxt) : cA; const char* nB = has_next ? (const char*)g.Bt + (size_t)nxt.pn * 2 * hB : cB;
#pragma unroll 1
        for (int t = 0; t < nt; t += 2) {
            const bool last = (t == nt - 2);
            const char* a1 = cA + (size_t)(t + 1) * kstep;
            const char* a2 = last ? nA : cA + (size_t)(t + 2) * kstep; const char* b2 = last ? nB : cB + (size_t)(t + 2) * kstep;
            const char* a3 = a2 + kstep; const char* b3 = b2 + kstep;
            PG8_LDB(B0, 0, 0); PG8_LDB(B1, 0, 1); PG8_SCHED; PG8_LDA(At, 0, 0); PG8_STAGE(PG8_SA(1, 1), a1 + hA, voffA);
            PG8_WAIT_V(8); PG8_WAIT_L(0); PG8_BAR; PG8_MMA(0, 0, At, B0); PG8_MMA(0, 1, At, B1); PG8_BAR; PG8_SCHED;
            PG8_LDA(At, 0, 1); PG8_STAGE(PG8_SB(0, 0), b2, voffB); PG8_STAGE(PG8_SB(0, 1), b2 + hB, voffB); PG8_STAGE(PG8_SA(0, 0), a2, voffA);
            PG8_WAIT_V(8); PG8_WAIT_L(0); PG8_BAR; PG8_MMA(1, 0, At, B0); PG8_MMA(1, 1, At, B1); PG8_BAR; PG8_SCHED;
            PG8_LDB(B0, 1, 0); PG8_LDB(B1, 1, 1); PG8_SCHED; PG8_LDA(At, 1, 0); PG8_STAGE(PG8_SA(0, 1), a2 + hA, voffA);
            PG8_WAIT_V(8); PG8_WAIT_L(0); PG8_BAR; PG8_MMA(0, 0, At, B0); PG8_MMA(0, 1, At, B1); PG8_BAR; PG8_SCHED;
            PG8_LDA(At, 1, 1); PG8_STAGE(PG8_SB(1, 0), b3, voffB); PG8_STAGE(PG8_SB(1, 1), b3 + hB, voffB); PG8_STAGE(PG8_SA(1, 0), a3, voffA);
            PG8_WAIT_V(8); PG8_WAIT_L(0); PG8_BAR; PG8_MMA(1, 0, At, B0); PG8_MMA(1, 1, At, B1); PG8_BAR; PG8_SCHED;
        }
        if (wr == 0) PG8_BAR;
        E(acc, cur, wr, wc, fr, fq);
        if (!has_next) break;
#pragma unroll
        for (int a = 0; a < 2; ++a)
#pragma unroll
            for (int b = 0; b < 2; ++b)
#pragma unroll
                for (int m = 0; m < 4; ++m)
#pragma unroll
                    for (int n = 0; n < 2; ++n) acc[a][b][m][n] = (f32x4){0.f, 0.f, 0.f, 0.f};
        cur = nxt; cA = nA; cB = nB; ++ui;
        if (wr == 1) PG8_BAR;
    }
    PG8_WAIT_V(0);
    PG8_BAR;
#undef PG8_SA
#undef PG8_SB
#undef PG8_STAGE
#undef PG8_LDA
#undef PG8_LDB
#undef PG8_MMA
#undef PG8_WAIT_V
#undef PG8_WAIT_L
#undef PG8_BAR
#undef PG8_SCHED
#undef PG8_ACOL
}
}

using pg8::Unit;
__device__ __forceinline__ void st_bf16x8(bf16* p, f32x4 v0, f32x4 v1) { v4u w; w.x = cvt_pk_bf16(v0[0], v0[1]); w.y = cvt_pk_bf16(v0[2], v0[3]); w.z = cvt_pk_bf16(v1[0], v1[1]); w.w = cvt_pk_bf16(v1[2], v1[3]); *(v4u*)p = w; }

struct EpiIn {
    unsigned char* ws;
    __device__ __forceinline__ void operator()(const f32x4 (&acc)[2][2][4][2], const Unit& u, int wr, int wc, int fr, int fq) const {
        const int pn = u.pn; const int row0 = u.pm * 256 + wr * 64 + fr;
        if (pn == 44) {
            if (wc == 0 && fq < 2) { float* alr = (float*)(ws + WS_ALR);
#pragma unroll
                for (int ai = 0; ai < 2; ++ai)
#pragma unroll
                    for (int m = 0; m < 4; ++m) { float* rp = alr + (size_t)(row0 + ai * 128 + m * 16) * 16 + 8 * fq;
                        *(f32x4*)rp = acc[ai][0][m][0]; *(f32x4*)(rp + 4) = acc[ai][0][m][1]; } }
            return;
        }
        if (pn >= 16 && pn < 32) {
            bf16* G = (bf16*)(ws + WS_R); const int col0 = (pn - 16) * 128 + wc * 32 + 8 * fq;
#pragma unroll
            for (int ai = 0; ai < 2; ++ai)
#pragma unroll
                for (int m = 0; m < 4; ++m) { f32x4 g0, g1;
#pragma unroll
                    for (int j = 0; j < 4; ++j) { const float r0 = acc[ai][0][m][0][j], r1 = acc[ai][0][m][1][j], a0 = acc[ai][1][m][0][j], a1 = acc[ai][1][m][1][j];
                        g0[j] = r0 * sigmoidf_(r0) * sigmoidf_(a0); g1[j] = r1 * sigmoidf_(r1) * sigmoidf_(a1); }
                    st_bf16x8(G + (size_t)(row0 + ai * 128 + m * 16) * 2048 + col0, g0, g1); }
            return;
        }
        bf16* base; int ldc, ct; float sc = 1.f;
        if (pn < 4) { base = (bf16*)(ws + WS_Q); ldc = 1024; ct = pn; sc = 0.0625f; }
        else if (pn < 8) { base = (bf16*)(ws + WS_K); ldc = 1024; ct = pn - 4; }
        else if (pn < 16) { base = (bf16*)(ws + WS_V); ldc = 2048; ct = pn - 8; }
        else if (pn < 36) { base = (bf16*)(ws + WS_U); ldc = 1024; ct = pn - 32; }
        else { base = (bf16*)(ws + WS_GB); ldc = 2048; ct = pn - 36; }
        const int col0 = ct * 256 + wc * 32 + 8 * fq;
#pragma unroll
        for (int ai = 0; ai < 2; ++ai)
#pragma unroll
            for (int m = 0; m < 4; ++m) { bf16* rowp = base + (size_t)(row0 + ai * 128 + m * 16) * ldc + col0;
#pragma unroll
                for (int bj = 0; bj < 2; ++bj) st_bf16x8(rowp + bj * 128, acc[ai][bj][m][0] * sc, acc[ai][bj][m][1] * sc); }
    }
};
namespace gs {
using namespace pg8;
struct SUnit { int st, pm, pn, kt0, nkt, r, s, late; };
__device__ __forceinline__ bool su_next(int i, int G, int c, SUnit& u) {
    int st = 0, pm = 0, pn = 0, kt0 = 0, nkt = 32, r = 0, sp = 0, late = 0;
    if (G != 256) {
        const long LL = (long)i * G + c; if (LL >= 288 + 288 + 1152 + 288) return false;
        const int L = (int)LL; late = 1;
        if (L < 288) { st = 0; nkt = 4; pm = L >> 3; pn = L & 7; }
        else if (L < 576) { st = 1; pm = (L - 288) >> 3; pn = (L - 288) & 7; }
        else if (L < 1728) { st = 2; pm = (L - 576) >> 5; pn = (L - 576) & 31; }
        else { st = 3; nkt = 128; pm = (L - 1728) >> 3; pn = (L - 1728) & 7; }
    } else {
        const int ty = (c < 160) ? 0 : (c < 192 ? 1 : 2);
        const int last = (ty == 2) ? 7 : 8;
        if (i > last) return false;
        if (i <= 1) { const int x = c & 7, y = c >> 3; st = i; nkt = (i == 0) ? 4 : 32; late = i; pm = 8 * (x >> 1) + (y & 7); pn = 4 * (x & 1) + (y >> 3); }
        else if (i == last) { st = 4; const int x = c & 7; int y;
            if (ty == 2) { const int k = (c - 192) >> 3; y = k >> 1; sp = k & 1; } else if (ty == 1) { y = (c - 160) >> 3; sp = 2; } else { const int k = c >> 3; y = k / 5; sp = 3 + (k - 5 * y); }
            pm = 32 + y; pn = x; r = y * 8 + x;
            kt0 = (sp < 2) ? 42 * sp : (sp == 2 ? 84 : 108 + 4 * (sp - 3)); nkt = (sp < 2) ? 42 : (sp == 2 ? 24 : 4); }
        else if (i == last - 1) { st = 3; nkt = 128; const int rank = (ty == 2) ? c - 192 : (ty == 1 ? c - 160 : c), P2 = (ty == 2) ? 4 : (ty == 1 ? 2 : 10), pm0 = (ty == 2) ? 0 : (ty == 1 ? 8 : 12);
            const int x = rank & 7, k = rank >> 3; pn = 2 * (x & 3) + (k & 1); pm = pm0 + (x >> 2) * P2 + (k >> 1); late = (pm >= 24) ? 1 : 0; }
        else if (ty == 1 && i <= 3) { st = i - 2; nkt = (i == 2) ? 4 : 32; late = i - 2; pm = 32 + ((c - 160) >> 3); pn = c & 7; }
        else { st = 2; int j2;
            if (i == 2) { j2 = (ty == 0) ? c : 160 + (c - 192); late = 1; } else if (i == 3) j2 = 224 + ((ty == 0) ? c : 160 + (c - 192)); else j2 = 448 + 256 * (i - 4) + c;
            const int rd = j2 >> 8, jr = j2 & 255, x = jr & 7, y = jr >> 3;
            pm = (rd < 4) ? 8 * rd + (y & 7) : 32 + (y & 3); pn = (rd < 4) ? 4 * x + (y >> 3) : 4 * x + (y >> 2); }
    }
    u.st = st; u.pm = pm; u.pn = pn; u.kt0 = kt0; u.nkt = nkt; u.r = r; u.s = sp; u.late = late;
    return true;
}
struct Ctx { unsigned char* ws; const float* xp; const float* xs; float* out; unsigned* ctl; const float* gn; const float* pscale; const float* gfin; };
__device__ __forceinline__ void st16_wt(__amdgpu_buffer_rsrc_t rs, unsigned off, v4u v) { __builtin_amdgcn_raw_buffer_store_b128(v, rs, off, 0, 16); }
__device__ __forceinline__ void st16_pl(__amdgpu_buffer_rsrc_t rs, unsigned off, v4u v) { __builtin_amdgcn_raw_buffer_store_b128(v, rs, off, 0, 0); }
#define ST16(X_, rs, off, v) st16_wt(rs, off, v)
__device__ __forceinline__ v4u pk8(f32x4 v0, f32x4 v1) { v4u w; w.x = cvt_pk_bf16(v0[0], v0[1]); w.y = cvt_pk_bf16(v0[2], v0[3]); w.z = cvt_pk_bf16(v1[0], v1[1]); w.w = cvt_pk_bf16(v1[2], v1[3]); return w; }
__device__ __forceinline__ float epi_rg(const Ctx& X, const SUnit& u, const f32x4 (&v)[2][2], int ai, int m, int wr, int wc, int fr, int fq) {
    const int row = u.pm * 256 + ai * 128 + wr * 64 + m * 16 + fr, col0 = u.pn * 256 + wc * 32 + 8 * fq;
    if (u.st == 0) {
        const float rs = __builtin_amdgcn_rsqf(((const float*)(X.ctl + CW_SSQ))[row * 4 + (u.pn >> 1)] * (1.f / DV) + EPS);
        const __amdgpu_buffer_rsrc_t rm = __builtin_amdgcn_make_buffer_rsrc((void*)(X.ws + WS_MB), (short)0, (int)((size_t)M * DM * 2), 0x00020000);
        const bf16* OG = (const bf16*)(X.ws + WS_OG); const bf16* Gt = (const bf16*)(X.ws + WS_R); const bf16* GB = (const bf16*)(X.ws + WS_GB);
#pragma unroll
        for (int bj = 0; bj < 2; ++bj) { const size_t o2 = (size_t)row * DM + col0 + bj * 128; const int cc = col0 + bj * 128;
            const v4u xo = *(const v4u*)(OG + o2), xg = *(const v4u*)(Gt + o2), xb = *(const v4u*)(GB + o2);
            const f32x4 n0 = *(const f32x4*)(X.gn + (cc & 511)), n1 = *(const f32x4*)(X.gn + (cc & 511) + 4), p0 = *(const f32x4*)(X.pscale + cc), p1 = *(const f32x4*)(X.pscale + cc + 4);
            const unsigned ao[4] = {xo.x, xo.y, xo.z, xo.w}, ag[4] = {xg.x, xg.y, xg.z, xg.w}, ab[4] = {xb.x, xb.y, xb.z, xb.w};
            f32x4 r0, r1;
#pragma unroll
            for (int j = 0; j < 2; ++j) {
                r0[2 * j] = bf2f(ag[j] & 0xffffu) * (bf2f(ao[j] & 0xffffu) * rs * n0[2 * j]) + sigmoidf_(bf2f(ab[j] & 0xffffu)) * (v[bj][0][2 * j] * p0[2 * j]);
                r0[2 * j + 1] = bf2f(ag[j] >> 16) * (bf2f(ao[j] >> 16) * rs * n0[2 * j + 1]) + sigmoidf_(bf2f(ab[j] >> 16)) * (v[bj][0][2 * j + 1] * p0[2 * j + 1]);
                r1[2 * j] = bf2f(ag[2 + j] & 0xffffu) * (bf2f(ao[2 + j] & 0xffffu) * rs * n1[2 * j]) + sigmoidf_(bf2f(ab[2 + j] & 0xffffu)) * (v[bj][1][2 * j] * p1[2 * j]);
                r1[2 * j + 1] = bf2f(ag[2 + j] >> 16) * (bf2f(ao[2 + j] >> 16) * rs * n1[2 * j + 1]) + sigmoidf_(bf2f(ab[2 + j] >> 16)) * (v[bj][1][2 * j + 1] * p1[2 * j + 1]); }
            ST16(X, rm, (unsigned)(o2 * 2), pk8(r0, r1)); }
        return 0.f;
    }
    if (u.st == 2) {
        const float rs = __builtin_amdgcn_rsqf(((const float*)(X.ctl + CW_SSQ1))[row] * (1.f / DM) + EPS);
        const __amdgpu_buffer_rsrc_t rh = __builtin_amdgcn_make_buffer_rsrc((void*)(X.ws + WS_HID), (short)0, (int)((size_t)M * FF * 2), 0x00020000);
#pragma unroll
        for (int bj = 0; bj < 2; ++bj) { f32x4 v0 = v[bj][0] * rs, v1 = v[bj][1] * rs;
#pragma unroll
            for (int j = 0; j < 4; ++j) { const float a = fmaxf(v0[j], 0.f), b = fmaxf(v1[j], 0.f); v0[j] = a * a; v1[j] = b * b; }
            ST16(X, rh, (unsigned)(((size_t)row * FF + col0 + bj * 128) * 2), pk8(v0, v1)); }
        return 0.f;
    }
    const size_t off = (size_t)row * DM + col0; float ss = 0.f;
    if (u.st == 1) {
        const float* xin = (row < NP) ? X.xp : X.xs - (size_t)NP * DM;
        const __amdgpu_buffer_rsrc_t rb = __builtin_amdgcn_make_buffer_rsrc((void*)(X.ws + WS_X1B), (short)0, (int)((size_t)M * DM * 2), 0x00020000);
#pragma unroll
        for (int bj = 0; bj < 2; ++bj) { const f32x4 a0 = *(const f32x4*)(xin + off + bj * 128), a1 = *(const f32x4*)(xin + off + bj * 128 + 4);
            const f32x4 v0 = a0 + v[bj][0], v1 = a1 + v[bj][1];
            ST16(X, rb, (unsigned)((off + bj * 128) * 2), pk8(v0, v1));
            ss += (v0[0] * v0[0] + v0[1] * v0[1]) + (v0[2] * v0[2] + v0[3] * v0[3]) + (v1[0] * v1[0] + v1[1] * v1[1]) + (v1[2] * v1[2] + v1[3] * v1[3]); }
        ss += __shfl_xor(ss, 16); ss += __shfl_xor(ss, 32);
        float old = 0.f; if (fq == 0) old = atomicAdd((float*)(X.ctl + CW_SSQ1) + row, ss);
        return old;
    } else {
        const bf16* x1 = (const bf16*)(X.ws + WS_X1B); float* xo = X.out + OUT_Y;
#pragma unroll
        for (int bj = 0; bj < 2; ++bj) { const v4u xa = *(const v4u*)(x1 + off + bj * 128);
            const f32x4 a0 = (f32x4){bf2f(xa.x & 0xffffu), bf2f(xa.x >> 16), bf2f(xa.y & 0xffffu), bf2f(xa.y >> 16)}, a1 = (f32x4){bf2f(xa.z & 0xffffu), bf2f(xa.z >> 16), bf2f(xa.w & 0xffffu), bf2f(xa.w >> 16)};
            const f32x4 v0 = a0 + v[bj][0], v1 = a1 + v[bj][1];
            *(f32x4*)(xo + off + bj * 128) = v0; *(f32x4*)(xo + off + bj * 128 + 4) = v1;
            ss += (v0[0] * v0[0] + v0[1] * v0[1]) + (v0[2] * v0[2] + v0[3] * v0[3]) + (v1[0] * v1[0] + v1[1] * v1[1]) + (v1[2] * v1[2] + v1[3] * v1[3]); }
        ss += __shfl_xor(ss, 16); ss += __shfl_xor(ss, 32);
        if (fq == 0) atomicAdd((float*)(X.ctl + CW_SSQ2) + row, ss);
    }
    return 0.f;
}
__device__ __forceinline__ void wait_count(unsigned* word, unsigned need, unsigned* tmo) {
    if (threadIdx.x < 64) {
        unsigned polls = 0;
        while ((unsigned)__builtin_amdgcn_readfirstlane(__hip_atomic_load(word, __ATOMIC_RELAXED, __HIP_MEMORY_SCOPE_AGENT)) < need) {
            if ((++polls & 1023u) == 0u) { if (__builtin_amdgcn_readfirstlane(__hip_atomic_load(tmo, __ATOMIC_RELAXED, __HIP_MEMORY_SCOPE_AGENT)) != 0u) break;
                if (polls > (1u << 22)) { if (threadIdx.x == 0) __hip_atomic_store(tmo, 1u, __ATOMIC_RELAXED, __HIP_MEMORY_SCOPE_AGENT); break; } }
            __builtin_amdgcn_s_sleep(2); }
        __builtin_amdgcn_fence(__ATOMIC_ACQUIRE, "agent");
        asm volatile("s_waitcnt vmcnt(0)" ::: "memory");
    }
    asm volatile("" ::: "memory"); __builtin_amdgcn_s_barrier(); asm volatile("" ::: "memory");
}
__device__ __forceinline__ void a_ready(const Ctx& X, const SUnit& u) {
    if (u.st == 0) return;
    unsigned* w = X.ctl + (u.st == 1 ? CW_CNTP : (u.st == 2 ? CW_CNT5 : CW_CNT6)) + 64 * u.pm;
    wait_count(w, u.st >= 3 ? 256u : 64u, X.ctl + CW_TMO);
}
__device__ __forceinline__ void epi2_comp(const Ctx& X, const SUnit& u, const f32x4 (&v)[2][2], float ssq, int ai, int m, int wr, int wc, int fr, int fq) {
    const int row = u.pm * 256 + ai * 128 + wr * 64 + m * 16 + fr, col0 = u.pn * 256 + wc * 32 + 8 * fq;
    const float rs = __builtin_amdgcn_rsqf(ssq * (1.f / DM) + EPS);
    const __amdgpu_buffer_rsrc_t rh = __builtin_amdgcn_make_buffer_rsrc((void*)(X.ws + WS_HID), (short)0, (int)((size_t)M * FF * 2), 0x00020000);
#pragma unroll
    for (int bj = 0; bj < 2; ++bj) { f32x4 v0 = v[bj][0] * rs, v1 = v[bj][1] * rs;
#pragma unroll
        for (int j = 0; j < 4; ++j) { const float a = fmaxf(v0[j], 0.f), b = fmaxf(v1[j], 0.f); v0[j] = a * a; v1[j] = b * b; }
        ST16(X, rh, (unsigned)(((size_t)row * FF + col0 + bj * 128) * 2), pk8(v0, v1)); }
}
typedef const __attribute__((address_space(1))) f32x4* gptr4;
__device__ __forceinline__ void epi0_comp(const Ctx& X, const SUnit& u, const f32x4 (&v)[2][2], float ssq, const f32x4 (&nv)[2][2], const f32x4 (&pv)[2][2], int ai, int m, int wr, int wc, int fr, int fq) {
    const int row = u.pm * 256 + ai * 128 + wr * 64 + m * 16 + fr, col0 = u.pn * 256 + wc * 32 + 8 * fq;
    const float rs = __builtin_amdgcn_rsqf(ssq * (1.f / DV) + EPS);
    const __amdgpu_buffer_rsrc_t rm = __builtin_amdgcn_make_buffer_rsrc((void*)(X.ws + WS_MB), (short)0, (int)((size_t)M * DM * 2), 0x00020000);
    const bf16* OG = (const bf16*)(X.ws + WS_OG); const bf16* Gt = (const bf16*)(X.ws + WS_R); const bf16* GB = (const bf16*)(X.ws + WS_GB);
    v4u xo[2], xg[2], xb[2];
#pragma unroll
    for (int bj = 0; bj < 2; ++bj) { const size_t o2 = (size_t)row * DM + col0 + bj * 128; xo[bj] = *(const v4u*)(OG + o2); xg[bj] = *(const v4u*)(Gt + o2); xb[bj] = *(const v4u*)(GB + o2); }
#pragma unroll
    for (int bj = 0; bj < 2; ++bj) { const size_t o2 = (size_t)row * DM + col0 + bj * 128;
        const unsigned ao[4] = {xo[bj].x, xo[bj].y, xo[bj].z, xo[bj].w}, ag[4] = {xg[bj].x, xg[bj].y, xg[bj].z, xg[bj].w}, ab[4] = {xb[bj].x, xb[bj].y, xb[bj].z, xb[bj].w};
        const f32x4 n0 = nv[bj][0] * rs, n1 = nv[bj][1] * rs, p0 = pv[bj][0], p1 = pv[bj][1];
        f32x4 r0, r1;
#pragma unroll
        for (int j = 0; j < 2; ++j) {
            r0[2 * j] = bf2f(ag[j] & 0xffffu) * (bf2f(ao[j] & 0xffffu) * n0[2 * j]) + sigmoidf_(bf2f(ab[j] & 0xffffu)) * (v[bj][0][2 * j] * p0[2 * j]);
            r0[2 * j + 1] = bf2f(ag[j] >> 16) * (bf2f(ao[j] >> 16) * n0[2 * j + 1]) + sigmoidf_(bf2f(ab[j] >> 16)) * (v[bj][0][2 * j + 1] * p0[2 * j + 1]);
            r1[2 * j] = bf2f(ag[2 + j] & 0xffffu) * (bf2f(ao[2 + j] & 0xffffu) * n1[2 * j]) + sigmoidf_(bf2f(ab[2 + j] & 0xffffu)) * (v[bj][1][2 * j] * p1[2 * j]);
            r1[2 * j + 1] = bf2f(ag[2 + j] >> 16) * (bf2f(ao[2 + j] >> 16) * n1[2 * j + 1]) + sigmoidf_(bf2f(ab[2 + j] >> 16)) * (v[bj][1][2 * j + 1] * p1[2 * j + 1]); }
        ST16(X, rm, (unsigned)(o2 * 2), pk8(r0, r1)); }
}
__device__ __forceinline__ void epi1_load(const Ctx& X, const SUnit& u, int ai, int m, int wr, int wc, int fr, int fq, f32x4 (&xa)[4]) {
    const int row = u.pm * 256 + ai * 128 + wr * 64 + m * 16 + fr, col0 = u.pn * 256 + wc * 32 + 8 * fq;
    const float* xin = ((row < NP) ? X.xp : X.xs - (size_t)NP * DM) + (size_t)row * DM + col0;
    xa[0] = *(const f32x4*)(xin); xa[1] = *(const f32x4*)(xin + 4); xa[2] = *(const f32x4*)(xin + 128); xa[3] = *(const f32x4*)(xin + 132);
}
__device__ __forceinline__ float epi1_comp(const Ctx& X, const SUnit& u, const f32x4 (&v)[2][2], const f32x4 (&xa)[4], int ai, int m, int wr, int wc, int fr, int fq) {
    const int row = u.pm * 256 + ai * 128 + wr * 64 + m * 16 + fr, col0 = u.pn * 256 + wc * 32 + 8 * fq;
    const size_t off = (size_t)row * DM + col0; float ss = 0.f;
    const __amdgpu_buffer_rsrc_t rb = __builtin_amdgcn_make_buffer_rsrc((void*)(X.ws + WS_X1B), (short)0, (int)((size_t)M * DM * 2), 0x00020000);
#pragma unroll
    for (int bj = 0; bj < 2; ++bj) { const f32x4 v0 = xa[2 * bj] + v[bj][0], v1 = xa[2 * bj + 1] + v[bj][1];
        ST16(X, rb, (unsigned)((off + bj * 128) * 2), pk8(v0, v1));
        ss += (v0[0] * v0[0] + v0[1] * v0[1]) + (v0[2] * v0[2] + v0[3] * v0[3]) + (v1[0] * v1[0] + v1[1] * v1[1]) + (v1[2] * v1[2] + v1[3] * v1[3]); }
    ss += __shfl_xor(ss, 16); ss += __shfl_xor(ss, 32);
    float old = 0.f; if (fq == 0) old = atomicAdd((float*)(X.ctl + CW_SSQ1) + row, ss);
    return old;
}
__device__ __forceinline__ void x1_load(const Ctx& X, const SUnit& u, int ai, int m, int wr, int wc, int fr, int fq, v4u (&xa)[2]) {
    const int row = u.pm * 256 + ai * 128 + wr * 64 + m * 16 + fr, col0 = u.pn * 256 + wc * 32 + 8 * fq;
    const bf16* x1 = (const bf16*)(X.ws + WS_X1B) + (size_t)row * DM + col0; xa[0] = *(const v4u*)x1; xa[1] = *(const v4u*)(x1 + 128);
}
__device__ __forceinline__ float x2_rg(f32x4 (&v)[2][2], const v4u (&xr)[2]) {
    float ss = 0.f;
#pragma unroll
    for (int bj = 0; bj < 2; ++bj) { const v4u xa = xr[bj];
        v[bj][0] += (f32x4){bf2f(xa.x & 0xffffu), bf2f(xa.x >> 16), bf2f(xa.y & 0xffffu), bf2f(xa.y >> 16)}; v[bj][1] += (f32x4){bf2f(xa.z & 0xffffu), bf2f(xa.z >> 16), bf2f(xa.w & 0xffffu), bf2f(xa.w >> 16)};
        const f32x4 v0 = v[bj][0], v1 = v[bj][1];
        ss += (v0[0] * v0[0] + v0[1] * v0[1]) + (v0[2] * v0[2] + v0[3] * v0[3]) + (v1[0] * v1[0] + v1[1] * v1[1]) + (v1[2] * v1[2] + v1[3] * v1[3]); }
    ss += __shfl_xor(ss, 16); ss += __shfl_xor(ss, 32);
    return ss;
}
__device__ __forceinline__ void y_rg(const Ctx& X, const SUnit& u, const f32x4 (&v)[2][2], float rstd, int ai, int m, int wr, int wc, int fr, int fq) {
    const int row = u.pm * 256 + ai * 128 + wr * 64 + m * 16 + fr, col0 = u.pn * 256 + wc * 32 + 8 * fq;
    float* yo = X.out + OUT_Y + (size_t)row * DM + col0;
#pragma unroll
    for (int bj = 0; bj < 2; ++bj) { const f32x4 g0 = *(gptr4)(X.gfin + col0 + bj * 128), g1 = *(gptr4)(X.gfin + col0 + bj * 128 + 4);
        *(f32x4*)(yo + bj * 128) = v[bj][0] * rstd * g0; *(f32x4*)(yo + bj * 128 + 4) = v[bj][1] * rstd * g1; }
}
__device__ __forceinline__ void gemm_stream(LAS unsigned char* lds, const Ctx X, const int G, const int c) {
    const int tid = threadIdx.x, wid = __builtin_amdgcn_readfirstlane(tid >> 6), lane = tid & 63, wr = wid >> 2, wc = wid & 3, fr = lane & 15, fq = lane >> 4;
    unsigned RA2[2], RB2[2], C2[2];
#pragma unroll
    for (int i = 0; i < 2; ++i) { int R, C; stage_rc(tid * 16 + i * 8192, R, C); RA2[i] = (unsigned)R * 2u; RB2[i] = (unsigned)((R & ~31) + perm32(R & 31)) * 2u; C2[i] = (unsigned)C * 2u; }
    const size_t kstep = (size_t)(BK * 2);
    const unsigned ldsw = (unsigned)wid * 1024u;
    const int aoff = lds_byte(wr * 64 + fr, fq * 8), boff = lds_byte(wc * 32 + fr, fq * 8);
#define GS_LDA(u) ((u).st == 0 ? 1024 : ((u).st >= 3 ? FF : DM))
#define GS_LDB(u) ((u).st == 0 ? 256 : ((u).st >= 3 ? FF : DM))
#define GS_ABASE(u) ((const char*)X.ws + ((u).st == 0 ? WS_PB : ((u).st == 1 ? WS_MB : ((u).st == 2 ? WS_X1B : WS_HID))) + ((size_t)(u).pm * 256 * GS_LDA(u) + (size_t)(u).kt0 * BK + ((u).st == 0 ? ((u).pn >> 1) * 256 : 0)) * 2)
#define GS_BBASE(u) ((const char*)X.ws + ((u).st == 0 ? WS_WPOOL : ((u).st == 1 ? WS_WOUT : ((u).st == 2 ? WS_WUP : WS_WDN))) + ((size_t)(u).pn * 256 * GS_LDB(u) + (size_t)(u).kt0 * BK) * 2)
#define PG8_SA(b, h) (((b) * 2 + (h)) * HTB)
#define PG8_SB(b, h) ((4 + (b) * 2 + (h)) * HTB)
#define PG8_STAGE(bufoff, gbase, R2, ld) do { _Pragma("unroll") for (int _i = 0; _i < 2; ++_i) \
        __builtin_amdgcn_global_load_lds((const unsigned*)((const char*)(gbase) + ((R2)[_i] * (unsigned)(ld) + C2[_i])), (LAS unsigned*)(lds + (bufoff) + ldsw + _i * 8192), 16, 0, 0); } while (0)
#define PG8_LDA(dst, b, h) do { _Pragma("unroll") for (int m = 0; m < 4; ++m) _Pragma("unroll") for (int k = 0; k < 2; ++k) dst[m][k] = *(const LAS bf16x8*)(lds + PG8_SA(b, h) + aoff + m * 2048 + k * 1024); } while (0)
#define PG8_LDB(dst, b, h) do { _Pragma("unroll") for (int n = 0; n < 2; ++n) _Pragma("unroll") for (int k = 0; k < 2; ++k) dst[n][k] = *(const LAS bf16x8*)(lds + PG8_SB(b, h) + boff + n * 2048 + k * 1024); } while (0)
#define PG8_MMA(ai, bj, At, Bt) do { __builtin_amdgcn_s_setprio(1); _Pragma("unroll") for (int m = 0; m < 4; ++m) _Pragma("unroll") for (int n = 0; n < 2; ++n) _Pragma("unroll") for (int k = 0; k < 2; ++k) \
        acc[ai][bj][m][n] = __builtin_amdgcn_mfma_f32_16x16x32_bf16(Bt[n][k], At[m][k], acc[ai][bj][m][n], 0, 0, 0); __builtin_amdgcn_s_setprio(0); } while (0)
#define PG8_WAIT_V(n) asm volatile("s_waitcnt vmcnt(" #n ")" ::: "memory")
#define PG8_WAIT_L(n) asm volatile("s_waitcnt lgkmcnt(" #n ")" ::: "memory")
#define PG8_BAR __builtin_amdgcn_s_barrier()
#define PG8_SCHED __builtin_amdgcn_sched_barrier(0)
    SUnit cur, nxt; int ui = 0, pend = -1;
    if (!su_next(0, G, c, cur)) return;
    f32x4 acc[2][2][4][2];
#pragma unroll
    for (int a = 0; a < 2; ++a)
#pragma unroll
        for (int b = 0; b < 2; ++b)
#pragma unroll
            for (int m = 0; m < 4; ++m)
#pragma unroll
                for (int n = 0; n < 2; ++n) acc[a][b][m][n] = (f32x4){0.f, 0.f, 0.f, 0.f};
    bf16x8 At[4][2], B0[2][2], B1[2][2];
    const char* cA = GS_ABASE(cur); const char* cB = GS_BBASE(cur); int clA = GS_LDA(cur), clB = GS_LDB(cur);
#define GS_PROLOGUE() do { a_ready(X, cur); const size_t hA_ = (size_t)HALF * clA * 2, hB_ = (size_t)HALF * clB * 2; \
    PG8_STAGE(PG8_SB(0, 0), cB, RB2, clB); PG8_STAGE(PG8_SB(0, 1), cB + hB_, RB2, clB); PG8_STAGE(PG8_SA(0, 0), cA, RA2, clA); PG8_STAGE(PG8_SA(0, 1), cA + hA_, RA2, clA); \
    if (wr == 1) PG8_BAR; \
    PG8_WAIT_V(2); PG8_BAR; \
    PG8_STAGE(PG8_SB(1, 0), cB + kstep, RB2, clB); PG8_STAGE(PG8_SA(1, 0), cA + kstep, RA2, clA); PG8_STAGE(PG8_SB(1, 1), cB + hB_ + kstep, RB2, clB); \
    PG8_WAIT_V(6); PG8_BAR; } while (0)
    GS_PROLOGUE();
    for (;;) {
        const bool has_next = su_next(ui + 1, G, c, nxt);
        const bool early = has_next && !nxt.late;
        const char* nA = early ? GS_ABASE(nxt) : cA; const char* nB = early ? GS_BBASE(nxt) : cB; const int nlA = early ? GS_LDA(nxt) : clA, nlB = early ? GS_LDB(nxt) : clB;
        const int nt = cur.nkt; const size_t hA = (size_t)HALF * clA * 2;
#pragma unroll 1
        for (int t = 0; t < nt; t += 2) {
            const bool last = (t == nt - 2);
            const char* a1 = cA + (size_t)(t + 1) * kstep;
            const char* a2 = last ? nA : cA + (size_t)(t + 2) * kstep; const char* b2 = last ? nB : cB + (size_t)(t + 2) * kstep;
            const char* a3 = a2 + kstep; const char* b3 = b2 + kstep;
            const int lA2 = last ? nlA : clA, lB2 = last ? nlB : clB; const size_t hA2 = (size_t)HALF * lA2 * 2, hB2 = (size_t)HALF * lB2 * 2;
            if (last && early) a_ready(X, nxt);
            PG8_LDB(B0, 0, 0); PG8_LDB(B1, 0, 1); PG8_SCHED; PG8_LDA(At, 0, 0); PG8_STAGE(PG8_SA(1, 1), a1 + hA, RA2, clA);
            PG8_WAIT_V(8); PG8_WAIT_L(0); PG8_BAR; PG8_MMA(0, 0, At, B0); PG8_MMA(0, 1, At, B1); PG8_BAR; PG8_SCHED;
            PG8_LDA(At, 0, 1); PG8_STAGE(PG8_SB(0, 0), b2, RB2, lB2); PG8_STAGE(PG8_SB(0, 1), b2 + hB2, RB2, lB2); PG8_STAGE(PG8_SA(0, 0), a2, RA2, lA2);
            PG8_WAIT_V(8); PG8_WAIT_L(0); PG8_BAR; PG8_MMA(1, 0, At, B0); PG8_MMA(1, 1, At, B1); PG8_BAR; PG8_SCHED;
            PG8_LDB(B0, 1, 0); PG8_LDB(B1, 1, 1); PG8_SCHED; PG8_LDA(At, 1, 0); PG8_STAGE(PG8_SA(0, 1), a2 + hA2, RA2, lA2);
            PG8_WAIT_V(8); PG8_WAIT_L(0); PG8_BAR; PG8_MMA(0, 0, At, B0); PG8_MMA(0, 1, At, B1); PG8_BAR; PG8_SCHED;
            PG8_LDA(At, 1, 1); PG8_STAGE(PG8_SB(1, 0), b3, RB2, lB2); PG8_STAGE(PG8_SB(1, 1), b3 + hB2, RB2, lB2); PG8_STAGE(PG8_SA(1, 0), a3, RA2, lA2);
            PG8_WAIT_V(8); PG8_WAIT_L(0); PG8_BAR; PG8_MMA(1, 0, At, B0); PG8_MMA(1, 1, At, B1);
            if (pend >= 0) { PG8_WAIT_V(0); if (lane == 0) __hip_atomic_fetch_add(X.ctl + pend, 1u, __ATOMIC_RELAXED, __HIP_MEMORY_SCOPE_AGENT); pend = -1; }
            PG8_BAR; PG8_SCHED;
        }
        if (wr == 0) PG8_BAR;
        int fr_ = fr, fq_ = fq; asm volatile("" : "+v"(fr_), "+v"(fq_));
        if (cur.st == 3 && G == 256) {
            LAS float* XP = (LAS float*)(lds + STAGE_BYTES); LAS float* XR = XP + 1024;
            { v4u xr[2][2]; x1_load(X, cur, 0, 0, wr, wc, fr_, fq_, xr[0]);
#pragma unroll
            for (int k = 0; k < 8; ++k) { const int ai = k >> 2, m = k & 3;
                    if (k < 7) x1_load(X, cur, (k + 1) >> 2, (k + 1) & 3, wr, wc, fr_, fq_, xr[(k + 1) & 1]);
                    f32x4 v[2][2] = {{acc[ai][0][m][0], acc[ai][0][m][1]}, {acc[ai][1][m][0], acc[ai][1][m][1]}};
                    const float ss = x2_rg(v, xr[k & 1]);
                    acc[ai][0][m][0] = v[0][0]; acc[ai][0][m][1] = v[0][1]; acc[ai][1][m][0] = v[1][0]; acc[ai][1][m][1] = v[1][1];
                    if (fq_ == 0) XP[(ai * 128 + wr * 64 + m * 16 + fr_) * 4 + wc] = ss; } }
            PG8_WAIT_L(0); PG8_BAR; asm volatile("" ::: "memory");
            float* xs_ = (float*)(X.ws + WS_XS) + (size_t)cur.pm * 2048;
            if (tid < 256) { const f32x4 p4 = *(const LAS f32x4*)(XP + tid * 4); __hip_atomic_store(xs_ + cur.pn * 256 + tid, (p4[0] + p4[1]) + (p4[2] + p4[3]), __ATOMIC_RELAXED, __HIP_MEMORY_SCOPE_AGENT);
                asm volatile("s_waitcnt vmcnt(0)" ::: "memory");
                if (lane == 0) __hip_atomic_fetch_add(X.ctl + CW_CNT7 + 64 * cur.pm, 1u, __ATOMIC_RELAXED, __HIP_MEMORY_SCOPE_AGENT); }
            wait_count(X.ctl + CW_CNT7 + 64 * cur.pm, 32u, X.ctl + CW_TMO);
            if (tid < 256) { float tot = 0.f;
#pragma unroll
                for (int q = 0; q < 8; ++q) tot += xs_[q * 256 + tid];
                XR[tid] = __builtin_amdgcn_rsqf(tot * (1.f / DM) + EPS); }
            PG8_WAIT_L(0); PG8_BAR; asm volatile("" ::: "memory");
#pragma unroll
            for (int ai = 0; ai < 2; ++ai)
#pragma unroll
                for (int m = 0; m < 4; ++m) { const f32x4 v[2][2] = {{acc[ai][0][m][0], acc[ai][0][m][1]}, {acc[ai][1][m][0], acc[ai][1][m][1]}};
                    y_rg(X, cur, v, XR[ai * 128 + wr * 64 + m * 16 + fr_], ai, m, wr, wc, fr_, fq_); asm volatile("" ::: "memory"); }
            PG8_WAIT_L(0); PG8_BAR; asm volatile("" ::: "memory");
        } else if (cur.st != 4) { float olds[8];
            if (cur.st == 1) { f32x4 xa[2][4]; epi1_load(X, cur, 0, 0, wr, wc, fr_, fq_, xa[0]);
#pragma unroll
                for (int k = 0; k < 8; ++k) { const int ai = k >> 2, m = k & 3;
                    if (k < 7) epi1_load(X, cur, (k + 1) >> 2, (k + 1) & 3, wr, wc, fr_, fq_, xa[(k + 1) & 1]);
                    const f32x4 v[2][2] = {{acc[ai][0][m][0], acc[ai][0][m][1]}, {acc[ai][1][m][0], acc[ai][1][m][1]}}; olds[k] = epi1_comp(X, cur, v, xa[k & 1], ai, m, wr, wc, fr_, fq_); }
                asm volatile("" :: "v"(olds[0]), "v"(olds[1]), "v"(olds[2]), "v"(olds[3]), "v"(olds[4]), "v"(olds[5]), "v"(olds[6]), "v"(olds[7]));
            } else if (cur.st == 2) { float sq[8];
#pragma unroll
                for (int k = 0; k < 8; ++k) sq[k] = ((const float*)(X.ctl + CW_SSQ1))[cur.pm * 256 + (k >> 2) * 128 + wr * 64 + (k & 3) * 16 + fr_];
#pragma unroll
                for (int k = 0; k < 8; ++k) { const int ai = k >> 2, m = k & 3;
                    const f32x4 v[2][2] = {{acc[ai][0][m][0], acc[ai][0][m][1]}, {acc[ai][1][m][0], acc[ai][1][m][1]}}; epi2_comp(X, cur, v, sq[k], ai, m, wr, wc, fr_, fq_); }
            } else if (cur.st == 0) { float sq[8]; f32x4 nv[2][2], pv[2][2];
                { const int cc = cur.pn * 256 + wc * 32 + 8 * fq_;
#pragma unroll
                for (int bj = 0; bj < 2; ++bj) { nv[bj][0] = *(gptr4)(X.gn + ((cc + bj * 128) & 511)); nv[bj][1] = *(gptr4)(X.gn + ((cc + bj * 128) & 511) + 4); pv[bj][0] = *(gptr4)(X.pscale + cc + bj * 128); pv[bj][1] = *(gptr4)(X.pscale + cc + bj * 128 + 4); } }
#pragma unroll
                for (int k = 0; k < 8; ++k) sq[k] = ((const float*)(X.ctl + CW_SSQ))[(cur.pm * 256 + (k >> 2) * 128 + wr * 64 + (k & 3) * 16 + fr_) * 4 + (cur.pn >> 1)];
#pragma unroll
                for (int k = 0; k < 8; ++k) { const int ai = k >> 2, m = k & 3;
                    const f32x4 v[2][2] = {{acc[ai][0][m][0], acc[ai][0][m][1]}, {acc[ai][1][m][0], acc[ai][1][m][1]}}; epi0_comp(X, cur, v, sq[k], nv, pv, ai, m, wr, wc, fr_, fq_); }
            } else {
#pragma unroll
            for (int ai = 0; ai < 2; ++ai)
#pragma unroll
                for (int m = 0; m < 4; ++m) { const f32x4 v[2][2] = {{acc[ai][0][m][0], acc[ai][0][m][1]}, {acc[ai][1][m][0], acc[ai][1][m][1]}}; olds[ai * 4 + m] = epi_rg(X, cur, v, ai, m, wr, wc, fr_, fq_); }
            }
            if (cur.st < 3) {
                const int widx = (cur.st == 0 ? CW_CNTP : (cur.st == 1 ? CW_CNT5 : CW_CNT6)) + 64 * cur.pm;
                if (early) pend = widx;
                else { asm volatile("s_waitcnt vmcnt(0)" ::: "memory"); if (lane == 0) __hip_atomic_fetch_add(X.ctl + widx, 1u, __ATOMIC_RELAXED, __HIP_MEMORY_SCOPE_AGENT); } }
        } else {
            const __amdgpu_buffer_rsrc_t rsl = __builtin_amdgcn_make_buffer_rsrc((void*)(X.ws + WS_SLAB + (size_t)(cur.r * 8 + cur.s) * 131072), (short)0, 131072, 0x00020000);
#pragma unroll
            for (int ai = 0; ai < 2; ++ai)
#pragma unroll
                for (int bj = 0; bj < 2; ++bj)
#pragma unroll
                    for (int m = 0; m < 4; ++m) st16_wt(rsl, (unsigned)((((ai * 2 + bj) * 4 + m)) * 8192 + tid * 16), pk8(acc[ai][bj][m][0], acc[ai][bj][m][1]));
            asm volatile("s_waitcnt vmcnt(0)" ::: "memory");
            if (lane == 0) __hip_atomic_fetch_add(X.ctl + CW_CNTS + 64 * cur.r, 1u, __ATOMIC_RELAXED, __HIP_MEMORY_SCOPE_AGENT);
            wait_count(X.ctl + CW_CNTS + 64 * cur.r, 64u, X.ctl + CW_TMO);
            const int rai = cur.s >> 2, rm = cur.s & 3;
            f32x4 v[2][2] = {{(f32x4){0.f, 0.f, 0.f, 0.f}, (f32x4){0.f, 0.f, 0.f, 0.f}}, {(f32x4){0.f, 0.f, 0.f, 0.f}, (f32x4){0.f, 0.f, 0.f, 0.f}}};
            const char* sb = (const char*)(X.ws + WS_SLAB) + (size_t)cur.r * 8 * 131072 + (size_t)((rai * 2) * 4 + rm) * 8192 + (size_t)tid * 16;
#pragma unroll
            for (int p = 0; p < 8; ++p)
#pragma unroll
                for (int bj = 0; bj < 2; ++bj) { const v4u x = *(const v4u*)(sb + (size_t)p * 131072 + (size_t)(bj * 4) * 8192);
                    v[bj][0] += (f32x4){bf2f(x.x & 0xffffu), bf2f(x.x >> 16), bf2f(x.y & 0xffffu), bf2f(x.y >> 16)};
                    v[bj][1] += (f32x4){bf2f(x.z & 0xffffu), bf2f(x.z >> 16), bf2f(x.w & 0xffffu), bf2f(x.w >> 16)}; }
            if (G != 256) (void)epi_rg(X, cur, v, rai, rm, wr, wc, fr_, fq_);
            else {
                LAS float* XP = (LAS float*)(lds + STAGE_BYTES); LAS float* XR = XP + 1024;
                v4u xr4[2]; x1_load(X, cur, rai, rm, wr, wc, fr_, fq_, xr4); const float ss = x2_rg(v, xr4);
                if (fq_ == 0) XP[(wr * 16 + fr_) * 4 + wc] = ss;
                PG8_WAIT_L(0); PG8_BAR; asm volatile("" ::: "memory");
                const int gi = (cur.pm - 32) * 8 + cur.s; float* xs4 = (float*)(X.ws + WS_XS4) + (size_t)gi * 256;
                if (tid < 32) { const f32x4 p4 = *(const LAS f32x4*)(XP + tid * 4); __hip_atomic_store(xs4 + cur.pn * 32 + tid, (p4[0] + p4[1]) + (p4[2] + p4[3]), __ATOMIC_RELAXED, __HIP_MEMORY_SCOPE_AGENT);
                    asm volatile("s_waitcnt vmcnt(0)" ::: "memory");
                    if (lane == 0) __hip_atomic_fetch_add(X.ctl + CW_CNT8 + 64 * gi, 1u, __ATOMIC_RELAXED, __HIP_MEMORY_SCOPE_AGENT); }
                wait_count(X.ctl + CW_CNT8 + 64 * gi, 8u, X.ctl + CW_TMO);
                if (tid < 32) { float tot = 0.f;
#pragma unroll
                    for (int q = 0; q < 8; ++q) tot += xs4[q * 32 + tid];
                    XR[tid] = __builtin_amdgcn_rsqf(tot * (1.f / DM) + EPS); }
                PG8_WAIT_L(0); PG8_BAR; asm volatile("" ::: "memory");
                y_rg(X, cur, v, XR[wr * 16 + fr_], rai, rm, wr, wc, fr_, fq_);
            }
        }
        if (!has_next) break;
#pragma unroll
        for (int a = 0; a < 2; ++a)
#pragma unroll
            for (int b = 0; b < 2; ++b)
#pragma unroll
                for (int m = 0; m < 4; ++m)
#pragma unroll
                    for (int n = 0; n < 2; ++n) acc[a][b][m][n] = (f32x4){0.f, 0.f, 0.f, 0.f};
        cur = nxt; ++ui;
        if (early) { cA = nA; cB = nB; clA = nlA; clB = nlB; if (wr == 1) PG8_BAR; }
        else { PG8_WAIT_V(0); PG8_BAR; cA = GS_ABASE(cur); cB = GS_BBASE(cur); clA = GS_LDA(cur); clB = GS_LDB(cur); GS_PROLOGUE(); }
    }
    PG8_WAIT_V(0);
    PG8_BAR;
#undef GS_PROLOGUE
#undef GS_LDA
#undef GS_LDB
#undef GS_ABASE
#undef GS_BBASE
#undef PG8_SA
#undef PG8_SB
#undef PG8_STAGE
#undef PG8_LDA
#undef PG8_LDB
#undef PG8_MMA
#undef PG8_WAIT_V
#undef PG8_WAIT_L
#undef PG8_BAR
#undef PG8_SCHED
}
}

#define XB_TMO      128
#define XB_XCNT(j)  (256  + 64 * (j))
#define XB_XSUB(j)  (1280 + 64 * (j))
#define XB_XGEN(j)  (2304 + 64 * (j))
#define XB_TOP      3328
#define XB_TOPGEN   3392
#define XCD_BAR_WORDS 3456
#define XB_SPIN_CAP (1u << 18)
__device__ __forceinline__ unsigned xb_ld(unsigned* p)              { return __hip_atomic_load(p, __ATOMIC_RELAXED, __HIP_MEMORY_SCOPE_AGENT); }
__device__ __forceinline__ unsigned xb_add(unsigned* p, unsigned v) { return __hip_atomic_fetch_add(p, v, __ATOMIC_RELAXED, __HIP_MEMORY_SCOPE_AGENT); }
__device__ __forceinline__ unsigned xb_xcc_id() { return (unsigned)__builtin_amdgcn_s_getreg((3 << 11) | 20) & 0xFu; }
#define XB_SPIN(cond, bar) do { unsigned _sp = 0; while (cond) { __builtin_amdgcn_s_sleep(1); \
    if ((++_sp & 255u) == 0u) { if (xb_ld(&(bar)[XB_TMO])) break; if (_sp > XB_SPIN_CAP) { atomicAdd(&(bar)[XB_TMO], 1u); break; } } } } while (0)
struct XcdBarrier { unsigned* bar; unsigned x; volatile LAS unsigned* st; };
__device__ __forceinline__ XcdBarrier xcd_barrier_post(unsigned* bar, volatile LAS unsigned* st) {
    XcdBarrier b; b.bar = bar; b.x = xb_xcc_id(); b.st = st;
    if (threadIdx.x == 0) (void)xb_add(&bar[XB_XCNT(b.x)], 1u);
    return b;
}
__device__ __forceinline__ void xcd_barrier_complete(unsigned* bar, unsigned x, unsigned& nloc, unsigned& nx) {
    const unsigned G = gridDim.x * gridDim.y * gridDim.z;
    unsigned sum, cnt, mine, sp = 0u;
    for (;;) {
        sum = 0u; cnt = 0u; mine = 0u;
#pragma unroll
        for (unsigned j = 0; j < 16; ++j) { const unsigned c = xb_ld(&bar[XB_XCNT(j)]); sum += c; cnt += (c > 0u) ? 1u : 0u; mine = (j == x) ? c : mine; }
        if (sum == G) break;
        __builtin_amdgcn_s_sleep(1);
        if ((++sp & 255u) == 0u) { if (xb_ld(&bar[XB_TMO])) break; if (sp > XB_SPIN_CAP) { atomicAdd(&bar[XB_TMO], 1u); break; } }
    }
    nloc = mine > 0u ? mine : 1u; nx = cnt > 0u ? cnt : 1u;
}
__device__ __forceinline__ void xcd_barrier(const XcdBarrier& b) {
    asm volatile("s_waitcnt vmcnt(0)" ::: "memory");
    __syncthreads();
    if (threadIdx.x == 0) {
        unsigned* bar = b.bar;
        __builtin_amdgcn_s_waitcnt(0);
        unsigned nloc = b.st[0], nx = b.st[1];
        if (nloc == 0u) { xcd_barrier_complete(bar, b.x, nloc, nx); b.st[0] = nloc; b.st[1] = nx; }
        const unsigned old = xb_add(&bar[XB_XSUB(b.x)], 1u);
        const unsigned gen = old / nloc;
        if (old + 1u == (gen + 1u) * nloc) {
            __builtin_amdgcn_fence(__ATOMIC_RELEASE, "agent");
            asm volatile("s_waitcnt vmcnt(0)" ::: "memory");
            const unsigned og = xb_add(&bar[XB_TOP], 1u);
            const unsigned tg = og / nx;
            if (og + 1u == (tg + 1u) * nx) xb_add(&bar[XB_TOPGEN], 1u);
            else XB_SPIN(xb_ld(&bar[XB_TOPGEN]) == tg, bar);
            __builtin_amdgcn_fence(__ATOMIC_ACQUIRE, "agent");
            xb_add(&bar[XB_XGEN(b.x)], 1u);
            asm volatile("s_waitcnt vmcnt(0)" ::: "memory");
        } else {
            XB_SPIN(xb_ld(&bar[XB_XGEN(b.x)]) == gen, bar);
            __builtin_amdgcn_fence(__ATOMIC_ACQUIRE, "agent");
            asm volatile("s_waitcnt vmcnt(0)" ::: "memory");
        }
    }
    __syncthreads();
}

struct Frame {
    LAS unsigned char* lds;
    volatile LAS unsigned* MISC;
    unsigned* ctl;
    int tid, lane, wave, vcu, G;
    float* out; unsigned char* ws;
    __device__ __forceinline__ const float* inp(int k) const { const LAS unsigned* t = (const LAS unsigned*)(lds + PTAB_OFF) + 2 * k;
        const unsigned lo = __builtin_amdgcn_readfirstlane(t[0]), hi = __builtin_amdgcn_readfirstlane(t[1]); return (const float*)(((unsigned long long)hi << 32) | lo); }
};

template <bool SCALE>
__device__ __forceinline__ void tr_item(const float* W, int ldw, int scol, int ncols, const float* ks, bf16* WT, int ldt, int drow, int k0, LAS float* scr, int lane) {
    const int j = lane & 31, jc = (j < ncols) ? j : 0;
    const float* src = W + (size_t)(k0 + (lane >> 5)) * ldw + scol + jc;
    float v[32];
#pragma unroll
    for (int i = 0; i < 32; ++i) v[i] = src[(size_t)(2 * i) * ldw];
    if (SCALE) {
#pragma unroll
        for (int i = 0; i < 32; ++i) v[i] *= ks[k0 + 2 * i + (lane >> 5)]; }
    const float msk = (j < ncols) ? 1.f : 0.f;
#pragma unroll
    for (int i = 0; i < 32; ++i) scr[(2 * i + (lane >> 5)) * 33 + j] = v[i] * msk;
    LDS_WAIT(); asm volatile("" ::: "memory");
    const int c = lane & 7;
#pragma unroll
    for (int jj = 0; jj < 4; ++jj) { const int n = (lane >> 3) + 8 * jj; const LAS float* s = scr + (8 * c) * 33 + n;
        v4u o; o.x = cvt_pk_bf16(s[0 * 33], s[1 * 33]); o.y = cvt_pk_bf16(s[2 * 33], s[3 * 33]); o.z = cvt_pk_bf16(s[4 * 33], s[5 * 33]); o.w = cvt_pk_bf16(s[6 * 33], s[7 * 33]);
        *(v4u*)(WT + (size_t)(drow + n) * ldt + k0 + 8 * c) = o; }
    LDS_WAIT(); asm volatile("" ::: "memory");
}
__device__ __forceinline__ void p0_prologue(Frame& F, const int part, const int gw, const int NGW) {
    LAS float* scr = (LAS float*)(F.lds + F.wave * 16384);
    const int lane = F.lane;
    constexpr int I_IN = 32 * 360, I_OUT = 32 * 64, I_UP = 32 * 256, I_DN = 128 * 64, I_PL = 4 * 64;
    constexpr int NITEMS = I_IN + I_OUT + I_UP + I_DN + I_PL;
    unsigned char* ws = F.ws;
    for (int it = (part == 0 ? 0 : I_IN) + gw; it < (part == 0 ? I_IN : NITEMS); it += NGW) {
        int r = it;
        if (r < I_IN) { const int kb = r / 360, nb = r % 360, n0 = nb * 32; int scol, nc;
            if (n0 < 4096) { scol = n0; nc = 32; }
            else if (n0 < 8192) { const int t = (n0 - 4096) >> 8, w = (n0 - 4096) & 255; scol = (w < 128) ? 4096 + 128 * t + w : 7184 + 128 * t + (w - 128); nc = 32; }
            else if (n0 < 9216) { scol = 6160 + (n0 - 8192); nc = 32; }
            else if (n0 < 11264) { scol = 9232 + (n0 - 9216); nc = 32; }
            else if (n0 == 11264) { scol = 6144; nc = 16; } else { scol = 0; nc = 0; }
            tr_item<false>(F.inp(5), INW, scol, nc, nullptr, (bf16*)(ws + WS_WIN), DM, n0, kb * 64, scr, lane); continue; } r -= I_IN;
        if (r < I_OUT) { const int kb = r / 64, nb = r % 64; tr_item<false>(F.inp(11), DM, nb * 32, 32, nullptr, (bf16*)(ws + WS_WOUT), DM, nb * 32, kb * 64, scr, lane); continue; } r -= I_OUT;
        if (r < I_UP) { const int kb = r / 256, nb = r % 256; tr_item<true>(F.inp(13), FF, nb * 32, 32, F.inp(12), (bf16*)(ws + WS_WUP), DM, nb * 32, kb * 64, scr, lane); continue; } r -= I_UP;
        if (r < I_DN) { const int kb = r / 64, nb = r % 64; tr_item<false>(F.inp(14), DM, nb * 32, 32, nullptr, (bf16*)(ws + WS_WDN), FF, nb * 32, kb * 64, scr, lane); continue; } r -= I_DN;
        { const int gi = r / 64, q = r % 64, kb = q / 16, nb = q % 16; tr_item<false>(F.inp(9) + (size_t)gi * 256 * 512, 512, nb * 32, 32, nullptr, (bf16*)(ws + WS_WPOOL), 256, gi * 512 + nb * 32, kb * 64, scr, lane); }
    }
    if (part != 0) return;
    f32x4 gv[8];
#pragma unroll
    for (int j = 0; j < 8; ++j) gv[j] = ((const f32x4*)F.inp(4))[64 * j + lane];
    bf16* Hb = (bf16*)(ws + WS_H);
    for (int m = gw; m < M; m += NGW) {
        const float* xrow = (m < NP) ? F.inp(0) + (size_t)m * DM : F.inp(1) + (size_t)(m - NP) * DM;
        const f32x4* xr = (const f32x4*)xrow + lane; f32x4 v[8]; float s = 0.f;
#pragma unroll
        for (int j = 0; j < 8; ++j) { v[j] = xr[64 * j]; s += (v[j][0] * v[j][0] + v[j][1] * v[j][1]) + (v[j][2] * v[j][2] + v[j][3] * v[j][3]); }
        const float rs = __builtin_amdgcn_rsqf(wave_sum(s) * (1.f / DM) + EPS);
        v2u* o8 = (v2u*)(Hb + (size_t)m * DM) + lane;
#pragma unroll
        for (int j = 0; j < 8; ++j) { const f32x4 y = v[j] * rs * gv[j]; v2u w; w.x = cvt_pk_bf16(y[0], y[1]); w.y = cvt_pk_bf16(y[2], y[3]); o8[64 * j] = w; }
    }
}

constexpr int QP = 264;
constexpr int VP = 520;
__device__ __forceinline__ void gla_prep_item(Frame& F, int item) {
    const int c = item >> 2, h = item & 3, tid = F.tid, lane = F.lane, wid = F.wave;
    const bool smp = c >= NCH_P; const int r0 = c * 64;
    unsigned char* ws = F.ws;
    LAS bf16* Qs = (LAS bf16*)F.lds; LAS bf16* Ks = Qs + 64 * QP; LAS float* ALRs = (LAS float*)(F.lds + 67584); LAS float* TOT = (LAS float*)(F.lds + 71680); LAS bf16* Vs = (LAS bf16*)(F.lds + 72704);
    const bf16* Qg = (const bf16*)(ws + WS_Q); const bf16* Kg = (const bf16*)(ws + WS_K); const bf16* Vg = (const bf16*)(ws + WS_V);
#pragma unroll
    for (int j = 0; j < 4; ++j) { const int p = tid + 512 * j, row = p >> 5, c16 = p & 31;
        *(LAS v4u*)(Qs + row * QP + c16 * 8) = *(const v4u*)(Qg + (size_t)(r0 + row) * 1024 + h * 256 + c16 * 8);
        *(LAS v4u*)(Ks + row * QP + c16 * 8) = *(const v4u*)(Kg + (size_t)(r0 + row) * 1024 + h * 256 + c16 * 8); }
    if (tid < 256) *(LAS v4u*)(ALRs + tid * 4) = *(const v4u*)((const float*)(ws + WS_ALR) + (size_t)r0 * 16 + tid * 4);
    if (!smp) {
#pragma unroll
        for (int j = 0; j < 8; ++j) { const int p = tid + 512 * j, row = p >> 6, c16 = p & 63;
            *(LAS v4u*)(Vs + row * VP + c16 * 8) = *(const v4u*)(Vg + (size_t)(r0 + row) * 2048 + h * 512 + c16 * 8); } }
    const int d = tid & 255, half = tid >> 8;
    float wup[16];
#pragma unroll
    for (int j = 0; j < 16; ++j) wup[j] = F.inp(6)[j * 1024 + h * 256 + d];
    const float ba = F.inp(7)[h * 256 + d];
    __syncthreads();
    float bl[32]; float run = 0.f;
#pragma unroll
    for (int i = 0; i < 32; ++i) { const int t = 32 * half + i; float a = ba;
#pragma unroll
        for (int j4 = 0; j4 < 4; ++j4) { const f32x4 al = *(const LAS f32x4*)(ALRs + t * 16 + 4 * j4); a += al[0] * wup[4 * j4] + al[1] * wup[4 * j4 + 1] + al[2] * wup[4 * j4 + 2] + al[3] * wup[4 * j4 + 3]; }
        const float la = (fminf(a, 0.f) - __logf(1.f + __expf(-fabsf(a)))) * 0.0625f;
        if (smp && (i & 7) == 0) run = 0.f;
        run += la; bl[i] = run; }
    if (half == 0) TOT[d] = run;
    __syncthreads();
    if (!smp && half == 1) { const float off = TOT[d];
#pragma unroll
        for (int i = 0; i < 32; ++i) bl[i] += off; }
    unsigned kk[16];
#pragma unroll
    for (int i = 0; i < 32; i += 2) {
        const int t = 32 * half + i;
        const float e0 = __expf(bl[i]), e1 = __expf(bl[i + 1]), n0 = __expf(-bl[i]), n1 = __expf(-bl[i + 1]);
        const float q0 = bf2f(Qs[t * QP + d]) * e0, q1 = bf2f(Qs[(t + 1) * QP + d]) * e1;
        const float k0 = bf2f(Ks[t * QP + d]) * n0, k1 = bf2f(Ks[(t + 1) * QP + d]) * n1;
        const unsigned qp = cvt_pk_bf16(q0, q1), kp = cvt_pk_bf16(k0, k1);
        Qs[t * QP + d] = (bf16)(qp & 0xffffu); Qs[(t + 1) * QP + d] = (bf16)(qp >> 16);
        Ks[t * QP + d] = (bf16)(kp & 0xffffu); Ks[(t + 1) * QP + d] = (bf16)(kp >> 16);
        kk[i >> 1] = kp; }
    { bf16* ktt = (bf16*)(ws + WS_KTT) + ((size_t)(c * 4 + h) * 256 + d) * 64 + 32 * half;
#pragma unroll
        for (int j = 0; j < 4; ++j) *(v4u*)(ktt + 8 * j) = (v4u){kk[4 * j], kk[4 * j + 1], kk[4 * j + 2], kk[4 * j + 3]}; }
    if (!smp) { if (half == 1) ((float*)(ws + WS_EBP))[(size_t)c * 1024 + h * 256 + d] = __expf(bl[31]); }
    else {
#pragma unroll
        for (int j = 0; j < 4; ++j) ((float*)(ws + WS_EBS))[(size_t)((c - NCH_P) * 8 + 4 * half + j) * 1024 + h * 256 + d] = __expf(bl[8 * j + 7]); }
    __syncthreads();
    { bf16* QTg = (bf16*)(ws + WS_QT);
#pragma unroll
        for (int j = 0; j < 4; ++j) { const int p = tid + 512 * j, row = p >> 5, c16 = p & 31;
            *(v4u*)(QTg + (size_t)(r0 + row) * 1024 + h * 256 + c16 * 8) = *(const LAS v4u*)(Qs + row * QP + c16 * 8); } }
    { const int g = lane >> 4, cc = lane & 15, mt = wid >> 1, nt0 = 2 * (wid & 1);
        f32x4 pa[2] = {(f32x4){0.f, 0.f, 0.f, 0.f}, (f32x4){0.f, 0.f, 0.f, 0.f}};
#pragma unroll
        for (int ks = 0; ks < 8; ++ks) { const bf16x8 a = *(const LAS bf16x8*)(Qs + (16 * mt + cc) * QP + 32 * ks + 8 * g);
#pragma unroll
            for (int n = 0; n < 2; ++n) { const bf16x8 b = *(const LAS bf16x8*)(Ks + (16 * (nt0 + n) + cc) * QP + 32 * ks + 8 * g);
                pa[n] = __builtin_amdgcn_mfma_f32_16x16x32_bf16(a, b, pa[n], 0, 0, 0); } }
        bf16* PSg = (bf16*)(ws + WS_PS) + (size_t)(c * 4 + h) * 4096;
#pragma unroll
        for (int n = 0; n < 2; ++n)
#pragma unroll
            for (int r = 0; r < 4; ++r) { const int t = 16 * mt + 4 * g + r, s = 16 * (nt0 + n) + cc; const bool ok = (s <= t) && (!smp || ((s >> 3) == (t >> 3)));
                PSg[t * 64 + s] = (bf16)f2bf(ok ? pa[n][r] : 0.f); } }
    if (!smp) { unsigned vv[32];
#pragma unroll
        for (int s = 0; s < 64; s += 2) vv[s >> 1] = (unsigned)Vs[s * VP + tid] | ((unsigned)Vs[(s + 1) * VP + tid] << 16);
        bf16* vt = (bf16*)(ws + WS_VT) + ((size_t)(c * 4 + h) * 512 + tid) * 64;
#pragma unroll
        for (int j = 0; j < 8; ++j) *(v4u*)(vt + 8 * j) = (v4u){vv[4 * j], vv[4 * j + 1], vv[4 * j + 2], vv[4 * j + 3]}; }
    __syncthreads();
}
__device__ __forceinline__ void pool_prep(Frame& F, const int bi, const int nb) {
    unsigned char* ws = F.ws; const bf16* U = (const bf16*)(ws + WS_U); bf16* PB = (bf16*)(ws + WS_PB); const float* sp = F.inp(3);
    const int gt = bi * 512 + F.tid, NT = nb * 512;
    for (int idx = gt; idx < M * 128; idx += NT) {
        const int row = idx >> 7, cg = idx & 127, ch = cg * 8, w = 2 << (cg >> 5);
        int t, nvalid; const float* hist = sp; float cnt;
        if (row < NP) { t = row & (SEQ - 1); nvalid = (t + 1 < w) ? t + 1 : w; cnt = (float)nvalid; }
        else { const int rs = row - NP; t = rs & 7; nvalid = (t + 1 < w) ? t + 1 : w; cnt = (float)w; hist = sp + (size_t)((rs >> 3) * 15 + 15) * 1024 + ch; }
        v4u xu[16];
#pragma unroll
        for (int i = 0; i < 16; ++i) xu[i] = *(const v4u*)(U + (size_t)(row - (i < nvalid ? i : 0)) * 1024 + ch);
        float acc[8] = {0.f, 0.f, 0.f, 0.f, 0.f, 0.f, 0.f, 0.f};
        if (row >= NP && nvalid < w) {
            for (int i = nvalid; i < w; ++i) { const float* q = hist + (ptrdiff_t)(t - i) * 1024; const f32x4 a = *(const f32x4*)q, bb = *(const f32x4*)(q + 4);
#pragma unroll
                for (int j = 0; j < 4; ++j) { acc[j] += a[j]; acc[4 + j] += bb[j]; } } }
        float u0[8];
#pragma unroll
        for (int i = 0; i < 16; ++i) { const float mk = (i < nvalid) ? 1.f : 0.f; const unsigned xs[4] = {xu[i].x, xu[i].y, xu[i].z, xu[i].w};
#pragma unroll
            for (int j = 0; j < 4; ++j) { const float a = bf2f(xs[j] & 0xffffu), b = bf2f(xs[j] >> 16); acc[2 * j] += a * mk; acc[2 * j + 1] += b * mk; if (i == 0) { u0[2 * j] = a; u0[2 * j + 1] = b; } } }
        const float ic = __builtin_amdgcn_rcpf(cnt); v4u o;
        o.x = cvt_pk_bf16(acc[0] * ic - u0[0], acc[1] * ic - u0[1]); o.y = cvt_pk_bf16(acc[2] * ic - u0[2], acc[3] * ic - u0[3]);
        o.z = cvt_pk_bf16(acc[4] * ic - u0[4], acc[5] * ic - u0[5]); o.w = cvt_pk_bf16(acc[6] * ic - u0[6], acc[7] * ic - u0[7]);
        *(v4u*)(PB + (size_t)row * 1024 + ch) = o;
    }
    float* out = F.out;
    for (int idx = gt; idx < (4 + 128) * 15 * 128; idx += NT) {
        const int cg = idx & 127, rj = idx >> 7, ch = cg * 8; f32x4 a, b; float* dst;
        if (rj < 60) { const int bb = rj / 15, j = rj % 15; const v4u x = *(const v4u*)(U + (size_t)(bb * SEQ + SEQ - 15 + j) * 1024 + ch);
            a = (f32x4){bf2f(x.x & 0xffffu), bf2f(x.x >> 16), bf2f(x.y & 0xffffu), bf2f(x.y >> 16)}; b = (f32x4){bf2f(x.z & 0xffffu), bf2f(x.z >> 16), bf2f(x.w & 0xffffu), bf2f(x.w >> 16)};
            dst = out + OUT_BUFP + (size_t)rj * 1024 + ch; }
        else { const int r2 = rj - 60, bb = r2 / 15, j = r2 % 15;
            if (j < 7) { const float* q = sp + (size_t)(bb * 15 + j + 8) * 1024 + ch; a = *(const f32x4*)q; b = *(const f32x4*)(q + 4); }
            else { const v4u x = *(const v4u*)(U + (size_t)(NP + bb * 8 + j - 7) * 1024 + ch);
                a = (f32x4){bf2f(x.x & 0xffffu), bf2f(x.x >> 16), bf2f(x.y & 0xffffu), bf2f(x.y >> 16)}; b = (f32x4){bf2f(x.z & 0xffffu), bf2f(x.z >> 16), bf2f(x.w & 0xffffu), bf2f(x.w >> 16)}; }
            dst = out + OUT_BUFS + (size_t)r2 * 1024 + ch; }
        *(f32x4*)dst = a; *(f32x4*)(dst + 4) = b;
    }
}

constexpr int KP = 72;
__device__ __forceinline__ void gla_chain(Frame& F, int cb, float* SSQ, const int pvar) {
    int tid_ = F.tid; asm volatile("" : "+v"(tid_));
    const int b = (cb & 15) >> 2, h = cb & 3, vs = cb >> 4, tid = tid_, lane = tid_ & 63, wid = F.wave;
    const int g = lane >> 4, c = lane & 15, dh = wid >> 2, vg = wid & 3, dbase = dh * 128;
    unsigned char* ws = F.ws;
    LAS bf16* Qs = (LAS bf16*)F.lds; LAS bf16* Kt = (LAS bf16*)(F.lds + 33792); LAS bf16* Ps = (LAS bf16*)(F.lds + 70656); LAS bf16* Vt = (LAS bf16*)(F.lds + 79872);
    LAS float* EB = (LAS float*)(F.lds + 98304); LAS float* Ored = (LAS float*)(F.lds + 99328);
    const bf16* QTg = (const bf16*)(ws + WS_QT); const bf16* KTTg = (const bf16*)(ws + WS_KTT); const bf16* PSg = (const bf16*)(ws + WS_PS); const bf16* VTg = (const bf16*)(ws + WS_VT);
    const float* EBg = (const float*)(ws + WS_EBP); bf16* OG = (bf16*)(ws + WS_OG);
    f32x4 S[8][2];
#pragma unroll
    for (int i = 0; i < 8; ++i) { S[i][0] = (f32x4){0.f, 0.f, 0.f, 0.f}; S[i][1] = (f32x4){0.f, 0.f, 0.f, 0.f}; }
    v4u pq[4], pk[4], pp, pv[2]; float pe = 0.f;
    const unsigned t16 = (unsigned)tid * 16u, qoff = (unsigned)(tid >> 5) * 2048u + (unsigned)(tid & 31) * 16u;
    const unsigned lq = (unsigned)(tid >> 5) * (QP * 2) + (unsigned)(tid & 31) * 16u, lk = (unsigned)(tid >> 3) * (KP * 2) + (unsigned)(tid & 7) * 16u;
#define CH_LOAD_A(n) do { const int ci_ = b * 32 + (n); const char* qb_ = (const char*)QTg + ((size_t)ci_ * 65536 + h * 256) * 2; const char* pb_ = (const char*)PSg + (size_t)(ci_ * 4 + h) * 8192; \
        _Pragma("unroll") for (int j = 0; j < 4; ++j) pq[j] = *(const v4u*)(qb_ + j * 32768 + qoff); \
        pp = *(const v4u*)(pb_ + t16); } while (0)
#define CH_LOAD_B(n) do { const int ci_ = b * 32 + (n); const char* kb_ = (const char*)KTTg + (size_t)(ci_ * 4 + h) * 32768; const char* vb_ = (const char*)VTg + ((size_t)(ci_ * 4 + h) * 512 + vs * 128) * 128; \
        _Pragma("unroll") for (int j = 0; j < 4; ++j) pk[j] = *(const v4u*)(kb_ + j * 8192 + t16); \
        _Pragma("unroll") for (int j = 0; j < 2; ++j) pv[j] = *(const v4u*)(vb_ + j * 8192 + t16); \
        if (tid < 256) pe = *(const float*)((const char*)(EBg + (size_t)ci_ * 1024 + h * 256) + (unsigned)tid * 4u); } while (0)
#define CH_LDG(n, grp) do { const int ci_ = b * 32 + (n); const char* qb_ = (const char*)QTg + ((size_t)ci_ * 65536 + h * 256) * 2; const char* pb_ = (const char*)PSg + (size_t)(ci_ * 4 + h) * 8192; \
        const char* kb_ = (const char*)KTTg + (size_t)(ci_ * 4 + h) * 32768; const char* vb_ = (const char*)VTg + ((size_t)(ci_ * 4 + h) * 512 + vs * 128) * 128; \
        if ((grp) == 0) { pq[0] = *(const v4u*)(qb_ + qoff); pq[1] = *(const v4u*)(qb_ + 32768 + qoff); pk[0] = *(const v4u*)(kb_ + t16); } \
        if ((grp) == 1) { pq[2] = *(const v4u*)(qb_ + 2 * 32768 + qoff); pq[3] = *(const v4u*)(qb_ + 3 * 32768 + qoff); pk[1] = *(const v4u*)(kb_ + 8192 + t16); } \
        if ((grp) == 2) { pk[2] = *(const v4u*)(kb_ + 2 * 8192 + t16); pk[3] = *(const v4u*)(kb_ + 3 * 8192 + t16); pp = *(const v4u*)(pb_ + t16); } \
        if ((grp) == 3) { pv[0] = *(const v4u*)(vb_ + t16); pv[1] = *(const v4u*)(vb_ + 8192 + t16); if (tid < 256) pe = *(const float*)((const char*)(EBg + (size_t)ci_ * 1024 + h * 256) + (unsigned)tid * 4u); } \
        asm volatile("" ::: "memory"); } while (0)
#define CH_STORE() do { \
        _Pragma("unroll") for (int j = 0; j < 4; ++j) { *(LAS v4u*)((LAS char*)Qs + j * (16 * QP * 2) + lq) = pq[j]; *(LAS v4u*)((LAS char*)Kt + j * (64 * KP * 2) + lk) = pk[j]; } \
        *(LAS v4u*)((LAS char*)Ps + lk) = pp; \
        _Pragma("unroll") for (int j = 0; j < 2; ++j) *(LAS v4u*)((LAS char*)Vt + j * (64 * KP * 2) + lk) = pv[j]; \
        if (tid < 256) EB[tid] = pe; } while (0)
    CH_LOAD_A(0); CH_LOAD_B(0); CH_STORE(); __syncthreads();
    for (int n = 0; n < 32; ++n) {
        const bool ldn = (n + 1 < 32) && !(pvar & 4);
        if (ldn) CH_LDG(n + 1, 0);
        f32x4 oT[2][4];
#pragma unroll
        for (int vt = 0; vt < 2; ++vt)
#pragma unroll
            for (int tt = 0; tt < 4; ++tt) oT[vt][tt] = (f32x4){0.f, 0.f, 0.f, 0.f};
        {
            bf16x8 qf[4], va[2], pb[4];
#define CH_QLOAD(dst, ks_) do { _Pragma("unroll") for (int tt = 0; tt < 4; ++tt) { const LAS bf16* qp = Qs + (16 * tt + c) * QP + dbase + 32 * (ks_) + 4 * g; \
                const v2u q0 = *(const LAS v2u*)qp, q1 = *(const LAS v2u*)(qp + 16); dst[tt] = __builtin_bit_cast(bf16x8, ((v4u){q0.x, q0.y, q1.x, q1.y})); } } while (0)
#pragma unroll
            for (int ks = 0; ks < 4; ++ks) {
                if (ks == 2 && ldn) CH_LDG(n + 1, 1);
                CH_QLOAD(qf, ks);
                if (ks == 3) {
#pragma unroll
                    for (int vt = 0; vt < 2; ++vt) va[vt] = *(const LAS bf16x8*)(Vt + (32 * vg + 16 * vt + c) * KP + 32 * dh + 8 * g);
#pragma unroll
                    for (int tt = 0; tt < 4; ++tt) pb[tt] = *(const LAS bf16x8*)(Ps + (16 * tt + c) * KP + 32 * dh + 8 * g); }
                bf16x8 sa[2];
#pragma unroll
                for (int vt = 0; vt < 2; ++vt) { const f32x4 lo = S[2 * ks][vt], hi = S[2 * ks + 1][vt];
                    v4u w; w.x = cvt_pk_bf16(lo[0], lo[1]); w.y = cvt_pk_bf16(lo[2], lo[3]); w.z = cvt_pk_bf16(hi[0], hi[1]); w.w = cvt_pk_bf16(hi[2], hi[3]); sa[vt] = __builtin_bit_cast(bf16x8, w); }
#pragma unroll
                for (int tt = 0; tt < 4; ++tt)
#pragma unroll
                    for (int vt = 0; vt < 2; ++vt) oT[vt][tt] = __builtin_amdgcn_mfma_f32_16x16x32_bf16(sa[vt], qf[tt], oT[vt][tt], 0, 0, 0);
            }
#undef CH_QLOAD
#pragma unroll
            for (int tt = 0; tt < 4; ++tt)
#pragma unroll
                for (int vt = 0; vt < 2; ++vt) oT[vt][tt] = __builtin_amdgcn_mfma_f32_16x16x32_bf16(va[vt], pb[tt], oT[vt][tt], 0, 0, 0);
        }
        if (ldn) CH_LDG(n + 1, 2);
        {
#pragma unroll
            for (int vt = 0; vt < 2; ++vt)
#pragma unroll
                for (int t2 = 0; t2 < 2; ++t2) { const int tt = 2 * (1 - dh) + t2;
#pragma unroll
                    for (int r = 0; r < 4; ++r) Ored[((dh * 4 + vg) * 16 + (vt * 2 + t2) * 4 + r) * 64 + lane] = (dh == 0) ? oT[vt][2 + t2][r] : oT[vt][t2][r]; } }
        __syncthreads();
        if (ldn) CH_LDG(n + 1, 3);
        {
            bf16x8 vb[2][2], ka[4];
#define CH_KLOAD(dst, ks_, mg_) do { _Pragma("unroll") for (int q = 0; q < 4; ++q) dst[q] = *(const LAS bf16x8*)(Kt + (dbase + 16 * (4 * (mg_) + q) + c) * KP + 32 * (ks_) + 8 * g); } while (0)
#pragma unroll
            for (int ks = 0; ks < 2; ++ks)
#pragma unroll
                for (int vt = 0; vt < 2; ++vt) vb[ks][vt] = *(const LAS bf16x8*)(Vt + (32 * vg + 16 * vt + c) * KP + 32 * ks + 8 * g);
#pragma unroll
            for (int st = 0; st < 4; ++st) { const int ks = st >> 1, mg = st & 1;
                CH_KLOAD(ka, ks, mg);
#pragma unroll
                for (int q = 0; q < 4; ++q)
#pragma unroll
                    for (int vt = 0; vt < 2; ++vt) S[4 * mg + q][vt] = __builtin_amdgcn_mfma_f32_16x16x32_bf16(ka[q], vb[ks][vt], S[4 * mg + q][vt], 0, 0, 0); }
#undef CH_KLOAD
        }
#pragma unroll
        for (int md = 0; md < 8; ++md) { const f32x4 e = *(const LAS f32x4*)(EB + dbase + 16 * md + 4 * g); S[md][0] *= e; S[md][1] *= e; }
        {
            const int rowb = b * SEQ + n * 64;
            char* ogb = (char*)OG + ((size_t)rowb * 2048 + h * 512 + vs * 128 + 32 * vg) * 2; char* sqb = (char*)(SSQ + (size_t)rowb * 4 + h);
            const unsigned ogl = (unsigned)c * 4096u + (unsigned)g * 8u, sql = (unsigned)c * 16u;
#pragma unroll
            for (int t2 = 0; t2 < 2; ++t2) { float ss = 0.f; const int tt = 2 * dh + t2;
#pragma unroll
                for (int vt = 0; vt < 2; ++vt) { f32x4 o = (dh == 0) ? oT[vt][t2] : oT[vt][2 + t2];
#pragma unroll
                    for (int r = 0; r < 4; ++r) { o[r] += Ored[(((1 - dh) * 4 + vg) * 16 + (vt * 2 + t2) * 4 + r) * 64 + lane]; ss += o[r] * o[r]; }
                    v2u w; w.x = cvt_pk_bf16(o[0], o[1]); w.y = cvt_pk_bf16(o[2], o[3]);
                    *(v2u*)(ogb + tt * 65536 + vt * 32 + ogl) = w; }
                ss += __shfl_xor(ss, 16); ss += __shfl_xor(ss, 32);
                if (g == 0) atomicAdd((float*)(sqb + tt * 256 + sql), ss); } }
        __syncthreads();
        if (n + 1 < 32 && !(pvar & 4)) { CH_STORE(); }
        __syncthreads();
    }
#undef CH_LOAD_A
#undef CH_LOAD_B
#undef CH_STORE
    float* sg = F.out + OUT_SGP + (size_t)(b * 4 + h) * 256 * 512;
#pragma unroll
    for (int md = 0; md < 8; ++md)
#pragma unroll
        for (int vt = 0; vt < 2; ++vt)
#pragma unroll
            for (int r = 0; r < 4; ++r) sg[(size_t)(dbase + 16 * md + 4 * g + r) * 512 + vs * 128 + 32 * vg + 16 * vt + c] = S[md][vt][r];
}
__device__ __forceinline__ void gla_sample_unit(Frame& F, int u, float* SSQ) {
    const int b = u >> 3, h = (u >> 1) & 3, vh = u & 1, tid = F.tid, lane = F.lane, wid = F.wave;
    unsigned char* ws = F.ws;
    const int row0 = NP + b * 8, cs = NCH_P + (b >> 3), si = (b & 7) * 8;
    const float* Sin = F.inp(2) + (size_t)(b * 4 + h) * 256 * 512 + vh * 256 + 4 * lane;
    float* Sout = F.out + OUT_SGS + (size_t)(b * 4 + h) * 256 * 512 + vh * 256 + 4 * lane;
    f32x4 sva[4], svb[4], svc[4];
#define SMP_LOAD(dst, r_) do { _Pragma("unroll") for (int j = 0; j < 4; ++j) dst[j] = __builtin_nontemporal_load((const f32x4*)(Sin + (size_t)(wid + 8 * ((r_) + j)) * 512)); } while (0)
    SMP_LOAD(sva, 0); SMP_LOAD(svb, 4); SMP_LOAD(svc, 8);
    LAS float* QK = (LAS float*)F.lds; LAS float* EBs = (LAS float*)(F.lds + 16384); LAS float* Ored = (LAS float*)(F.lds + 17408);
    { const int d = tid & 255;
        if (tid < 256) { const bf16* qt = (const bf16*)(ws + WS_QT) + (size_t)row0 * 1024 + h * 256 + d; f32x4 a, bq;
#pragma unroll
            for (int t = 0; t < 4; ++t) { a[t] = bf2f(qt[(size_t)t * 1024]); bq[t] = bf2f(qt[(size_t)(t + 4) * 1024]); }
            *(LAS f32x4*)(QK + d * 16) = a; *(LAS f32x4*)(QK + d * 16 + 4) = bq;
            EBs[d] = ((const float*)(ws + WS_EBS))[(size_t)b * 1024 + h * 256 + d]; }
        else { const v4u x = *(const v4u*)((const bf16*)(ws + WS_KTT) + ((size_t)(cs * 4 + h) * 256 + d) * 64 + si);
            *(LAS f32x4*)(QK + d * 16 + 8) = (f32x4){bf2f(x.x & 0xffffu), bf2f(x.x >> 16), bf2f(x.y & 0xffffu), bf2f(x.y >> 16)};
            *(LAS f32x4*)(QK + d * 16 + 12) = (f32x4){bf2f(x.z & 0xffffu), bf2f(x.z >> 16), bf2f(x.w & 0xffffu), bf2f(x.w >> 16)}; } }
    f32x4 v[8], o[8];
    { const bf16* Vg = (const bf16*)(ws + WS_V) + (size_t)row0 * 2048 + h * 512 + vh * 256 + 4 * lane;
#pragma unroll
        for (int s = 0; s < 8; ++s) { const v2u x = *(const v2u*)(Vg + (size_t)s * 2048); v[s] = (f32x4){bf2f(x.x & 0xffffu), bf2f(x.x >> 16), bf2f(x.y & 0xffffu), bf2f(x.y >> 16)}; o[s] = (f32x4){0.f, 0.f, 0.f, 0.f}; } }
    __syncthreads();
#define SMP_COMP(src, r_) do { _Pragma("unroll") for (int j = 0; j < 4; ++j) { const int d = wid + 8 * ((r_) + j); \
            const f32x4 q0 = *(const LAS f32x4*)(QK + d * 16), q1 = *(const LAS f32x4*)(QK + d * 16 + 4), k0 = *(const LAS f32x4*)(QK + d * 16 + 8), k1 = *(const LAS f32x4*)(QK + d * 16 + 12); \
            const float e = EBs[d]; f32x4 sn = src[j]; \
            _Pragma("unroll") for (int s = 0; s < 4; ++s) { sn += v[s] * k0[s]; o[s] += src[j] * q0[s]; } \
            _Pragma("unroll") for (int s = 0; s < 4; ++s) { sn += v[s + 4] * k1[s]; o[s + 4] += src[j] * q1[s]; } \
            __builtin_nontemporal_store(sn * e, (f32x4*)(Sout + (size_t)d * 512)); } } while (0)
    SMP_COMP(sva, 0); SMP_LOAD(sva, 12);
    SMP_COMP(svb, 4); SMP_LOAD(svb, 16);
    SMP_COMP(svc, 8); SMP_LOAD(svc, 20);
    SMP_COMP(sva, 12); SMP_LOAD(sva, 24);
    SMP_COMP(svb, 16); SMP_LOAD(svb, 28);
    SMP_COMP(svc, 20);
    SMP_COMP(sva, 24);
    SMP_COMP(svb, 28);
#undef SMP_LOAD
#undef SMP_COMP
#pragma unroll
    for (int t = 0; t < 8; ++t) *(LAS f32x4*)(Ored + (wid * 8 + t) * 256 + 4 * lane) = o[t];
    __syncthreads();
    { const int t = wid; f32x4 ot = (f32x4){0.f, 0.f, 0.f, 0.f};
#pragma unroll
        for (int w = 0; w < 8; ++w) ot += *(const LAS f32x4*)(Ored + (w * 8 + t) * 256 + 4 * lane);
        const v4u px = *(const v4u*)((const bf16*)(ws + WS_PS) + ((size_t)(cs * 4 + h) * 64 + si + t) * 64 + si);
        const float pr[8] = {bf2f(px.x & 0xffffu), bf2f(px.x >> 16), bf2f(px.y & 0xffffu), bf2f(px.y >> 16), bf2f(px.z & 0xffffu), bf2f(px.z >> 16), bf2f(px.w & 0xffffu), bf2f(px.w >> 16)};
#pragma unroll
        for (int s = 0; s < 8; ++s) ot += v[s] * pr[s];
        v2u w2; w2.x = cvt_pk_bf16(ot[0], ot[1]); w2.y = cvt_pk_bf16(ot[2], ot[3]);
        *(v2u*)((bf16*)(ws + WS_OG) + (size_t)(row0 + t) * 2048 + h * 512 + vh * 256 + 4 * lane) = w2;
        const float ss = wave_sum((ot[0] * ot[0] + ot[1] * ot[1]) + (ot[2] * ot[2] + ot[3] * ot[3]));
        if (lane == 0) atomicAdd(SSQ + (size_t)(row0 + t) * 4 + h, ss); }
    __syncthreads();
}

__device__ __forceinline__ void final_norm(Frame& F, float* dst) {
    const int gw = F.vcu * NWAVES + F.wave, NGW = F.G * NWAVES, lane = F.lane; const float* SSQ2 = (const float*)(F.ctl + CW_SSQ2);
    f32x4 gv[8];
#pragma unroll
    for (int j = 0; j < 8; ++j) gv[j] = ((const f32x4*)F.inp(15))[64 * j + lane];
    for (int m = gw; m < M; m += NGW) { const float rs = __builtin_amdgcn_rsqf(SSQ2[m] * (1.f / DM) + EPS); const f32x4* xr = (const f32x4*)(F.out + OUT_Y + (size_t)m * DM) + lane; f32x4* xw = (f32x4*)(dst + (size_t)m * DM) + lane;
#pragma unroll
        for (int j = 0; j < 8; ++j) xw[64 * j] = xr[64 * j] * rs * gv[j]; }
}

struct Args { const float* in[16]; float* out; unsigned char* ws; int ph_lo, ph_hi; };
__global__ void __launch_bounds__(NWAVES * 64, 2) mk_fwd(Args args) {
    extern __shared__ __attribute__((aligned(16))) unsigned char lds[];
    Frame F;
    F.lds = (LAS unsigned char*)lds; F.MISC = (volatile LAS unsigned*)(F.lds + MISC_OFF);
    F.tid = threadIdx.x; F.lane = F.tid & 63; F.wave = __builtin_amdgcn_readfirstlane(F.tid >> 6);
    F.G = gridDim.x; { const int bx = blockIdx.x; F.vcu = (F.G % 8 == 0) ? (bx % 8) * (F.G / 8) + bx / 8 : bx; }
    F.out = args.out; F.ws = args.ws; F.ctl = (unsigned*)(args.ws + WS_CTL);
    for (int u = F.tid; u < (LDS_BYTES - LDSCTL_OFF) / 4; u += NWAVES * 64) ((LAS unsigned*)(F.lds + LDSCTL_OFF))[u] = 0u;
    __syncthreads();
    if (F.tid < 16) ((LAS unsigned long long*)(F.lds + PTAB_OFF))[F.tid] = (unsigned long long)args.in[F.tid];
    __syncthreads();
    const int lo = args.ph_lo, hi = args.ph_hi;
    const bool use_bar = (hi - lo) > 1;
    XcdBarrier bar; bar.bar = F.ctl + CW_BAR; bar.x = 0; bar.st = nullptr;
    if (use_bar) bar = xcd_barrier_post(F.ctl + CW_BAR, F.MISC + 8);
#define IN(k) (((PHMASK >> (k)) & 1) && lo <= (k) && (k) < hi)
#define SEAM(k) do { if (IN(k) && IN((k) + 1)) xcd_barrier(bar); } while (0)
    unsigned char* ws = args.ws;
    const int bx = (int)blockIdx.x;

#define REPS(k) (((PROBE_MASK >> (k)) & 1) ? 2 : 1)
#define LASTREP(k, r) ((r) == REPS(k) - 1)
#define REPBAR(k, r) do { if (!LASTREP(k, r) && use_bar) xcd_barrier(bar); } while (0)
    float* dummy = (float*)(ws + WS_DUMMY);
    if (IN(0)) for (int r = 0; r < REPS(0); ++r) { p0_prologue(F, 0, F.vcu * NWAVES + F.wave, F.G * NWAVES); REPBAR(0, r); } SEAM(0);
    if (IN(1)) for (int r = 0; r < REPS(1); ++r) { pg8::Gemm g{(const bf16*)(ws + WS_H), (const bf16*)(ws + WS_WIN), DM, DM, DM, 0}; pg8::StaticOrder S; S.init(M, NIN, F.G, bx);
        EpiIn E{ws}; pg8::gemm_phase(F.lds, g, S, E);
        if (LASTREP(1, r)) {
            const int nt_ = (M / 256) * (NIN / 256), full = nt_ / F.G, rem = nt_ - full * F.G;
            __syncthreads();
            if (rem == 0 || rem >= F.G) p0_prologue(F, 1, bx * NWAVES + F.wave, F.G * NWAVES);
            else if (bx >= rem) p0_prologue(F, 1, (bx - rem) * NWAVES + F.wave, (F.G - rem) * NWAVES); }
        REPBAR(1, r); } SEAM(1);
    if (IN(2)) for (int r = 0; r < REPS(2); ++r) { for (int it = bx; it < NCH * 4; it += F.G) gla_prep_item(F, it);
        { const int n3 = NCH * 4 - 2 * F.G;
          if (F.G == 256 && n3 > 0 && n3 < F.G) { if (bx >= n3) pool_prep(F, bx - n3, F.G - n3); } else pool_prep(F, bx, F.G); }
        REPBAR(2, r); } SEAM(2);
    if (IN(3))
#pragma unroll
    for (int r = 0; r < REPS(3); ++r) {
        float* SSQ = LASTREP(3, r) ? (float*)(F.ctl + CW_SSQ) : dummy;
        const int pv = LASTREP(3, r) ? 0 : PROBE_VAR;
        if (!(pv & 2)) {
        if (bx < 64) gla_chain(F, bx, SSQ, pv);
        }
        __syncthreads();
        if (!(pv & 1))
        for (;;) { if (F.tid == 0) F.MISC[0] = atomicAdd(F.ctl + CW_WORK + 64 * r, 1u); __syncthreads(); const int u = (int)F.MISC[0]; __syncthreads(); if (u >= 1024) break; gla_sample_unit(F, u, SSQ); }
        REPBAR(3, r);
    }
    if (IN(3) && IN(5)) xcd_barrier(bar);
    if (IN(5)) { gs::Ctx X{ws, F.inp(0), F.inp(1), F.out, F.ctl, F.inp(8), F.inp(10), F.inp(15)}; gs::gemm_stream(F.lds, X, F.G, bx); }
    if (IN(5) && IN(8) && F.G != 256) xcd_barrier(bar);
    if (IN(8) && F.G != 256) { final_norm(F, F.out + OUT_Y); }
#undef IN
#undef SEAM
#undef REPS
#undef LASTREP
#undef REPBAR
}

extern "C" void kernel_launch(void* const* d_in, const int* in_sizes, int n_in, void* d_out, int out_size, void* d_ws, size_t ws_size, hipStream_t stream) {
    static int grid = 0;
    if (grid == 0) {
        if (n_in != 16 || (size_t)out_size != OUT_END || ws_size < WS_END) { fprintf(stderr, "kernel_launch: unexpected shapes (n_in %d, out %d, ws %zu); nothing launched\n", n_in, out_size, ws_size); grid = -1; return; }
        int dev = 0, cus = 0, per_cu = 0;
        if (hipGetDevice(&dev) != hipSuccess || hipDeviceGetAttribute(&cus, hipDeviceAttributeMultiprocessorCount, dev) != hipSuccess) { grid = -1; return; }
        if (hipFuncSetAttribute((const void*)mk_fwd, hipFuncAttributeMaxDynamicSharedMemorySize, LDS_BYTES) != hipSuccess) { fprintf(stderr, "kernel_launch: hipFuncSetAttribute failed\n"); grid = -1; return; }
        if (hipOccupancyMaxActiveBlocksPerMultiprocessor(&per_cu, (const void*)mk_fwd, NWAVES * 64, LDS_BYTES) != hipSuccess || per_cu < 1) { fprintf(stderr, "kernel_launch: occupancy query says %d blocks per CU; nothing launched\n", per_cu); (void)hipGetLastError(); grid = -1; return; }
        grid = cus;
        if (grid < 72 || grid > 4096) { fprintf(stderr, "kernel_launch: unexpected CU count %d\n", cus); grid = -1; return; }
    }
    if (grid < 0) return;
    (void)hipMemsetAsync((char*)d_ws + WS_CTL, 0, CTL_ZERO_BYTES, stream);
    Args a{};
    for (int i = 0; i < 16; ++i) a.in[i] = (const float*)d_in[i];
    a.out = (float*)d_out; a.ws = (unsigned char*)d_ws;
#if MK_N_LAUNCHES == 1
    a.ph_lo = 0; a.ph_hi = NPHASES;
    hipLaunchKernelGGL(mk_fwd, dim3(grid), dim3(NWAVES * 64), LDS_BYTES, stream, a);
#else
    for (int p = 0; p < NPHASES; ++p) { a.ph_lo = p; a.ph_hi = p + 1; hipLaunchKernelGGL(mk_fwd, dim3(grid), dim3(NWAVES * 64), LDS_BYTES, stream, a); }
#endif
}
```

```cpp
#include <hip/hip_runtime.h>
#include <cstdio>
#include <cstdint>

#ifndef PHMASK
#define PHMASK 0x1ff
#endif
#ifndef PROBE_MASK
#define PROBE_MASK 0
#endif
#ifndef PROBE_VAR
#define PROBE_VAR 0
#endif
#ifndef MK_N_LAUNCHES
#define MK_N_LAUNCHES 1
#endif

#define GAS __attribute__((address_space(1)))
#define LAS __attribute__((address_space(3)))
typedef unsigned short bf16;
typedef unsigned v4u __attribute__((ext_vector_type(4)));
typedef unsigned v2u __attribute__((ext_vector_type(2)));
typedef float f32x4 __attribute__((ext_vector_type(4)));
typedef float f32x2 __attribute__((ext_vector_type(2)));
typedef short bf16x8 __attribute__((ext_vector_type(8)));
typedef GAS unsigned gu32;
#define RLX_AGENT __ATOMIC_RELAXED, __HIP_MEMORY_SCOPE_AGENT
#define LDS_WAIT() asm volatile("s_waitcnt lgkmcnt(0)" ::: "memory")
#define VM_WAIT() asm volatile("s_waitcnt vmcnt(0)" ::: "memory")

constexpr int DM = 2048, NP = 8192, NS = 1024, M = NP + NS;
constexpr int SEQ = 2048, NBS = 128, TS = 8;
constexpr int NH = 4, DK = 256, DV = 512, QW = 1024, VW = 2048, UW = 1024;
constexpr int INW = 11280, NIN = 11520, FF = 8192;
constexpr int NCH_P = 128, NCH = 144;
constexpr float EPS = 1e-6f;
constexpr size_t OUT_Y = 0, OUT_SGP = (size_t)M * DM, OUT_BUFP = OUT_SGP + 4 * 4 * 256 * 512, OUT_SGS = OUT_BUFP + 4 * 15 * 1024, OUT_BUFS = OUT_SGS + (size_t)128 * 4 * 256 * 512, OUT_END = OUT_BUFS + 128 * 15 * 1024;
constexpr size_t MiB = 1u << 20;
constexpr size_t WS_CTL = 0, CTL_ZERO_BYTES = 1 * MiB;
constexpr size_t WS_WPOOL = 1 * MiB, WS_WOUT = 2 * MiB, WS_WUP = 10 * MiB, WS_WDN = 42 * MiB, WS_WIN = 74 * MiB, WS_H = 119 * MiB;
constexpr size_t WS_Q = 155 * MiB, WS_K = 173 * MiB, WS_U = 191 * MiB, WS_V = 209 * MiB, WS_R = 245 * MiB, WS_GA = 281 * MiB, WS_GB = 317 * MiB, WS_ALR = 353 * MiB;
constexpr size_t WS_QT = 354 * MiB, WS_KTT = 372 * MiB, WS_VT = 390 * MiB, WS_PS = 422 * MiB, WS_EBP = 427 * MiB, WS_EBS = 427 * MiB + 512 * 1024;
constexpr size_t WS_PB = 428 * MiB, WS_OB = 446 * MiB, WS_OG = 482 * MiB, WS_MB = 518 * MiB, WS_X1 = 554 * MiB, WS_X1B = 626 * MiB, WS_HID = 662 * MiB, WS_DUMMY = 806 * MiB, WS_XS = 806 * MiB + 512 * 1024, WS_XS4 = 807 * MiB, WS_SLAB = 808 * MiB, WS_END = 872 * MiB;
static_assert(WS_WIN + (size_t)NIN * DM * 2 <= WS_H && WS_H + (size_t)M * DM * 2 <= WS_Q && WS_HID + (size_t)M * FF * 2 <= WS_DUMMY && WS_X1 + (size_t)M * DM * 4 <= WS_X1B, "ws map");
constexpr int CW_TMO = 0, CW_BAR = 4096, CW_WORK = 8192, CW_SSQ = 16384, CW_SSQ1 = 65536, CW_SSQ2 = 81920, CW_CNT5 = 98304, CW_CNT6 = 102400, CW_CNTS = 106496, CW_CNTP = 110592, CW_CNT7 = 114688, CW_CNT8 = 118784;
static_assert(CW_SSQ + M * 4 <= CW_SSQ1 && CW_SSQ1 + M <= CW_SSQ2 && (CW_SSQ2 + M) * 4 <= (int)CTL_ZERO_BYTES, "ctl map");
constexpr int RING_BYTES = 131072, LDSCTL_OFF = 140 * 1024, MISC_OFF = LDSCTL_OFF + 320, PTAB_OFF = LDSCTL_OFF + 1024, LDS_BYTES = 147456;
constexpr int NWAVES = 8;
constexpr int NPHASES = 9;

__device__ __forceinline__ float bf2f(unsigned b) { return __builtin_bit_cast(float, b << 16); }
__device__ __forceinline__ unsigned cvt_pk_bf16(float lo, float hi) { unsigned r; asm volatile("v_cvt_pk_bf16_f32 %0, %1, %2" : "=v"(r) : "v"(lo), "v"(hi)); return r; }
__device__ __forceinline__ unsigned f2bf(float f) { return cvt_pk_bf16(f, 0.f) & 0xffffu; }
__device__ __forceinline__ float wave_sum(float v) {
#pragma unroll
    for (int o = 1; o < 64; o <<= 1) v += __shfl_xor(v, o);
    return v;
}
__device__ __forceinline__ float sigmoidf_(float x) { return __builtin_amdgcn_rcpf(1.f + __expf(-x)); }

namespace pg8 {
constexpr int BM = 256, BK = 64, HALF = 128, HTB = HALF * BK * 2, STAGE_BYTES = 8 * HTB, NXCD = 8, WGM = 8;
__host__ __device__ __forceinline__ int lds_byte(int r, int c) { const int st = (r >> 4) * 2 + (c >> 5), rr = r & 15, cc = c & 31, ob = rr * 64 + cc * 2; return st * 1024 + (ob ^ (((ob >> 9) & 1) << 5)); }
__host__ __device__ __forceinline__ void stage_rc(int b, int& R, int& C) { const int st = b / 1024, sb = b % 1024, swz = sb ^ (((sb >> 9) & 1) << 5); R = (st >> 1) * 16 + swz / 64; C = (st & 1) * 32 + (swz % 64) / 2; }
__host__ __device__ __forceinline__ int perm32(int rho) { const int n = rho >> 4, i = rho & 15; return 8 * (i >> 2) + 4 * n + (i & 3); }

struct Unit { int pm, pn; };
struct Gemm { const bf16* A; const bf16* Bt; int lda, ldb, K, a_div; };

struct StaticOrder {
    int nM, nN, nwg, G, c;
    __device__ void init(int M_, int N_, int G_, int c_) { nM = M_ / BM; nN = N_ / BM; nwg = nM * nN; G = G_; c = c_; }
    __device__ bool next(int i, Unit& u) const {
        const long L = (long)i * G + c; if (c < 0 || L >= nwg) return false;
        int wgid = (int)L; { const int q = nwg / NXCD, r = nwg % NXCD, xcd = wgid % NXCD, off = wgid / NXCD; wgid = (xcd < r ? xcd * (q + 1) : r * (q + 1) + (xcd - r) * q) + off; }
        const int nig = WGM * nN, gid = wgid / nig, fm = gid * WGM, gsz = (nM - fm) < WGM ? (nM - fm) : WGM;
        u.pm = fm + ((wgid % nig) % gsz); u.pn = (wgid % nig) / gsz; return true;
    }
};

template <class Epi, class Sched>
__device__ __forceinline__ void gemm_phase(LAS unsigned char* lds, const Gemm g, const Sched& S, const Epi& E) {
    const int tid = threadIdx.x, wid = __builtin_amdgcn_readfirstlane(tid >> 6), lane = tid & 63, wr = wid >> 2, wc = wid & 3, fr = lane & 15, fq = lane >> 4;
    const int K = g.K, nt = K / BK;
    unsigned voffA[2], voffB[2];
#pragma unroll
    for (int i = 0; i < 2; ++i) { int R, C; stage_rc(tid * 16 + i * 8192, R, C); const int Rb = (R & ~31) + perm32(R & 31);
        voffA[i] = (unsigned)(R * g.lda + C) * 2u; voffB[i] = (unsigned)(Rb * g.ldb + C) * 2u; }
    const size_t kstep = (size_t)(BK * 2);
    const size_t hA = (size_t)HALF * g.lda * 2, hB = (size_t)HALF * g.ldb * 2;
    const unsigned ldsw = (unsigned)wid * 1024u;
    const int aoff = lds_byte(wr * 64 + fr, fq * 8), boff = lds_byte(wc * 32 + fr, fq * 8);
#define PG8_SA(b, h) (((b) * 2 + (h)) * HTB)
#define PG8_SB(b, h) ((4 + (b) * 2 + (h)) * HTB)
#define PG8_STAGE(bufoff, gbase, voff) do { _Pragma("unroll") for (int _i = 0; _i < 2; ++_i) \
        __builtin_amdgcn_global_load_lds((const unsigned*)((const char*)(gbase) + (voff)[_i]), (LAS unsigned*)(lds + (bufoff) + ldsw + _i * 8192), 16, 0, 0); } while (0)
#define PG8_LDA(dst, b, h) do { _Pragma("unroll") for (int m = 0; m < 4; ++m) _Pragma("unroll") for (int k = 0; k < 2; ++k) dst[m][k] = *(const LAS bf16x8*)(lds + PG8_SA(b, h) + aoff + m * 2048 + k * 1024); } while (0)
#define PG8_LDB(dst, b, h) do { _Pragma("unroll") for (int n = 0; n < 2; ++n) _Pragma("unroll") for (int k = 0; k < 2; ++k) dst[n][k] = *(const LAS bf16x8*)(lds + PG8_SB(b, h) + boff + n * 2048 + k * 1024); } while (0)
#define PG8_MMA(ai, bj, At, Bt) do { __builtin_amdgcn_s_setprio(1); _Pragma("unroll") for (int m = 0; m < 4; ++m) _Pragma("unroll") for (int n = 0; n < 2; ++n) _Pragma("unroll") for (int k = 0; k < 2; ++k) \
        acc[ai][bj][m][n] = __builtin_amdgcn_mfma_f32_16x16x32_bf16(Bt[n][k], At[m][k], acc[ai][bj][m][n], 0, 0, 0); __builtin_amdgcn_s_setprio(0); } while (0)
#define PG8_WAIT_V(n) asm volatile("s_waitcnt vmcnt(" #n ")" ::: "memory")
#define PG8_WAIT_L(n) asm volatile("s_waitcnt lgkmcnt(" #n ")" ::: "memory")
#define PG8_BAR __builtin_amdgcn_s_barrier()
#define PG8_SCHED __builtin_amdgcn_sched_barrier(0)
#define PG8_ACOL(u) ((size_t)(g.a_div ? ((u).pn / g.a_div) * K * 2 : 0))
    Unit cur, nxt; int ui = 0;
    if (!S.next(0, cur)) return;
    f32x4 acc[2][2][4][2];
#pragma unroll
    for (int a = 0; a < 2; ++a)
#pragma unroll
        for (int b = 0; b < 2; ++b)
#pragma unroll
            for (int m = 0; m < 4; ++m)
#pragma unroll
                for (int n = 0; n < 2; ++n) acc[a][b][m][n] = (f32x4){0.f, 0.f, 0.f, 0.f};
    bf16x8 At[4][2], B0[2][2], B1[2][2];
    const char* cA = (const char*)g.A + (size_t)cur.pm * 2 * hA + PG8_ACOL(cur); const char* cB = (const char*)g.Bt + (size_t)cur.pn * 2 * hB;
    PG8_STAGE(PG8_SB(0, 0), cB, voffB); PG8_STAGE(PG8_SB(0, 1), cB + hB, voffB); PG8_STAGE(PG8_SA(0, 0), cA, voffA); PG8_STAGE(PG8_SA(0, 1), cA + hA, voffA);
    if (wr == 1) PG8_BAR;
    PG8_WAIT_V(2); PG8_BAR;
    PG8_STAGE(PG8_SB(1, 0), cB + kstep, voffB); PG8_STAGE(PG8_SA(1, 0), cA + kstep, voffA); PG8_STAGE(PG8_SB(1, 1), cB + hB + kstep, voffB);
    PG8_WAIT_V(6); PG8_BAR;
    for (;;) {
        const bool has_next = S.next(ui + 1, nxt);
        const char* nA = has_next ? (const char*)g.A + (size_t)nxt.pm * 2 * hA + PG8_ACOL(nxt) : cA; const char* nB = has_next ? (const char*)g.Bt + (size_t)nxt.pn * 2 * hB : cB;
#pragma unroll 1
        for (int t = 0; t < nt; t += 2) {
            const bool last = (t == nt - 2);
            const char* a1 = cA + (size_t)(t + 1) * kstep;
            const char* a2 = last ? nA : cA + (size_t)(t + 2) * kstep; const char* b2 = last ? nB : cB + (size_t)(t + 2) * kstep;
            const char* a3 = a2 + kstep; const char* b3 = b2 + kstep;
            PG8_LDB(B0, 0, 0); PG8_LDB(B1, 0, 1); PG8_SCHED; PG8_LDA(At, 0, 0); PG8_STAGE(PG8_SA(1, 1), a1 + hA, voffA);
            PG8_WAIT_V(8); PG8_WAIT_L(0); PG8_BAR; PG8_MMA(0, 0, At, B0); PG8_MMA(0, 1, At, B1); PG8_BAR; PG8_SCHED;
            PG8_LDA(At, 0, 1); PG8_STAGE(PG8_SB(0, 0), b2, voffB); PG8_STAGE(PG8_SB(0, 1), b2 + hB, voffB); PG8_STAGE(PG8_SA(0, 0), a2, voffA);
            PG8_WAIT_V(8); PG8_WAIT_L(0); PG8_BAR; PG8_MMA(1, 0, At, B0); PG8_MMA(1, 1, At, B1); PG8_BAR; PG8_SCHED;
            PG8_LDB(B0, 1, 0); PG8_LDB(B1, 1, 1); PG8_SCHED; PG8_LDA(At, 1, 0); PG8_STAGE(PG8_SA(0, 1), a2 + hA, voffA);
            PG8_WAIT_V(8); PG8_WAIT_L(0); PG8_BAR; PG8_MMA(0, 0, At, B0); PG8_MMA(0, 1, At, B1); PG8_BAR; PG8_SCHED;
            PG8_LDA(At, 1, 1); PG8_STAGE(PG8_SB(1, 0), b3, voffB); PG8_STAGE(PG8_SB(1, 1), b3 + hB, voffB); PG8_STAGE(PG8_SA(1, 0), a3, voffA);
            PG8_WAIT_V(8); PG8_WAIT_L(0); PG8_BAR; PG8_MMA(1, 0, At, B0); PG8_MMA(1, 1, At, B1); PG8_BAR; PG8_SCHED;
        }
        if (wr == 0) PG8_BAR;
        E(acc, cur, wr, wc, fr, fq);
        if (!has_next) break;
#pragma unroll
        for (int a = 0; a < 2; ++a)
#pragma unroll
            for (int b = 0; b < 2; ++b)
#pragma unroll
                for (int m = 0; m < 4; ++m)
#pragma unroll
                    for (int n = 0; n < 2; ++n) acc[a][b][m][n] = (f32x4){0.f, 0.f, 0.f, 0.f};
        cur = nxt; cA = nA; cB = nB; ++ui;
        if (wr == 1) PG8_BAR;
    }
    PG8_WAIT_V(0);
    PG8_BAR;
#undef PG8_SA
#undef PG8_SB
#undef PG8_STAGE
#undef PG8_LDA
#undef PG8_LDB
#undef PG8_MMA
#undef PG8_WAIT_V
#undef PG8_WAIT_L
#undef PG8_BAR
#undef PG8_SCHED
#undef PG8_ACOL
}
}

using pg8::Unit;
__device__ __forceinline__ void st_bf16x8(bf16* p, f32x4 v0, f32x4 v1) { v4u w; w.x = cvt_pk_bf16(v0[0], v0[1]); w.y = cvt_pk_bf16(v0[2], v0[3]); w.z = cvt_pk_bf16(v1[0], v1[1]); w.w = cvt_pk_bf16(v1[2], v1[3]); *(v4u*)p = w; }

struct EpiIn {
    unsigned char* ws;
    __device__ __forceinline__ void operator()(const f32x4 (&acc)[2][2][4][2], const Unit& u, int wr, int wc, int fr, int fq) const {
        const int pn = u.pn; const int row0 = u.pm * 256 + wr * 64 + fr;
        if (pn == 44) {
            if (wc == 0 && fq < 2) { float* alr = (float*)(ws + WS_ALR);
#pragma unroll
                for (int ai = 0; ai < 2; ++ai)
#pragma unroll
                    for (int m = 0; m < 4; ++m) { float* rp = alr + (size_t)(row0 + ai * 128 + m * 16) * 16 + 8 * fq;
                        *(f32x4*)rp = acc[ai][0][m][0]; *(f32x4*)(rp + 4) = acc[ai][0][m][1]; } }
            return;
        }
        if (pn >= 16 && pn < 32) {
            bf16* G = (bf16*)(ws + WS_R); const int col0 = (pn - 16) * 128 + wc * 32 + 8 * fq;
#pragma unroll
            for (int ai = 0; ai < 2; ++ai)
#pragma unroll
                for (int m = 0; m < 4; ++m) { f32x4 g0, g1;
#pragma unroll
                    for (int j = 0; j < 4; ++j) { const float r0 = acc[ai][0][m][0][j], r1 = acc[ai][0][m][1][j], a0 = acc[ai][1][m][0][j], a1 = acc[ai][1][m][1][j];
                        g0[j] = r0 * sigmoidf_(r0) * sigmoidf_(a0); g1[j] = r1 * sigmoidf_(r1) * sigmoidf_(a1); }
                    st_bf16x8(G + (size_t)(row0 + ai * 128 + m * 16) * 2048 + col0, g0, g1); }
            return;
        }
        bf16* base; int ldc, ct; float sc = 1.f;
        if (pn < 4) { base = (bf16*)(ws + WS_Q); ldc = 1024; ct = pn; sc = 0.0625f; }
        else if (pn < 8) { base = (bf16*)(ws + WS_K); ldc = 1024; ct = pn - 4; }
        else if (pn < 16) { base = (bf16*)(ws + WS_V); ldc = 2048; ct = pn - 8; }
        else if (pn < 36) { base = (bf16*)(ws + WS_U); ldc = 1024; ct = pn - 32; }
        else { base = (bf16*)(ws + WS_GB); ldc = 2048; ct = pn - 36; }
        const int col0 = ct * 256 + wc * 32 + 8 * fq;
#pragma unroll
        for (int ai = 0; ai < 2; ++ai)
#pragma unroll
            for (int m = 0; m < 4; ++m) { bf16* rowp = base + (size_t)(row0 + ai * 128 + m * 16) * ldc + col0;
#pragma unroll
                for (int bj = 0; bj < 2; ++bj) st_bf16x8(rowp + bj * 128, acc[ai][bj][m][0] * sc, acc[ai][bj][m][1] * sc); }
    }
};
namespace gs {
using namespace pg8;
struct SUnit { int st, pm, pn, kt0, nkt, r, s, late; };
__device__ __forceinline__ bool su_next(int i, int G, int c, SUnit& u) {
    int st = 0, pm = 0, pn = 0, kt0 = 0, nkt = 32, r = 0, sp = 0, late = 0;
    if (G != 256) {
        const long LL = (long)i * G + c; if (LL >= 288 + 288 + 1152 + 288) return false;
        const int L = (int)LL; late = 1;
        if (L < 288) { st = 0; nkt = 4; pm = L >> 3; pn = L & 7; }
        else if (L < 576) { st = 1; pm = (L - 288) >> 3; pn = (L - 288) & 7; }
        else if (L < 1728) { st = 2; pm = (L - 576) >> 5; pn = (L - 576) & 31; }
        else { st = 3; nkt = 128; pm = (L - 1728) >> 3; pn = (L - 1728) & 7; }
    } else {
        const int ty = (c < 160) ? 0 : (c < 192 ? 1 : 2);
        const int last = (ty == 2) ? 7 : 8;
        if (i > last) return false;
        if (i <= 1) { const int x = c & 7, y = c >> 3; st = i; nkt = (i == 0) ? 4 : 32; late = i; pm = 8 * (x >> 1) + (y & 7); pn = 4 * (x & 1) + (y >> 3); }
        else if (i == last) { st = 4; const int x = c & 7; int y;
            if (ty == 2) { const int k = (c - 192) >> 3; y = k >> 1; sp = k & 1; } else if (ty == 1) { y = (c - 160) >> 3; sp = 2; } else { const int k = c >> 3; y = k / 5; sp = 3 + (k - 5 * y); }
            pm = 32 + y; pn = x; r = y * 8 + x;
            kt0 = (sp < 2) ? 22 * sp : (sp == 2 ? 44 : 58 + 14 * (sp - 3)); nkt = (sp < 2) ? 22 : 14; }
        else if (i == last - 1) { st = 3; nkt = 128; const int rank = (ty == 2) ? c - 192 : (ty == 1 ? c - 160 : c), P2 = (ty == 2) ? 4 : (ty == 1 ? 2 : 10), pm0 = (ty == 2) ? 0 : (ty == 1 ? 8 : 12);
            const int x = rank & 7, k = rank >> 3; pn = 2 * (x & 3) + (k & 1); pm = pm0 + (x >> 2) * P2 + (k >> 1); late = (pm >= 24) ? 1 : 0; }
        else if (ty == 1 && i <= 3) { st = i - 2; nkt = (i == 2) ? 4 : 32; late = i - 2; pm = 32 + ((c - 160) >> 3); pn = c & 7; }
        else { st = 2; int j2;
            if (i == 2) { j2 = (ty == 0) ? c : 160 + (c - 192); late = 1; } else if (i == 3) j2 = 224 + ((ty == 0) ? c : 160 + (c - 192)); else j2 = 448 + 256 * (i - 4) + c;
            const int rd = j2 >> 8, jr = j2 & 255, x = jr & 7, y = jr >> 3;
            pm = (rd < 4) ? 8 * rd + (y & 7) : 32 + (y & 3); pn = (rd < 4) ? 4 * x + (y >> 3) : 4 * x + (y >> 2); }
    }
    u.st = st; u.pm = pm; u.pn = pn; u.kt0 = kt0; u.nkt = nkt; u.r = r; u.s = sp; u.late = late;
    return true;
}
struct Ctx { unsigned char* ws; const float* xp; const float* xs; float* out; unsigned* ctl; const float* gn; const float* pscale; const float* gfin; };
__device__ __forceinline__ void st16_wt(__amdgpu_buffer_rsrc_t rs, unsigned off, v4u v) { __builtin_amdgcn_raw_buffer_store_b128(v, rs, off, 0, 16); }
__device__ __forceinline__ void st16_pl(__amdgpu_buffer_rsrc_t rs, unsigned off, v4u v) { __builtin_amdgcn_raw_buffer_store_b128(v, rs, off, 0, 0); }
#define ST16(X_, rs, off, v) st16_wt(rs, off, v)
__device__ __forceinline__ v4u pk8(f32x4 v0, f32x4 v1) { v4u w; w.x = cvt_pk_bf16(v0[0], v0[1]); w.y = cvt_pk_bf16(v0[2], v0[3]); w.z = cvt_pk_bf16(v1[0], v1[1]); w.w = cvt_pk_bf16(v1[2], v1[3]); return w; }
__device__ __forceinline__ float epi_rg(const Ctx& X, const SUnit& u, const f32x4 (&v)[2][2], int ai, int m, int wr, int wc, int fr, int fq) {
    const int row = u.pm * 256 + ai * 128 + wr * 64 + m * 16 + fr, col0 = u.pn * 256 + wc * 32 + 8 * fq;
    if (u.st == 0) {
        const float rs = __builtin_amdgcn_rsqf(((const float*)(X.ctl + CW_SSQ))[row * 4 + (u.pn >> 1)] * (1.f / DV) + EPS);
        const __amdgpu_buffer_rsrc_t rm = __builtin_amdgcn_make_buffer_rsrc((void*)(X.ws + WS_MB), (short)0, (int)((size_t)M * DM * 2), 0x00020000);
        const bf16* OG = (const bf16*)(X.ws + WS_OG); const bf16* Gt = (const bf16*)(X.ws + WS_R); const bf16* GB = (const bf16*)(X.ws + WS_GB);
#pragma unroll
        for (int bj = 0; bj < 2; ++bj) { const size_t o2 = (size_t)row * DM + col0 + bj * 128; const int cc = col0 + bj * 128;
            const v4u xo = *(const v4u*)(OG + o2), xg = *(const v4u*)(Gt + o2), xb = *(const v4u*)(GB + o2);
            const f32x4 n0 = *(const f32x4*)(X.gn + (cc & 511)), n1 = *(const f32x4*)(X.gn + (cc & 511) + 4), p0 = *(const f32x4*)(X.pscale + cc), p1 = *(const f32x4*)(X.pscale + cc + 4);
            const unsigned ao[4] = {xo.x, xo.y, xo.z, xo.w}, ag[4] = {xg.x, xg.y, xg.z, xg.w}, ab[4] = {xb.x, xb.y, xb.z, xb.w};
            f32x4 r0, r1;
#pragma unroll
            for (int j = 0; j < 2; ++j) {
                r0[2 * j] = bf2f(ag[j] & 0xffffu) * (bf2f(ao[j] & 0xffffu) * rs * n0[2 * j]) + sigmoidf_(bf2f(ab[j] & 0xffffu)) * (v[bj][0][2 * j] * p0[2 * j]);
                r0[2 * j + 1] = bf2f(ag[j] >> 16) * (bf2f(ao[j] >> 16) * rs * n0[2 * j + 1]) + sigmoidf_(bf2f(ab[j] >> 16)) * (v[bj][0][2 * j + 1] * p0[2 * j + 1]);
                r1[2 * j] = bf2f(ag[2 + j] & 0xffffu) * (bf2f(ao[2 + j] & 0xffffu) * rs * n1[2 * j]) + sigmoidf_(bf2f(ab[2 + j] & 0xffffu)) * (v[bj][1][2 * j] * p1[2 * j]);
                r1[2 * j + 1] = bf2f(ag[2 + j] >> 16) * (bf2f(ao[2 + j] >> 16) * rs * n1[2 * j + 1]) + sigmoidf_(bf2f(ab[2 + j] >> 16)) * (v[bj][1][2 * j + 1] * p1[2 * j + 1]); }
            ST16(X, rm, (unsigned)(o2 * 2), pk8(r0, r1)); }
        return 0.f;
    }
    if (u.st == 2) {
        const float rs = __builtin_amdgcn_rsqf(((const float*)(X.ctl + CW_SSQ1))[row] * (1.f / DM) + EPS);
        const __amdgpu_buffer_rsrc_t rh = __builtin_amdgcn_make_buffer_rsrc((void*)(X.ws + WS_HID), (short)0, (int)((size_t)M * FF * 2), 0x00020000);
#pragma unroll
        for (int bj = 0; bj < 2; ++bj) { f32x4 v0 = v[bj][0] * rs, v1 = v[bj][1] * rs;
#pragma unroll
            for (int j = 0; j < 4; ++j) { const float a = fmaxf(v0[j], 0.f), b = fmaxf(v1[j], 0.f); v0[j] = a * a; v1[j] = b * b; }
            ST16(X, rh, (unsigned)(((size_t)row * FF + col0 + bj * 128) * 2), pk8(v0, v1)); }
        return 0.f;
    }
    const size_t off = (size_t)row * DM + col0; float ss = 0.f;
    if (u.st == 1) {
        const float* xin = (row < NP) ? X.xp : X.xs - (size_t)NP * DM;
        const __amdgpu_buffer_rsrc_t rb = __builtin_amdgcn_make_buffer_rsrc((void*)(X.ws + WS_X1B), (short)0, (int)((size_t)M * DM * 2), 0x00020000);
#pragma unroll
        for (int bj = 0; bj < 2; ++bj) { const f32x4 a0 = *(const f32x4*)(xin + off + bj * 128), a1 = *(const f32x4*)(xin + off + bj * 128 + 4);
            const f32x4 v0 = a0 + v[bj][0], v1 = a1 + v[bj][1];
            ST16(X, rb, (unsigned)((off + bj * 128) * 2), pk8(v0, v1));
            ss += (v0[0] * v0[0] + v0[1] * v0[1]) + (v0[2] * v0[2] + v0[3] * v0[3]) + (v1[0] * v1[0] + v1[1] * v1[1]) + (v1[2] * v1[2] + v1[3] * v1[3]); }
        ss += __shfl_xor(ss, 16); ss += __shfl_xor(ss, 32);
        float old = 0.f; if (fq == 0) old = atomicAdd((float*)(X.ctl + CW_SSQ1) + row, ss);
        return old;
    } else {
        const bf16* x1 = (const bf16*)(X.ws + WS_X1B); float* xo = X.out + OUT_Y;
#pragma unroll
        for (int bj = 0; bj < 2; ++bj) { const v4u xa = *(const v4u*)(x1 + off + bj * 128);
            const f32x4 a0 = (f32x4){bf2f(xa.x & 0xffffu), bf2f(xa.x >> 16), bf2f(xa.y & 0xffffu), bf2f(xa.y >> 16)}, a1 = (f32x4){bf2f(xa.z & 0xffffu), bf2f(xa.z >> 16), bf2f(xa.w & 0xffffu), bf2f(xa.w >> 16)};
            const f32x4 v0 = a0 + v[bj][0], v1 = a1 + v[bj][1];
            *(f32x4*)(xo + off + bj * 128) = v0; *(f32x4*)(xo + off + bj * 128 + 4) = v1;
            ss += (v0[0] * v0[0] + v0[1] * v0[1]) + (v0[2] * v0[2] + v0[3] * v0[3]) + (v1[0] * v1[0] + v1[1] * v1[1]) + (v1[2] * v1[2] + v1[3] * v1[3]); }
        ss += __shfl_xor(ss, 16); ss += __shfl_xor(ss, 32);
        if (fq == 0) atomicAdd((float*)(X.ctl + CW_SSQ2) + row, ss);
    }
    return 0.f;
}
__device__ __forceinline__ void wait_count(unsigned* word, unsigned need, unsigned* tmo) {
    if (threadIdx.x < 64) {
        unsigned polls = 0;
        while ((unsigned)__builtin_amdgcn_readfirstlane(__hip_atomic_load(word, __ATOMIC_RELAXED, __HIP_MEMORY_SCOPE_AGENT)) < need) {
            if ((++polls & 1023u) == 0u) { if (__builtin_amdgcn_readfirstlane(__hip_atomic_load(tmo, __ATOMIC_RELAXED, __HIP_MEMORY_SCOPE_AGENT)) != 0u) break;
                if (polls > (1u << 22)) { if (threadIdx.x == 0) __hip_atomic_store(tmo, 1u, __ATOMIC_RELAXED, __HIP_MEMORY_SCOPE_AGENT); break; } }
            __builtin_amdgcn_s_sleep(2); }
        __builtin_amdgcn_fence(__ATOMIC_ACQUIRE, "agent");
        asm volatile("s_waitcnt vmcnt(0)" ::: "memory");
    }
    asm volatile("" ::: "memory"); __builtin_amdgcn_s_barrier(); asm volatile("" ::: "memory");
}
__device__ __forceinline__ void a_ready(const Ctx& X, const SUnit& u) {
    if (u.st == 0) return;
    unsigned* w = X.ctl + (u.st == 1 ? CW_CNTP : (u.st == 2 ? CW_CNT5 : CW_CNT6)) + 64 * u.pm;
    wait_count(w, u.st >= 3 ? 256u : 64u, X.ctl + CW_TMO);
}
__device__ __forceinline__ void epi2_comp(const Ctx& X, const SUnit& u, const f32x4 (&v)[2][2], float ssq, int ai, int m, int wr, int wc, int fr, int fq) {
    const int row = u.pm * 256 + ai * 128 + wr * 64 + m * 16 + fr, col0 = u.pn * 256 + wc * 32 + 8 * fq;
    const float rs = __builtin_amdgcn_rsqf(ssq * (1.f / DM) + EPS);
    const __amdgpu_buffer_rsrc_t rh = __builtin_amdgcn_make_buffer_rsrc((void*)(X.ws + WS_HID), (short)0, (int)((size_t)M * FF * 2), 0x00020000);
#pragma unroll
    for (int bj = 0; bj < 2; ++bj) { f32x4 v0 = v[bj][0] * rs, v1 = v[bj][1] * rs;
#pragma unroll
        for (int j = 0; j < 4; ++j) { const float a = fmaxf(v0[j], 0.f), b = fmaxf(v1[j], 0.f); v0[j] = a * a; v1[j] = b * b; }
        ST16(X, rh, (unsigned)(((size_t)row * FF + col0 + bj * 128) * 2), pk8(v0, v1)); }
}
typedef const __attribute__((address_space(1))) f32x4* gptr4;
__device__ __forceinline__ void epi0_comp(const Ctx& X, const SUnit& u, const f32x4 (&v)[2][2], float ssq, const f32x4 (&nv)[2][2], const f32x4 (&pv)[2][2], int ai, int m, int wr, int wc, int fr, int fq) {
    const int row = u.pm * 256 + ai * 128 + wr * 64 + m * 16 + fr, col0 = u.pn * 256 + wc * 32 + 8 * fq;
    const float rs = __builtin_amdgcn_rsqf(ssq * (1.f / DV) + EPS);
    const __amdgpu_buffer_rsrc_t rm = __builtin_amdgcn_make_buffer_rsrc((void*)(X.ws + WS_MB), (short)0, (int)((size_t)M * DM * 2), 0x00020000);
    const bf16* OG = (const bf16*)(X.ws + WS_OG); const bf16* Gt = (const bf16*)(X.ws + WS_R); const bf16* GB = (const bf16*)(X.ws + WS_GB);
    v4u xo[2], xg[2], xb[2];
#pragma unroll
    for (int bj = 0; bj < 2; ++bj) { const size_t o2 = (size_t)row * DM + col0 + bj * 128; xo[bj] = *(const v4u*)(OG + o2); xg[bj] = *(const v4u*)(Gt + o2); xb[bj] = *(const v4u*)(GB + o2); }
#pragma unroll
    for (int bj = 0; bj < 2; ++bj) { const size_t o2 = (size_t)row * DM + col0 + bj * 128;
        const unsigned ao[4] = {xo[bj].x, xo[bj].y, xo[bj].z, xo[bj].w}, ag[4] = {xg[bj].x, xg[bj].y, xg[bj].z, xg[bj].w}, ab[4] = {xb[bj].x, xb[bj].y, xb[bj].z, xb[bj].w};
        const f32x4 n0 = nv[bj][0] * rs, n1 = nv[bj][1] * rs, p0 = pv[bj][0], p1 = pv[bj][1];
        f32x4 r0, r1;
#pragma unroll
        for (int j = 0; j < 2; ++j) {
            r0[2 * j] = bf2f(ag[j] & 0xffffu) * (bf2f(ao[j] & 0xffffu) * n0[2 * j]) + sigmoidf_(bf2f(ab[j] & 0xffffu)) * (v[bj][0][2 * j] * p0[2 * j]);
            r0[2 * j + 1] = bf2f(ag[j] >> 16) * (bf2f(ao[j] >> 16) * n0[2 * j + 1]) + sigmoidf_(bf2f(ab[j] >> 16)) * (v[bj][0][2 * j + 1] * p0[2 * j + 1]);
            r1[2 * j] = bf2f(ag[2 + j] & 0xffffu) * (bf2f(ao[2 + j] & 0xffffu) * n1[2 * j]) + sigmoidf_(bf2f(ab[2 + j] & 0xffffu)) * (v[bj][1][2 * j] * p1[2 * j]);
            r1[2 * j + 1] = bf2f(ag[2 + j] >> 16) * (bf2f(ao[2 + j] >> 16) * n1[2 * j + 1]) + sigmoidf_(bf2f(ab[2 + j] >> 16)) * (v[bj][1][2 * j + 1] * p1[2 * j + 1]); }
        ST16(X, rm, (unsigned)(o2 * 2), pk8(r0, r1)); }
}
__device__ __forceinline__ void epi1_load(const Ctx& X, const SUnit& u, int ai, int m, int wr, int wc, int fr, int fq, f32x4 (&xa)[4]) {
    const int row = u.pm * 256 + ai * 128 + wr * 64 + m * 16 + fr, col0 = u.pn * 256 + wc * 32 + 8 * fq;
    const float* xin = ((row < NP) ? X.xp : X.xs - (size_t)NP * DM) + (size_t)row * DM + col0;
    xa[0] = *(const f32x4*)(xin); xa[1] = *(const f32x4*)(xin + 4); xa[2] = *(const f32x4*)(xin + 128); xa[3] = *(const f32x4*)(xin + 132);
}
__device__ __forceinline__ float epi1_comp(const Ctx& X, const SUnit& u, const f32x4 (&v)[2][2], const f32x4 (&xa)[4], int ai, int m, int wr, int wc, int fr, int fq) {
    const int row = u.pm * 256 + ai * 128 + wr * 64 + m * 16 + fr, col0 = u.pn * 256 + wc * 32 + 8 * fq;
    const size_t off = (size_t)row * DM + col0; float ss = 0.f;
    const __amdgpu_buffer_rsrc_t rb = __builtin_amdgcn_make_buffer_rsrc((void*)(X.ws + WS_X1B), (short)0, (int)((size_t)M * DM * 2), 0x00020000);
#pragma unroll
    for (int bj = 0; bj < 2; ++bj) { const f32x4 v0 = xa[2 * bj] + v[bj][0], v1 = xa[2 * bj + 1] + v[bj][1];
        ST16(X, rb, (unsigned)((off + bj * 128) * 2), pk8(v0, v1));
        ss += (v0[0] * v0[0] + v0[1] * v0[1]) + (v0[2] * v0[2] + v0[3] * v0[3]) + (v1[0] * v1[0] + v1[1] * v1[1]) + (v1[2] * v1[2] + v1[3] * v1[3]); }
    ss += __shfl_xor(ss, 16); ss += __shfl_xor(ss, 32);
    float old = 0.f; if (fq == 0) old = atomicAdd((float*)(X.ctl + CW_SSQ1) + row, ss);
    return old;
}
__device__ __forceinline__ void x1_load(const Ctx& X, const SUnit& u, int ai, int m, int wr, int wc, int fr, int fq, v4u (&xa)[2]) {
    const int row = u.pm * 256 + ai * 128 + wr * 64 + m * 16 + fr, col0 = u.pn * 256 + wc * 32 + 8 * fq;
    const bf16* x1 = (const bf16*)(X.ws + WS_X1B) + (size_t)row * DM + col0; xa[0] = *(const v4u*)x1; xa[1] = *(const v4u*)(x1 + 128);
}
__device__ __forceinline__ float x2_rg(f32x4 (&v)[2][2], const v4u (&xr)[2]) {
    float ss = 0.f;
#pragma unroll
    for (int bj = 0; bj < 2; ++bj) { const v4u xa = xr[bj];
        v[bj][0] += (f32x4){bf2f(xa.x & 0xffffu), bf2f(xa.x >> 16), bf2f(xa.y & 0xffffu), bf2f(xa.y >> 16)}; v[bj][1] += (f32x4){bf2f(xa.z & 0xffffu), bf2f(xa.z >> 16), bf2f(xa.w & 0xffffu), bf2f(xa.w >> 16)};
        const f32x4 v0 = v[bj][0], v1 = v[bj][1];
        ss += (v0[0] * v0[0] + v0[1] * v0[1]) + (v0[2] * v0[2] + v0[3] * v0[3]) + (v1[0] * v1[0] + v1[1] * v1[1]) + (v1[2] * v1[2] + v1[3] * v1[3]); }
    ss += __shfl_xor(ss, 16); ss += __shfl_xor(ss, 32);
    return ss;
}
__device__ __forceinline__ void y_rg(const Ctx& X, const SUnit& u, const f32x4 (&v)[2][2], float rstd, int ai, int m, int wr, int wc, int fr, int fq) {
    const int row = u.pm * 256 + ai * 128 + wr * 64 + m * 16 + fr, col0 = u.pn * 256 + wc * 32 + 8 * fq;
    float* yo = X.out + OUT_Y + (size_t)row * DM + col0;
#pragma unroll
    for (int bj = 0; bj < 2; ++bj) { const f32x4 g0 = *(gptr4)(X.gfin + col0 + bj * 128), g1 = *(gptr4)(X.gfin + col0 + bj * 128 + 4);
        *(f32x4*)(yo + bj * 128) = v[bj][0] * rstd * g0; *(f32x4*)(yo + bj * 128 + 4) = v[bj][1] * rstd * g1; }
}
__device__ __forceinline__ void gemm_stream(LAS unsigned char* lds, const Ctx X, const int G, const int c) {
    const int tid = threadIdx.x, wid = __builtin_amdgcn_readfirstlane(tid >> 6), lane = tid & 63, wr = wid >> 2, wc = wid & 3, fr = lane & 15, fq = lane >> 4;
    unsigned RA2[2], RB2[2], C2[2];
#pragma unroll
    for (int i = 0; i < 2; ++i) { int R, C; stage_rc(tid * 16 + i * 8192, R, C); RA2[i] = (unsigned)R * 2u; RB2[i] = (unsigned)((R & ~31) + perm32(R & 31)) * 2u; C2[i] = (unsigned)C * 2u; }
    const size_t kstep = (size_t)(BK * 2);
    const unsigned ldsw = (unsigned)wid * 1024u;
    const int aoff = lds_byte(wr * 64 + fr, fq * 8), boff = lds_byte(wc * 32 + fr, fq * 8);
#define GS_LDA(u) ((u).st == 0 ? 1024 : ((u).st >= 3 ? FF : DM))
#define GS_LDB(u) ((u).st == 0 ? 256 : ((u).st >= 3 ? FF : DM))
#define GS_ABASE(u) ((const char*)X.ws + ((u).st == 0 ? WS_PB : ((u).st == 1 ? WS_MB : ((u).st == 2 ? WS_X1B : WS_HID))) + ((size_t)(u).pm * 256 * GS_LDA(u) + (size_t)(u).kt0 * BK + ((u).st == 0 ? ((u).pn >> 1) * 256 : 0)) * 2)
#define GS_BBASE(u) ((const char*)X.ws + ((u).st == 0 ? WS_WPOOL : ((u).st == 1 ? WS_WOUT : ((u).st == 2 ? WS_WUP : WS_WDN))) + ((size_t)(u).pn * 256 * GS_LDB(u) + (size_t)(u).kt0 * BK) * 2)
#define PG8_SA(b, h) (((b) * 2 + (h)) * HTB)
#define PG8_SB(b, h) ((4 + (b) * 2 + (h)) * HTB)
#define PG8_STAGE(bufoff, gbase, R2, ld) do { _Pragma("unroll") for (int _i = 0; _i < 2; ++_i) \
        __builtin_amdgcn_global_load_lds((const unsigned*)((const char*)(gbase) + ((R2)[_i] * (unsigned)(ld) + C2[_i])), (LAS unsigned*)(lds + (bufoff) + ldsw + _i * 8192), 16, 0, 0); } while (0)
#define PG8_LDA(dst, b, h) do { _Pragma("unroll") for (int m = 0; m < 4; ++m) _Pragma("unroll") for (int k = 0; k < 2; ++k) dst[m][k] = *(const LAS bf16x8*)(lds + PG8_SA(b, h) + aoff + m * 2048 + k * 1024); } while (0)
#define PG8_LDB(dst, b, h) do { _Pragma("unroll") for (int n = 0; n < 2; ++n) _Pragma("unroll") for (int k = 0; k < 2; ++k) dst[n][k] = *(const LAS bf16x8*)(lds + PG8_SB(b, h) + boff + n * 2048 + k * 1024); } while (0)
#define PG8_MMA(ai, bj, At, Bt) do { __builtin_amdgcn_s_setprio(1); _Pragma("unroll") for (int m = 0; m < 4; ++m) _Pragma("unroll") for (int n = 0; n < 2; ++n) _Pragma("unroll") for (int k = 0; k < 2; ++k) \
        acc[ai][bj][m][n] = __builtin_amdgcn_mfma_f32_16x16x32_bf16(Bt[n][k], At[m][k], acc[ai][bj][m][n], 0, 0, 0); __builtin_amdgcn_s_setprio(0); } while (0)
#define PG8_WAIT_V(n) asm volatile("s_waitcnt vmcnt(" #n ")" ::: "memory")
#define PG8_WAIT_L(n) asm volatile("s_waitcnt lgkmcnt(" #n ")" ::: "memory")
#define PG8_BAR __builtin_amdgcn_s_barrier()
#define PG8_SCHED __builtin_amdgcn_sched_barrier(0)
    SUnit cur, nxt; int ui = 0, pend = -1;
    if (!su_next(0, G, c, cur)) return;
    f32x4 acc[2][2][4][2];
#pragma unroll
    for (int a = 0; a < 2; ++a)
#pragma unroll
        for (int b = 0; b < 2; ++b)
#pragma unroll
            for (int m = 0; m < 4; ++m)
#pragma unroll
                for (int n = 0; n < 2; ++n) acc[a][b][m][n] = (f32x4){0.f, 0.f, 0.f, 0.f};
    bf16x8 At[4][2], B0[2][2], B1[2][2];
    const char* cA = GS_ABASE(cur); const char* cB = GS_BBASE(cur); int clA = GS_LDA(cur), clB = GS_LDB(cur);
#define GS_PROLOGUE() do { a_ready(X, cur); const size_t hA_ = (size_t)HALF * clA * 2, hB_ = (size_t)HALF * clB * 2; \
    PG8_STAGE(PG8_SB(0, 0), cB, RB2, clB); PG8_STAGE(PG8_SB(0, 1), cB + hB_, RB2, clB); PG8_STAGE(PG8_SA(0, 0), cA, RA2, clA); PG8_STAGE(PG8_SA(0, 1), cA + hA_, RA2, clA); \
    if (wr == 1) PG8_BAR; \
    PG8_WAIT_V(2); PG8_BAR; \
    PG8_STAGE(PG8_SB(1, 0), cB + kstep, RB2, clB); PG8_STAGE(PG8_SA(1, 0), cA + kstep, RA2, clA); PG8_STAGE(PG8_SB(1, 1), cB + hB_ + kstep, RB2, clB); \
    PG8_WAIT_V(6); PG8_BAR; } while (0)
    GS_PROLOGUE();
    for (;;) {
        const bool has_next = su_next(ui + 1, G, c, nxt);
        const bool early = has_next && !nxt.late;
        const char* nA = early ? GS_ABASE(nxt) : cA; const char* nB = early ? GS_BBASE(nxt) : cB; const int nlA = early ? GS_LDA(nxt) : clA, nlB = early ? GS_LDB(nxt) : clB;
        const int nt = cur.nkt; const size_t hA = (size_t)HALF * clA * 2;
#pragma unroll 1
        for (int t = 0; t < nt; t += 2) {
            const bool last = (t == nt - 2);
            const char* a1 = cA + (size_t)(t + 1) * kstep;
            const char* a2 = last ? nA : cA + (size_t)(t + 2) * kstep; const char* b2 = last ? nB : cB + (size_t)(t + 2) * kstep;
            const char* a3 = a2 + kstep; const char* b3 = b2 + kstep;
            const int lA2 = last ? nlA : clA, lB2 = last ? nlB : clB; const size_t hA2 = (size_t)HALF * lA2 * 2, hB2 = (size_t)HALF * lB2 * 2;
            if (last && early) a_ready(X, nxt);
            PG8_LDB(B0, 0, 0); PG8_LDB(B1, 0, 1); PG8_SCHED; PG8_LDA(At, 0, 0); PG8_STAGE(PG8_SA(1, 1), a1 + hA, RA2, clA);
            PG8_WAIT_V(8); PG8_WAIT_L(0); PG8_BAR; PG8_MMA(0, 0, At, B0); PG8_MMA(0, 1, At, B1); PG8_BAR; PG8_SCHED;
            PG8_LDA(At, 0, 1); PG8_STAGE(PG8_SB(0, 0), b2, RB2, lB2); PG8_STAGE(PG8_SB(0, 1), b2 + hB2, RB2, lB2); PG8_STAGE(PG8_SA(0, 0), a2, RA2, lA2);
            PG8_WAIT_V(8); PG8_WAIT_L(0); PG8_BAR; PG8_MMA(1, 0, At, B0); PG8_MMA(1, 1, At, B1); PG8_BAR; PG8_SCHED;
            PG8_LDB(B0, 1, 0); PG8_LDB(B1, 1, 1); PG8_SCHED; PG8_LDA(At, 1, 0); PG8_STAGE(PG8_SA(0, 1), a2 + hA2, RA2, lA2);
            PG8_WAIT_V(8); PG8_WAIT_L(0); PG8_BAR; PG8_MMA(0, 0, At, B0); PG8_MMA(0, 1, At, B1); PG8_BAR; PG8_SCHED;
            PG8_LDA(At, 1, 1); PG8_STAGE(PG8_SB(1, 0), b3, RB2, lB2); PG8_STAGE(PG8_SB(1, 1), b3 + hB2, RB2, lB2); PG8_STAGE(PG8_SA(1, 0), a3, RA2, lA2);
            PG8_WAIT_V(8); PG8_WAIT_L(0); PG8_BAR; PG8_MMA(1, 0, At, B0); PG8_MMA(1, 1, At, B1);
            if (pend >= 0) { PG8_WAIT_V(0); if (lane == 0) __hip_atomic_fetch_add(X.ctl + pend, 1u, __ATOMIC_RELAXED, __HIP_MEMORY_SCOPE_AGENT); pend = -1; }
            PG8_BAR; PG8_SCHED;
        }
        if (wr == 0) PG8_BAR;
        int fr_ = fr, fq_ = fq; asm volatile("" : "+v"(fr_), "+v"(fq_));
        if (cur.st == 3 && G == 256) {
            LAS float* XP = (LAS float*)(lds + STAGE_BYTES); LAS float* XR = XP + 1024;
            { v4u xr[2][2]; x1_load(X, cur, 0, 0, wr, wc, fr_, fq_, xr[0]);
#pragma unroll
            for (int k = 0; k < 8; ++k) { const int ai = k >> 2, m = k & 3;
                    if (k < 7) x1_load(X, cur, (k + 1) >> 2, (k + 1) & 3, wr, wc, fr_, fq_, xr[(k + 1) & 1]);
                    f32x4 v[2][2] = {{acc[ai][0][m][0], acc[ai][0][m][1]}, {acc[ai][1][m][0], acc[ai][1][m][1]}};
                    const float ss = x2_rg(v, xr[k & 1]);
                    acc[ai][0][m][0] = v[0][0]; acc[ai][0][m][1] = v[0][1]; acc[ai][1][m][0] = v[1][0]; acc[ai][1][m][1] = v[1][1];
                    if (fq_ == 0) XP[(ai * 128 + wr * 64 + m * 16 + fr_) * 4 + wc] = ss; } }
            PG8_WAIT_L(0); PG8_BAR; asm volatile("" ::: "memory");
            float* xs_ = (float*)(X.ws + WS_XS) + (size_t)cur.pm * 2048;
            if (tid < 256) { const f32x4 p4 = *(const LAS f32x4*)(XP + tid * 4); __hip_atomic_store(xs_ + cur.pn * 256 + tid, (p4[0] + p4[1]) + (p4[2] + p4[3]), __ATOMIC_RELAXED, __HIP_MEMORY_SCOPE_AGENT);
                asm volatile("s_waitcnt vmcnt(0)" ::: "memory");
                if (lane == 0) __hip_atomic_fetch_add(X.ctl + CW_CNT7 + 64 * cur.pm, 1u, __ATOMIC_RELAXED, __HIP_MEMORY_SCOPE_AGENT); }
            wait_count(X.ctl + CW_CNT7 + 64 * cur.pm, 32u, X.ctl + CW_TMO);
            if (tid < 256) { float tot = 0.f;
#pragma unroll
                for (int q = 0; q < 8; ++q) tot += xs_[q * 256 + tid];
                XR[tid] = __builtin_amdgcn_rsqf(tot * (1.f / DM) + EPS); }
            PG8_WAIT_L(0); PG8_BAR; asm volatile("" ::: "memory");
#pragma unroll
            for (int ai = 0; ai < 2; ++ai)
#pragma unroll
                for (int m = 0; m < 4; ++m) { const f32x4 v[2][2] = {{acc[ai][0][m][0], acc[ai][0][m][1]}, {acc[ai][1][m][0], acc[ai][1][m][1]}};
                    y_rg(X, cur, v, XR[ai * 128 + wr * 64 + m * 16 + fr_], ai, m, wr, wc, fr_, fq_); asm volatile("" ::: "memory"); }
            PG8_WAIT_L(0); PG8_BAR; asm volatile("" ::: "memory");
        } else if (cur.st != 4) { float olds[8];
            if (cur.st == 1) { f32x4 xa[2][4]; epi1_load(X, cur, 0, 0, wr, wc, fr_, fq_, xa[0]);
#pragma unroll
                for (int k = 0; k < 8; ++k) { const int ai = k >> 2, m = k & 3;
                    if (k < 7) epi1_load(X, cur, (k + 1) >> 2, (k + 1) & 3, wr, wc, fr_, fq_, xa[(k + 1) & 1]);
                    const f32x4 v[2][2] = {{acc[ai][0][m][0], acc[ai][0][m][1]}, {acc[ai][1][m][0], acc[ai][1][m][1]}}; olds[k] = epi1_comp(X, cur, v, xa[k & 1], ai, m, wr, wc, fr_, fq_); }
                asm volatile("" :: "v"(olds[0]), "v"(olds[1]), "v"(olds[2]), "v"(olds[3]), "v"(olds[4]), "v"(olds[5]), "v"(olds[6]), "v"(olds[7]));
            } else if (cur.st == 2) { float sq[8];
#pragma unroll
                for (int k = 0; k < 8; ++k) sq[k] = ((const float*)(X.ctl + CW_SSQ1))[cur.pm * 256 + (k >> 2) * 128 + wr * 64 + (k & 3) * 16 + fr_];
#pragma unroll
                for (int k = 0; k < 8; ++k) { const int ai = k >> 2, m = k & 3;
                    const f32x4 v[2][2] = {{acc[ai][0][m][0], acc[ai][0][m][1]}, {acc[ai][1][m][0], acc[ai][1][m][1]}}; epi2_comp(X, cur, v, sq[k], ai, m, wr, wc, fr_, fq_); }
            } else if (cur.st == 0) { float sq[8]; f32x4 nv[2][2], pv[2][2];
                { const int cc = cur.pn * 256 + wc * 32 + 8 * fq_;
#pragma unroll
                for (int bj = 0; bj < 2; ++bj) { nv[bj][0] = *(gptr4)(X.gn + ((cc + bj * 128) & 511)); nv[bj][1] = *(gptr4)(X.gn + ((cc + bj * 128) & 511) + 4); pv[bj][0] = *(gptr4)(X.pscale + cc + bj * 128); pv[bj][1] = *(gptr4)(X.pscale + cc + bj * 128 + 4); } }
#pragma unroll
                for (int k = 0; k < 8; ++k) sq[k] = ((const float*)(X.ctl + CW_SSQ))[(cur.pm * 256 + (k >> 2) * 128 + wr * 64 + (k & 3) * 16 + fr_) * 4 + (cur.pn >> 1)];
#pragma unroll
                for (int k = 0; k < 8; ++k) { const int ai = k >> 2, m = k & 3;
                    const f32x4 v[2][2] = {{acc[ai][0][m][0], acc[ai][0][m][1]}, {acc[ai][1][m][0], acc[ai][1][m][1]}}; epi0_comp(X, cur, v, sq[k], nv, pv, ai, m, wr, wc, fr_, fq_); }
            } else {
#pragma unroll
            for (int ai = 0; ai < 2; ++ai)
#pragma unroll
                for (int m = 0; m < 4; ++m) { const f32x4 v[2][2] = {{acc[ai][0][m][0], acc[ai][0][m][1]}, {acc[ai][1][m][0], acc[ai][1][m][1]}}; olds[ai * 4 + m] = epi_rg(X, cur, v, ai, m, wr, wc, fr_, fq_); }
            }
            if (cur.st < 3) {
                const int widx = (cur.st == 0 ? CW_CNTP : (cur.st == 1 ? CW_CNT5 : CW_CNT6)) + 64 * cur.pm;
                if (early) pend = widx;
                else { asm volatile("s_waitcnt vmcnt(0)" ::: "memory"); if (lane == 0) __hip_atomic_fetch_add(X.ctl + widx, 1u, __ATOMIC_RELAXED, __HIP_MEMORY_SCOPE_AGENT); } }
        } else {
            const __amdgpu_buffer_rsrc_t rsl = __builtin_amdgcn_make_buffer_rsrc((void*)(X.ws + WS_SLAB + (size_t)(cur.r * 8 + cur.s) * 131072), (short)0, 131072, 0x00020000);
#pragma unroll
            for (int ai = 0; ai < 2; ++ai)
#pragma unroll
                for (int bj = 0; bj < 2; ++bj)
#pragma unroll
                    for (int m = 0; m < 4; ++m) st16_wt(rsl, (unsigned)((((ai * 2 + bj) * 4 + m)) * 8192 + tid * 16), pk8(acc[ai][bj][m][0], acc[ai][bj][m][1]));
            asm volatile("s_waitcnt vmcnt(0)" ::: "memory");
            if (lane == 0) __hip_atomic_fetch_add(X.ctl + CW_CNTS + 64 * cur.r, 1u, __ATOMIC_RELAXED, __HIP_MEMORY_SCOPE_AGENT);
            wait_count(X.ctl + CW_CNTS + 64 * cur.r, 64u, X.ctl + CW_TMO);
            const int rai = cur.s >> 2, rm = cur.s & 3;
            f32x4 v[2][2] = {{(f32x4){0.f, 0.f, 0.f, 0.f}, (f32x4){0.f, 0.f, 0.f, 0.f}}, {(f32x4){0.f, 0.f, 0.f, 0.f}, (f32x4){0.f, 0.f, 0.f, 0.f}}};
            const char* sb = (const char*)(X.ws + WS_SLAB) + (size_t)cur.r * 8 * 131072 + (size_t)((rai * 2) * 4 + rm) * 8192 + (size_t)tid * 16;
#pragma unroll
            for (int p = 0; p < 8; ++p)
#pragma unroll
                for (int bj = 0; bj < 2; ++bj) { const v4u x = *(const v4u*)(sb + (size_t)p * 131072 + (size_t)(bj * 4) * 8192);
                    v[bj][0] += (f32x4){bf2f(x.x & 0xffffu), bf2f(x.x >> 16), bf2f(x.y & 0xffffu), bf2f(x.y >> 16)};
                    v[bj][1] += (f32x4){bf2f(x.z & 0xffffu), bf2f(x.z >> 16), bf2f(x.w & 0xffffu), bf2f(x.w >> 16)}; }
            if (G != 256) (void)epi_rg(X, cur, v, rai, rm, wr, wc, fr_, fq_);
            else {
                LAS float* XP = (LAS float*)(lds + STAGE_BYTES); LAS float* XR = XP + 1024;
                v4u xr4[2]; x1_load(X, cur, rai, rm, wr, wc, fr_, fq_, xr4); const float ss = x2_rg(v, xr4);
                if (fq_ == 0) XP[(wr * 16 + fr_) * 4 + wc] = ss;
                PG8_WAIT_L(0); PG8_BAR; asm volatile("" ::: "memory");
                const int gi = (cur.pm - 32) * 8 + cur.s; float* xs4 = (float*)(X.ws + WS_XS4) + (size_t)gi * 256;
                if (tid < 32) { const f32x4 p4 = *(const LAS f32x4*)(XP + tid * 4); __hip_atomic_store(xs4 + cur.pn * 32 + tid, (p4[0] + p4[1]) + (p4[2] + p4[3]), __ATOMIC_RELAXED, __HIP_MEMORY_SCOPE_AGENT);
                    asm volatile("s_waitcnt vmcnt(0)" ::: "memory");
                    if (lane == 0) __hip_atomic_fetch_add(X.ctl + CW_CNT8 + 64 * gi, 1u, __ATOMIC_RELAXED, __HIP_MEMORY_SCOPE_AGENT); }
                wait_count(X.ctl + CW_CNT8 + 64 * gi, 8u, X.ctl + CW_TMO);
                if (tid < 32) { float tot = 0.f;
#pragma unroll
                    for (int q = 0; q < 8; ++q) tot += xs4[q * 32 + tid];
                    XR[tid] = __builtin_amdgcn_rsqf(tot * (1.f / DM) + EPS); }
                PG8_WAIT_L(0); PG8_BAR; asm volatile("" ::: "memory");
                y_rg(X, cur, v, XR[wr * 16 + fr_], rai, rm, wr, wc, fr_, fq_);
            }
        }
        if (!has_next) break;
#pragma unroll
        for (int a = 0; a < 2; ++a)
#pragma unroll
            for (int b = 0; b < 2; ++b)
#pragma unroll
                for (int m = 0; m < 4; ++m)
#pragma unroll
                    for (int n = 0; n < 2; ++n) acc[a][b][m][n] = (f32x4){0.f, 0.f, 0.f, 0.f};
        cur = nxt; ++ui;
        if (early) { cA = nA; cB = nB; clA = nlA; clB = nlB; if (wr == 1) PG8_BAR; }
        else { PG8_WAIT_V(0); PG8_BAR; cA = GS_ABASE(cur); cB = GS_BBASE(cur); clA = GS_LDA(cur); clB = GS_LDB(cur); GS_PROLOGUE(); }
    }
    PG8_WAIT_V(0);
    PG8_BAR;
#undef GS_PROLOGUE
#undef GS_LDA
#undef GS_LDB
#undef GS_ABASE
#undef GS_BBASE
#undef PG8_SA
#undef PG8_SB
#undef PG8_STAGE
#undef PG8_LDA
#undef PG8_LDB
#undef PG8_MMA
#undef PG8_WAIT_V
#undef PG8_WAIT_L
#undef PG8_BAR
#undef PG8_SCHED
}
}

#define XB_TMO      128
#define XB_XCNT(j)  (256  + 64 * (j))
#define XB_XSUB(j)  (1280 + 64 * (j))
#define XB_XGEN(j)  (2304 + 64 * (j))
#define XB_TOP      3328
#define XB_TOPGEN   3392
#define XCD_BAR_WORDS 3456
#define XB_SPIN_CAP (1u << 18)
__device__ __forceinline__ unsigned xb_ld(unsigned* p)              { return __hip_atomic_load(p, __ATOMIC_RELAXED, __HIP_MEMORY_SCOPE_AGENT); }
__device__ __forceinline__ unsigned xb_add(unsigned* p, unsigned v) { return __hip_atomic_fetch_add(p, v, __ATOMIC_RELAXED, __HIP_MEMORY_SCOPE_AGENT); }
__device__ __forceinline__ unsigned xb_xcc_id() { return (unsigned)__builtin_amdgcn_s_getreg((3 << 11) | 20) & 0xFu; }
#define XB_SPIN(cond, bar) do { unsigned _sp = 0; while (cond) { __builtin_amdgcn_s_sleep(1); \
    if ((++_sp & 255u) == 0u) { if (xb_ld(&(bar)[XB_TMO])) break; if (_sp > XB_SPIN_CAP) { atomicAdd(&(bar)[XB_TMO], 1u); break; } } } } while (0)
struct XcdBarrier { unsigned* bar; unsigned x; volatile LAS unsigned* st; };
__device__ __forceinline__ XcdBarrier xcd_barrier_post(unsigned* bar, volatile LAS unsigned* st) {
    XcdBarrier b; b.bar = bar; b.x = xb_xcc_id(); b.st = st;
    if (threadIdx.x == 0) (void)xb_add(&bar[XB_XCNT(b.x)], 1u);
    return b;
}
__device__ __forceinline__ void xcd_barrier_complete(unsigned* bar, unsigned x, unsigned& nloc, unsigned& nx) {
    const unsigned G = gridDim.x * gridDim.y * gridDim.z;
    unsigned sum, cnt, mine, sp = 0u;
    for (;;) {
        sum = 0u; cnt = 0u; mine = 0u;
#pragma unroll
        for (unsigned j = 0; j < 16; ++j) { const unsigned c = xb_ld(&bar[XB_XCNT(j)]); sum += c; cnt += (c > 0u) ? 1u : 0u; mine = (j == x) ? c : mine; }
        if (sum == G) break;
        __builtin_amdgcn_s_sleep(1);
        if ((++sp & 255u) == 0u) { if (xb_ld(&bar[XB_TMO])) break; if (sp > XB_SPIN_CAP) { atomicAdd(&bar[XB_TMO], 1u); break; } }
    }
    nloc = mine > 0u ? mine : 1u; nx = cnt > 0u ? cnt : 1u;
}
__device__ __forceinline__ void xcd_barrier(const XcdBarrier& b) {
    asm volatile("s_waitcnt vmcnt(0)" ::: "memory");
    __syncthreads();
    if (threadIdx.x == 0) {
        unsigned* bar = b.bar;
        __builtin_amdgcn_s_waitcnt(0);
        unsigned nloc = b.st[0], nx = b.st[1];
        if (nloc == 0u) { xcd_barrier_complete(bar, b.x, nloc, nx); b.st[0] = nloc; b.st[1] = nx; }
        const unsigned old = xb_add(&bar[XB_XSUB(b.x)], 1u);
        const unsigned gen = old / nloc;
        if (old + 1u == (gen + 1u) * nloc) {
            __builtin_amdgcn_fence(__ATOMIC_RELEASE, "agent");
            asm volatile("s_waitcnt vmcnt(0)" ::: "memory");
            const unsigned og = xb_add(&bar[XB_TOP], 1u);
            const unsigned tg = og / nx;
            if (og + 1u == (tg + 1u) * nx) xb_add(&bar[XB_TOPGEN], 1u);
            else XB_SPIN(xb_ld(&bar[XB_TOPGEN]) == tg, bar);
            __builtin_amdgcn_fence(__ATOMIC_ACQUIRE, "agent");
            xb_add(&bar[XB_XGEN(b.x)], 1u);
            asm volatile("s_waitcnt vmcnt(0)" ::: "memory");
        } else {
            XB_SPIN(xb_ld(&bar[XB_XGEN(b.x)]) == gen, bar);
            __builtin_amdgcn_fence(__ATOMIC_ACQUIRE, "agent");
            asm volatile("s_waitcnt vmcnt(0)" ::: "memory");
        }
    }
    __syncthreads();
}

struct Frame {
    LAS unsigned char* lds;
    volatile LAS unsigned* MISC;
    unsigned* ctl;
    int tid, lane, wave, vcu, G;
    float* out; unsigned char* ws;
    __device__ __forceinline__ const float* inp(int k) const { const LAS unsigned* t = (const LAS unsigned*)(lds + PTAB_OFF) + 2 * k;
        const unsigned lo = __builtin_amdgcn_readfirstlane(t[0]), hi = __builtin_amdgcn_readfirstlane(t[1]); return (const float*)(((unsigned long long)hi << 32) | lo); }
};

template <bool SCALE>
__device__ __forceinline__ void tr_item(const float* W, int ldw, int scol, int ncols, const float* ks, bf16* WT, int ldt, int drow, int k0, LAS float* scr, int lane) {
    const int j = lane & 31, jc = (j < ncols) ? j : 0;
    const float* src = W + (size_t)(k0 + (lane >> 5)) * ldw + scol + jc;
    float v[32];
#pragma unroll
    for (int i = 0; i < 32; ++i) v[i] = src[(size_t)(2 * i) * ldw];
    if (SCALE) {
#pragma unroll
        for (int i = 0; i < 32; ++i) v[i] *= ks[k0 + 2 * i + (lane >> 5)]; }
    const float msk = (j < ncols) ? 1.f : 0.f;
#pragma unroll
    for (int i = 0; i < 32; ++i) scr[(2 * i + (lane >> 5)) * 33 + j] = v[i] * msk;
    LDS_WAIT(); asm volatile("" ::: "memory");
    const int c = lane & 7;
#pragma unroll
    for (int jj = 0; jj < 4; ++jj) { const int n = (lane >> 3) + 8 * jj; const LAS float* s = scr + (8 * c) * 33 + n;
        v4u o; o.x = cvt_pk_bf16(s[0 * 33], s[1 * 33]); o.y = cvt_pk_bf16(s[2 * 33], s[3 * 33]); o.z = cvt_pk_bf16(s[4 * 33], s[5 * 33]); o.w = cvt_pk_bf16(s[6 * 33], s[7 * 33]);
        *(v4u*)(WT + (size_t)(drow + n) * ldt + k0 + 8 * c) = o; }
    LDS_WAIT(); asm volatile("" ::: "memory");
}
__device__ __forceinline__ void p0_prologue(Frame& F, const int part, const int gw, const int NGW) {
    LAS float* scr = (LAS float*)(F.lds + F.wave * 16384);
    const int lane = F.lane;
    constexpr int I_IN = 32 * 360, I_OUT = 32 * 64, I_UP = 32 * 256, I_DN = 128 * 64, I_PL = 4 * 64;
    constexpr int NITEMS = I_IN + I_OUT + I_UP + I_DN + I_PL;
    unsigned char* ws = F.ws;
    for (int it = (part == 0 ? 0 : I_IN) + gw; it < (part == 0 ? I_IN : NITEMS); it += NGW) {
        int r = it;
        if (r < I_IN) { const int kb = r / 360, nb = r % 360, n0 = nb * 32; int scol, nc;
            if (n0 < 4096) { scol = n0; nc = 32; }
            else if (n0 < 8192) { const int t = (n0 - 4096) >> 8, w = (n0 - 4096) & 255; scol = (w < 128) ? 4096 + 128 * t + w : 7184 + 128 * t + (w - 128); nc = 32; }
            else if (n0 < 9216) { scol = 6160 + (n0 - 8192); nc = 32; }
            else if (n0 < 11264) { scol = 9232 + (n0 - 9216); nc = 32; }
            else if (n0 == 11264) { scol = 6144; nc = 16; } else { scol = 0; nc = 0; }
            tr_item<false>(F.inp(5), INW, scol, nc, nullptr, (bf16*)(ws + WS_WIN), DM, n0, kb * 64, scr, lane); continue; } r -= I_IN;
        if (r < I_OUT) { const int kb = r / 64, nb = r % 64; tr_item<false>(F.inp(11), DM, nb * 32, 32, nullptr, (bf16*)(ws + WS_WOUT), DM, nb * 32, kb * 64, scr, lane); continue; } r -= I_OUT;
        if (r < I_UP) { const int kb = r / 256, nb = r % 256; tr_item<true>(F.inp(13), FF, nb * 32, 32, F.inp(12), (bf16*)(ws + WS_WUP), DM, nb * 32, kb * 64, scr, lane); continue; } r -= I_UP;
        if (r < I_DN) { const int kb = r / 64, nb = r % 64; tr_item<false>(F.inp(14), DM, nb * 32, 32, nullptr, (bf16*)(ws + WS_WDN), FF, nb * 32, kb * 64, scr, lane); continue; } r -= I_DN;
        { const int gi = r / 64, q = r % 64, kb = q / 16, nb = q % 16; tr_item<false>(F.inp(9) + (size_t)gi * 256 * 512, 512, nb * 32, 32, nullptr, (bf16*)(ws + WS_WPOOL), 256, gi * 512 + nb * 32, kb * 64, scr, lane); }
    }
    if (part != 0) return;
    f32x4 gv[8];
#pragma unroll
    for (int j = 0; j < 8; ++j) gv[j] = ((const f32x4*)F.inp(4))[64 * j + lane];
    bf16* Hb = (bf16*)(ws + WS_H);
    for (int m = gw; m < M; m += NGW) {
        const float* xrow = (m < NP) ? F.inp(0) + (size_t)m * DM : F.inp(1) + (size_t)(m - NP) * DM;
        const f32x4* xr = (const f32x4*)xrow + lane; f32x4 v[8]; float s = 0.f;
#pragma unroll
        for (int j = 0; j < 8; ++j) { v[j] = xr[64 * j]; s += (v[j][0] * v[j][0] + v[j][1] * v[j][1]) + (v[j][2] * v[j][2] + v[j][3] * v[j][3]); }
        const float rs = __builtin_amdgcn_rsqf(wave_sum(s) * (1.f / DM) + EPS);
        v2u* o8 = (v2u*)(Hb + (size_t)m * DM) + lane;
#pragma unroll
        for (int j = 0; j < 8; ++j) { const f32x4 y = v[j] * rs * gv[j]; v2u w; w.x = cvt_pk_bf16(y[0], y[1]); w.y = cvt_pk_bf16(y[2], y[3]); o8[64 * j] = w; }
    }
}

constexpr int QP = 264;
constexpr int VP = 520;
__device__ __forceinline__ void gla_prep_item(Frame& F, int item) {
    const int c = item >> 2, h = item & 3, tid = F.tid, lane = F.lane, wid = F.wave;
    const bool smp = c >= NCH_P; const int r0 = c * 64;
    unsigned char* ws = F.ws;
    LAS bf16* Qs = (LAS bf16*)F.lds; LAS bf16* Ks = Qs + 64 * QP; LAS float* ALRs = (LAS float*)(F.lds + 67584); LAS float* TOT = (LAS float*)(F.lds + 71680); LAS bf16* Vs = (LAS bf16*)(F.lds + 72704);
    const bf16* Qg = (const bf16*)(ws + WS_Q); const bf16* Kg = (const bf16*)(ws + WS_K); const bf16* Vg = (const bf16*)(ws + WS_V);
#pragma unroll
    for (int j = 0; j < 4; ++j) { const int p = tid + 512 * j, row = p >> 5, c16 = p & 31;
        *(LAS v4u*)(Qs + row * QP + c16 * 8) = *(const v4u*)(Qg + (size_t)(r0 + row) * 1024 + h * 256 + c16 * 8);
        *(LAS v4u*)(Ks + row * QP + c16 * 8) = *(const v4u*)(Kg + (size_t)(r0 + row) * 1024 + h * 256 + c16 * 8); }
    if (tid < 256) *(LAS v4u*)(ALRs + tid * 4) = *(const v4u*)((const float*)(ws + WS_ALR) + (size_t)r0 * 16 + tid * 4);
    if (!smp) {
#pragma unroll
        for (int j = 0; j < 8; ++j) { const int p = tid + 512 * j, row = p >> 6, c16 = p & 63;
            *(LAS v4u*)(Vs + row * VP + c16 * 8) = *(const v4u*)(Vg + (size_t)(r0 + row) * 2048 + h * 512 + c16 * 8); } }
    const int d = tid & 255, half = tid >> 8;
    float wup[16];
#pragma unroll
    for (int j = 0; j < 16; ++j) wup[j] = F.inp(6)[j * 1024 + h * 256 + d];
    const float ba = F.inp(7)[h * 256 + d];
    __syncthreads();
    float bl[32]; float run = 0.f;
#pragma unroll
    for (int i = 0; i < 32; ++i) { const int t = 32 * half + i; float a = ba;
#pragma unroll
        for (int j4 = 0; j4 < 4; ++j4) { const f32x4 al = *(const LAS f32x4*)(ALRs + t * 16 + 4 * j4); a += al[0] * wup[4 * j4] + al[1] * wup[4 * j4 + 1] + al[2] * wup[4 * j4 + 2] + al[3] * wup[4 * j4 + 3]; }
        const float la = (fminf(a, 0.f) - __logf(1.f + __expf(-fabsf(a)))) * 0.0625f;
        if (smp && (i & 7) == 0) run = 0.f;
        run += la; bl[i] = run; }
    if (half == 0) TOT[d] = run;
    __syncthreads();
    if (!smp && half == 1) { const float off = TOT[d];
#pragma unroll
        for (int i = 0; i < 32; ++i) bl[i] += off; }
    unsigned kk[16];
#pragma unroll
    for (int i = 0; i < 32; i += 2) {
        const int t = 32 * half + i;
        const float e0 = __expf(bl[i]), e1 = __expf(bl[i + 1]), n0 = __expf(-bl[i]), n1 = __expf(-bl[i + 1]);
        const float q0 = bf2f(Qs[t * QP + d]) * e0, q1 = bf2f(Qs[(t + 1) * QP + d]) * e1;
        const float k0 = bf2f(Ks[t * QP + d]) * n0, k1 = bf2f(Ks[(t + 1) * QP + d]) * n1;
        const unsigned qp = cvt_pk_bf16(q0, q1), kp = cvt_pk_bf16(k0, k1);
        Qs[t * QP + d] = (bf16)(qp & 0xffffu); Qs[(t + 1) * QP + d] = (bf16)(qp >> 16);
        Ks[t * QP + d] = (bf16)(kp & 0xffffu); Ks[(t + 1) * QP + d] = (bf16)(kp >> 16);
        kk[i >> 1] = kp; }
    { bf16* ktt = (bf16*)(ws + WS_KTT) + ((size_t)(c * 4 + h) * 256 + d) * 64 + 32 * half;
#pragma unroll
        for (int j = 0; j < 4; ++j) *(v4u*)(ktt + 8 * j) = (v4u){kk[4 * j], kk[4 * j + 1], kk[4 * j + 2], kk[4 * j + 3]}; }
    if (!smp) { if (half == 1) ((float*)(ws + WS_EBP))[(size_t)c * 1024 + h * 256 + d] = __expf(bl[31]); }
    else {
#pragma unroll
        for (int j = 0; j < 4; ++j) ((float*)(ws + WS_EBS))[(size_t)((c - NCH_P) * 8 + 4 * half + j) * 1024 + h * 256 + d] = __expf(bl[8 * j + 7]); }
    __syncthreads();
    { bf16* QTg = (bf16*)(ws + WS_QT);
#pragma unroll
        for (int j = 0; j < 4; ++j) { const int p = tid + 512 * j, row = p >> 5, c16 = p & 31;
            *(v4u*)(QTg + (size_t)(r0 + row) * 1024 + h * 256 + c16 * 8) = *(const LAS v4u*)(Qs + row * QP + c16 * 8); } }
    { const int g = lane >> 4, cc = lane & 15, mt = wid >> 1, nt0 = 2 * (wid & 1);
        f32x4 pa[2] = {(f32x4){0.f, 0.f, 0.f, 0.f}, (f32x4){0.f, 0.f, 0.f, 0.f}};
#pragma unroll
        for (int ks = 0; ks < 8; ++ks) { const bf16x8 a = *(const LAS bf16x8*)(Qs + (16 * mt + cc) * QP + 32 * ks + 8 * g);
#pragma unroll
            for (int n = 0; n < 2; ++n) { const bf16x8 b = *(const LAS bf16x8*)(Ks + (16 * (nt0 + n) + cc) * QP + 32 * ks + 8 * g);
                pa[n] = __builtin_amdgcn_mfma_f32_16x16x32_bf16(a, b, pa[n], 0, 0, 0); } }
        bf16* PSg = (bf16*)(ws + WS_PS) + (size_t)(c * 4 + h) * 4096;
#pragma unroll
        for (int n = 0; n < 2; ++n)
#pragma unroll
            for (int r = 0; r < 4; ++r) { const int t = 16 * mt + 4 * g + r, s = 16 * (nt0 + n) + cc; const bool ok = (s <= t) && (!smp || ((s >> 3) == (t >> 3)));
                PSg[t * 64 + s] = (bf16)f2bf(ok ? pa[n][r] : 0.f); } }
    if (!smp) { unsigned vv[32];
#pragma unroll
        for (int s = 0; s < 64; s += 2) vv[s >> 1] = (unsigned)Vs[s * VP + tid] | ((unsigned)Vs[(s + 1) * VP + tid] << 16);
        bf16* vt = (bf16*)(ws + WS_VT) + ((size_t)(c * 4 + h) * 512 + tid) * 64;
#pragma unroll
        for (int j = 0; j < 8; ++j) *(v4u*)(vt + 8 * j) = (v4u){vv[4 * j], vv[4 * j + 1], vv[4 * j + 2], vv[4 * j + 3]}; }
    __syncthreads();
}
__device__ __forceinline__ void pool_prep(Frame& F, const int bi, const int nb) {
    unsigned char* ws = F.ws; const bf16* U = (const bf16*)(ws + WS_U); bf16* PB = (bf16*)(ws + WS_PB); const float* sp = F.inp(3);
    const int gt = bi * 512 + F.tid, NT = nb * 512;
    for (int idx = gt; idx < M * 128; idx += NT) {
        const int row = idx >> 7, cg = idx & 127, ch = cg * 8, w = 2 << (cg >> 5);
        int t, nvalid; const float* hist = sp; float cnt;
        if (row < NP) { t = row & (SEQ - 1); nvalid = (t + 1 < w) ? t + 1 : w; cnt = (float)nvalid; }
        else { const int rs = row - NP; t = rs & 7; nvalid = (t + 1 < w) ? t + 1 : w; cnt = (float)w; hist = sp + (size_t)((rs >> 3) * 15 + 15) * 1024 + ch; }
        v4u xu[16];
#pragma unroll
        for (int i = 0; i < 16; ++i) xu[i] = *(const v4u*)(U + (size_t)(row - (i < nvalid ? i : 0)) * 1024 + ch);
        float acc[8] = {0.f, 0.f, 0.f, 0.f, 0.f, 0.f, 0.f, 0.f};
        if (row >= NP && nvalid < w) {
            for (int i = nvalid; i < w; ++i) { const float* q = hist + (ptrdiff_t)(t - i) * 1024; const f32x4 a = *(const f32x4*)q, bb = *(const f32x4*)(q + 4);
#pragma unroll
                for (int j = 0; j < 4; ++j) { acc[j] += a[j]; acc[4 + j] += bb[j]; } } }
        float u0[8];
#pragma unroll
        for (int i = 0; i < 16; ++i) { const float mk = (i < nvalid) ? 1.f : 0.f; const unsigned xs[4] = {xu[i].x, xu[i].y, xu[i].z, xu[i].w};
#pragma unroll
            for (int j = 0; j < 4; ++j) { const float a = bf2f(xs[j] & 0xffffu), b = bf2f(xs[j] >> 16); acc[2 * j] += a * mk; acc[2 * j + 1] += b * mk; if (i == 0) { u0[2 * j] = a; u0[2 * j + 1] = b; } } }
        const float ic = __builtin_amdgcn_rcpf(cnt); v4u o;
        o.x = cvt_pk_bf16(acc[0] * ic - u0[0], acc[1] * ic - u0[1]); o.y = cvt_pk_bf16(acc[2] * ic - u0[2], acc[3] * ic - u0[3]);
        o.z = cvt_pk_bf16(acc[4] * ic - u0[4], acc[5] * ic - u0[5]); o.w = cvt_pk_bf16(acc[6] * ic - u0[6], acc[7] * ic - u0[7]);
        *(v4u*)(PB + (size_t)row * 1024 + ch) = o;
    }
    float* out = F.out;
    for (int idx = gt; idx < (4 + 128) * 15 * 128; idx += NT) {
        const int cg = idx & 127, rj = idx >> 7, ch = cg * 8; f32x4 a, b; float* dst;
        if (rj < 60) { const int bb = rj / 15, j = rj % 15; const v4u x = *(const v4u*)(U + (size_t)(bb * SEQ + SEQ - 15 + j) * 1024 + ch);
            a = (f32x4){bf2f(x.x & 0xffffu), bf2f(x.x >> 16), bf2f(x.y & 0xffffu), bf2f(x.y >> 16)}; b = (f32x4){bf2f(x.z & 0xffffu), bf2f(x.z >> 16), bf2f(x.w & 0xffffu), bf2f(x.w >> 16)};
            dst = out + OUT_BUFP + (size_t)rj * 1024 + ch; }
        else { const int r2 = rj - 60, bb = r2 / 15, j = r2 % 15;
            if (j < 7) { const float* q = sp + (size_t)(bb * 15 + j + 8) * 1024 + ch; a = *(const f32x4*)q; b = *(const f32x4*)(q + 4); }
            else { const v4u x = *(const v4u*)(U + (size_t)(NP + bb * 8 + j - 7) * 1024 + ch);
                a = (f32x4){bf2f(x.x & 0xffffu), bf2f(x.x >> 16), bf2f(x.y & 0xffffu), bf2f(x.y >> 16)}; b = (f32x4){bf2f(x.z & 0xffffu), bf2f(x.z >> 16), bf2f(x.w & 0xffffu), bf2f(x.w >> 16)}; }
            dst = out + OUT_BUFS + (size_t)r2 * 1024 + ch; }
        *(f32x4*)dst = a; *(f32x4*)(dst + 4) = b;
    }
}

constexpr int KP = 72;
__device__ __forceinline__ void gla_chain(Frame& F, int cb, float* SSQ, const int pvar) {
    int tid_ = F.tid; asm volatile("" : "+v"(tid_));
    const int b = (cb & 15) >> 2, h = cb & 3, vs = cb >> 4, tid = tid_, lane = tid_ & 63, wid = F.wave;
    const int g = lane >> 4, c = lane & 15, dh = wid >> 2, vg = wid & 3, dbase = dh * 128;
    unsigned char* ws = F.ws;
    LAS bf16* Qs = (LAS bf16*)F.lds; LAS bf16* Kt = (LAS bf16*)(F.lds + 33792); LAS bf16* Ps = (LAS bf16*)(F.lds + 70656); LAS bf16* Vt = (LAS bf16*)(F.lds + 79872);
    LAS float* EB = (LAS float*)(F.lds + 98304); LAS float* Ored = (LAS float*)(F.lds + 99328);
    const bf16* QTg = (const bf16*)(ws + WS_QT); const bf16* KTTg = (const bf16*)(ws + WS_KTT); const bf16* PSg = (const bf16*)(ws + WS_PS); const bf16* VTg = (const bf16*)(ws + WS_VT);
    const float* EBg = (const float*)(ws + WS_EBP); bf16* OG = (bf16*)(ws + WS_OG);
    f32x4 S[8][2];
#pragma unroll
    for (int i = 0; i < 8; ++i) { S[i][0] = (f32x4){0.f, 0.f, 0.f, 0.f}; S[i][1] = (f32x4){0.f, 0.f, 0.f, 0.f}; }
    v4u pq[4], pk[4], pp, pv[2]; float pe = 0.f;
    const unsigned t16 = (unsigned)tid * 16u, qoff = (unsigned)(tid >> 5) * 2048u + (unsigned)(tid & 31) * 16u;
    const unsigned lq = (unsigned)(tid >> 5) * (QP * 2) + (unsigned)(tid & 31) * 16u, lk = (unsigned)(tid >> 3) * (KP * 2) + (unsigned)(tid & 7) * 16u;
#define CH_LOAD_A(n) do { const int ci_ = b * 32 + (n); const char* qb_ = (const char*)QTg + ((size_t)ci_ * 65536 + h * 256) * 2; const char* pb_ = (const char*)PSg + (size_t)(ci_ * 4 + h) * 8192; \
        _Pragma("unroll") for (int j = 0; j < 4; ++j) pq[j] = *(const v4u*)(qb_ + j * 32768 + qoff); \
        pp = *(const v4u*)(pb_ + t16); } while (0)
#define CH_LOAD_B(n) do { const int ci_ = b * 32 + (n); const char* kb_ = (const char*)KTTg + (size_t)(ci_ * 4 + h) * 32768; const char* vb_ = (const char*)VTg + ((size_t)(ci_ * 4 + h) * 512 + vs * 128) * 128; \
        _Pragma("unroll") for (int j = 0; j < 4; ++j) pk[j] = *(const v4u*)(kb_ + j * 8192 + t16); \
        _Pragma("unroll") for (int j = 0; j < 2; ++j) pv[j] = *(const v4u*)(vb_ + j * 8192 + t16); \
        if (tid < 256) pe = *(const float*)((const char*)(EBg + (size_t)ci_ * 1024 + h * 256) + (unsigned)tid * 4u); } while (0)
#define CH_LDG(n, grp) do { const int ci_ = b * 32 + (n); const char* qb_ = (const char*)QTg + ((size_t)ci_ * 65536 + h * 256) * 2; const char* pb_ = (const char*)PSg + (size_t)(ci_ * 4 + h) * 8192; \
        const char* kb_ = (const char*)KTTg + (size_t)(ci_ * 4 + h) * 32768; const char* vb_ = (const char*)VTg + ((size_t)(ci_ * 4 + h) * 512 + vs * 128) * 128; \
        if ((grp) == 0) { pq[0] = *(const v4u*)(qb_ + qoff); pq[1] = *(const v4u*)(qb_ + 32768 + qoff); pk[0] = *(const v4u*)(kb_ + t16); } \
        if ((grp) == 1) { pq[2] = *(const v4u*)(qb_ + 2 * 32768 + qoff); pq[3] = *(const v4u*)(qb_ + 3 * 32768 + qoff); pk[1] = *(const v4u*)(kb_ + 8192 + t16); } \
        if ((grp) == 2) { pk[2] = *(const v4u*)(kb_ + 2 * 8192 + t16); pk[3] = *(const v4u*)(kb_ + 3 * 8192 + t16); pp = *(const v4u*)(pb_ + t16); } \
        if ((grp) == 3) { pv[0] = *(const v4u*)(vb_ + t16); pv[1] = *(const v4u*)(vb_ + 8192 + t16); if (tid < 256) pe = *(const float*)((const char*)(EBg + (size_t)ci_ * 1024 + h * 256) + (unsigned)tid * 4u); } \
        asm volatile("" ::: "memory"); } while (0)
#define CH_STORE() do { \
        _Pragma("unroll") for (int j = 0; j < 4; ++j) { *(LAS v4u*)((LAS char*)Qs + j * (16 * QP * 2) + lq) = pq[j]; *(LAS v4u*)((LAS char*)Kt + j * (64 * KP * 2) + lk) = pk[j]; } \
        *(LAS v4u*)((LAS char*)Ps + lk) = pp; \
        _Pragma("unroll") for (int j = 0; j < 2; ++j) *(LAS v4u*)((LAS char*)Vt + j * (64 * KP * 2) + lk) = pv[j]; \
        if (tid < 256) EB[tid] = pe; } while (0)
    CH_LOAD_A(0); CH_LOAD_B(0); CH_STORE(); __syncthreads();
    for (int n = 0; n < 32; ++n) {
        const bool ldn = (n + 1 < 32) && !(pvar & 4);
        if (ldn) CH_LDG(n + 1, 0);
        f32x4 oT[2][4];
#pragma unroll
        for (int vt = 0; vt < 2; ++vt)
#pragma unroll
            for (int tt = 0; tt < 4; ++tt) oT[vt][tt] = (f32x4){0.f, 0.f, 0.f, 0.f};
        {
            bf16x8 qf[4], va[2], pb[4];
#define CH_QLOAD(dst, ks_) do { _Pragma("unroll") for (int tt = 0; tt < 4; ++tt) { const LAS bf16* qp = Qs + (16 * tt + c) * QP + dbase + 32 * (ks_) + 4 * g; \
                const v2u q0 = *(const LAS v2u*)qp, q1 = *(const LAS v2u*)(qp + 16); dst[tt] = __builtin_bit_cast(bf16x8, ((v4u){q0.x, q0.y, q1.x, q1.y})); } } while (0)
#pragma unroll
            for (int ks = 0; ks < 4; ++ks) {
                if (ks == 2 && ldn) CH_LDG(n + 1, 1);
                CH_QLOAD(qf, ks);
                if (ks == 3) {
#pragma unroll
                    for (int vt = 0; vt < 2; ++vt) va[vt] = *(const LAS bf16x8*)(Vt + (32 * vg + 16 * vt + c) * KP + 32 * dh + 8 * g);
#pragma unroll
                    for (int tt = 0; tt < 4; ++tt) pb[tt] = *(const LAS bf16x8*)(Ps + (16 * tt + c) * KP + 32 * dh + 8 * g); }
                bf16x8 sa[2];
#pragma unroll
                for (int vt = 0; vt < 2; ++vt) { const f32x4 lo = S[2 * ks][vt], hi = S[2 * ks + 1][vt];
                    v4u w; w.x = cvt_pk_bf16(lo[0], lo[1]); w.y = cvt_pk_bf16(lo[2], lo[3]); w.z = cvt_pk_bf16(hi[0], hi[1]); w.w = cvt_pk_bf16(hi[2], hi[3]); sa[vt] = __builtin_bit_cast(bf16x8, w); }
#pragma unroll
                for (int tt = 0; tt < 4; ++tt)
#pragma unroll
                    for (int vt = 0; vt < 2; ++vt) oT[vt][tt] = __builtin_amdgcn_mfma_f32_16x16x32_bf16(sa[vt], qf[tt], oT[vt][tt], 0, 0, 0);
            }
#undef CH_QLOAD
#pragma unroll
            for (int tt = 0; tt < 4; ++tt)
#pragma unroll
                for (int vt = 0; vt < 2; ++vt) oT[vt][tt] = __builtin_amdgcn_mfma_f32_16x16x32_bf16(va[vt], pb[tt], oT[vt][tt], 0, 0, 0);
        }
        if (ldn) CH_LDG(n + 1, 2);
        {
#pragma unroll
            for (int vt = 0; vt < 2; ++vt)
#pragma unroll
                for (int t2 = 0; t2 < 2; ++t2) { const int tt = 2 * (1 - dh) + t2;
#pragma unroll
                    for (int r = 0; r < 4; ++r) Ored[((dh * 4 + vg) * 16 + (vt * 2 + t2) * 4 + r) * 64 + lane] = (dh == 0) ? oT[vt][2 + t2][r] : oT[vt][t2][r]; } }
        __syncthreads();
        if (ldn) CH_LDG(n + 1, 3);
        {
            bf16x8 vb[2][2], ka[4];
#define CH_KLOAD(dst, ks_, mg_) do { _Pragma("unroll") for (int q = 0; q < 4; ++q) dst[q] = *(const LAS bf16x8*)(Kt + (dbase + 16 * (4 * (mg_) + q) + c) * KP + 32 * (ks_) + 8 * g); } while (0)
#pragma unroll
            for (int ks = 0; ks < 2; ++ks)
#pragma unroll
                for (int vt = 0; vt < 2; ++vt) vb[ks][vt] = *(const LAS bf16x8*)(Vt + (32 * vg + 16 * vt + c) * KP + 32 * ks + 8 * g);
#pragma unroll
            for (int st = 0; st < 4; ++st) { const int ks = st >> 1, mg = st & 1;
                CH_KLOAD(ka, ks, mg);
#pragma unroll
                for (int q = 0; q < 4; ++q)
#pragma unroll
                    for (int vt = 0; vt < 2; ++vt) S[4 * mg + q][vt] = __builtin_amdgcn_mfma_f32_16x16x32_bf16(ka[q], vb[ks][vt], S[4 * mg + q][vt], 0, 0, 0); }
#undef CH_KLOAD
        }
#pragma unroll
        for (int md = 0; md < 8; ++md) { const f32x4 e = *(const LAS f32x4*)(EB + dbase + 16 * md + 4 * g); S[md][0] *= e; S[md][1] *= e; }
        {
            const int rowb = b * SEQ + n * 64;
            char* ogb = (char*)OG + ((size_t)rowb * 2048 + h * 512 + vs * 128 + 32 * vg) * 2; char* sqb = (char*)(SSQ + (size_t)rowb * 4 + h);
            const unsigned ogl = (unsigned)c * 4096u + (unsigned)g * 8u, sql = (unsigned)c * 16u;
#pragma unroll
            for (int t2 = 0; t2 < 2; ++t2) { float ss = 0.f; const int tt = 2 * dh + t2;
#pragma unroll
                for (int vt = 0; vt < 2; ++vt) { f32x4 o = (dh == 0) ? oT[vt][t2] : oT[vt][2 + t2];
#pragma unroll
                    for (int r = 0; r < 4; ++r) { o[r] += Ored[(((1 - dh) * 4 + vg) * 16 + (vt * 2 + t2) * 4 + r) * 64 + lane]; ss += o[r] * o[r]; }
                    v2u w; w.x = cvt_pk_bf16(o[0], o[1]); w.y = cvt_pk_bf16(o[2], o[3]);
                    *(v2u*)(ogb + tt * 65536 + vt * 32 + ogl) = w; }
                ss += __shfl_xor(ss, 16); ss += __shfl_xor(ss, 32);
                if (g == 0) atomicAdd((float*)(sqb + tt * 256 + sql), ss); } }
        __syncthreads();
        if (n + 1 < 32 && !(pvar & 4)) { CH_STORE(); }
        __syncthreads();
    }
#undef CH_LOAD_A
#undef CH_LOAD_B
#undef CH_STORE
    float* sg = F.out + OUT_SGP + (size_t)(b * 4 + h) * 256 * 512;
#pragma unroll
    for (int md = 0; md < 8; ++md)
#pragma unroll
        for (int vt = 0; vt < 2; ++vt)
#pragma unroll
            for (int r = 0; r < 4; ++r) sg[(size_t)(dbase + 16 * md + 4 * g + r) * 512 + vs * 128 + 32 * vg + 16 * vt + c] = S[md][vt][r];
}
__device__ __forceinline__ void gla_sample_unit(Frame& F, int u, float* SSQ) {
    const int b = u >> 3, h = (u >> 1) & 3, vh = u & 1, tid = F.tid, lane = F.lane, wid = F.wave;
    unsigned char* ws = F.ws;
    const int row0 = NP + b * 8, cs = NCH_P + (b >> 3), si = (b & 7) * 8;
    const float* Sin = F.inp(2) + (size_t)(b * 4 + h) * 256 * 512 + vh * 256 + 4 * lane;
    float* Sout = F.out + OUT_SGS + (size_t)(b * 4 + h) * 256 * 512 + vh * 256 + 4 * lane;
    f32x4 sva[4], svb[4], svc[4];
#define SMP_LOAD(dst, r_) do { _Pragma("unroll") for (int j = 0; j < 4; ++j) dst[j] = __builtin_nontemporal_load((const f32x4*)(Sin + (size_t)(wid + 8 * ((r_) + j)) * 512)); } while (0)
    SMP_LOAD(sva, 0); SMP_LOAD(svb, 4); SMP_LOAD(svc, 8);
    LAS float* QK = (LAS float*)F.lds; LAS float* EBs = (LAS float*)(F.lds + 16384); LAS float* Ored = (LAS float*)(F.lds + 17408);
    { const int d = tid & 255;
        if (tid < 256) { const bf16* qt = (const bf16*)(ws + WS_QT) + (size_t)row0 * 1024 + h * 256 + d; f32x4 a, bq;
#pragma unroll
            for (int t = 0; t < 4; ++t) { a[t] = bf2f(qt[(size_t)t * 1024]); bq[t] = bf2f(qt[(size_t)(t + 4) * 1024]); }
            *(LAS f32x4*)(QK + d * 16) = a; *(LAS f32x4*)(QK + d * 16 + 4) = bq;
            EBs[d] = ((const float*)(ws + WS_EBS))[(size_t)b * 1024 + h * 256 + d]; }
        else { const v4u x = *(const v4u*)((const bf16*)(ws + WS_KTT) + ((size_t)(cs * 4 + h) * 256 + d) * 64 + si);
            *(LAS f32x4*)(QK + d * 16 + 8) = (f32x4){bf2f(x.x & 0xffffu), bf2f(x.x >> 16), bf2f(x.y & 0xffffu), bf2f(x.y >> 16)};
            *(LAS f32x4*)(QK + d * 16 + 12) = (f32x4){bf2f(x.z & 0xffffu), bf2f(x.z >> 16), bf2f(x.w & 0xffffu), bf2f(x.w >> 16)}; } }
    f32x4 v[8], o[8];
    { const bf16* Vg = (const bf16*)(ws + WS_V) + (size_t)row0 * 2048 + h * 512 + vh * 256 + 4 * lane;
#pragma unroll
        for (int s = 0; s < 8; ++s) { const v2u x = *(const v2u*)(Vg + (size_t)s * 2048); v[s] = (f32x4){bf2f(x.x & 0xffffu), bf2f(x.x >> 16), bf2f(x.y & 0xffffu), bf2f(x.y >> 16)}; o[s] = (f32x4){0.f, 0.f, 0.f, 0.f}; } }
    __syncthreads();
#define SMP_COMP(src, r_) do { _Pragma("unroll") for (int j = 0; j < 4; ++j) { const int d = wid + 8 * ((r_) + j); \
            const f32x4 q0 = *(const LAS f32x4*)(QK + d * 16), q1 = *(const LAS f32x4*)(QK + d * 16 + 4), k0 = *(const LAS f32x4*)(QK + d * 16 + 8), k1 = *(const LAS f32x4*)(QK + d * 16 + 12); \
            const float e = EBs[d]; f32x4 sn = src[j]; \
            _Pragma("unroll") for (int s = 0; s < 4; ++s) { sn += v[s] * k0[s]; o[s] += src[j] * q0[s]; } \
            _Pragma("unroll") for (int s = 0; s < 4; ++s) { sn += v[s + 4] * k1[s]; o[s + 4] += src[j] * q1[s]; } \
            __builtin_nontemporal_store(sn * e, (f32x4*)(Sout + (size_t)d * 512)); } } while (0)
    SMP_COMP(sva, 0); SMP_LOAD(sva, 12);
    SMP_COMP(svb, 4); SMP_LOAD(svb, 16);
    SMP_COMP(svc, 8); SMP_LOAD(svc, 20);
    SMP_COMP(sva, 12); SMP_LOAD(sva, 24);
    SMP_COMP(svb, 16); SMP_LOAD(svb, 28);
    SMP_COMP(svc, 20);
    SMP_COMP(sva, 24);
    SMP_COMP(svb, 28);
#undef SMP_LOAD
#undef SMP_COMP
#pragma unroll
    for (int t = 0; t < 8; ++t) *(LAS f32x4*)(Ored + (wid * 8 + t) * 256 + 4 * lane) = o[t];
    __syncthreads();
    { const int t = wid; f32x4 ot = (f32x4){0.f, 0.f, 0.f, 0.f};
#pragma unroll
        for (int w = 0; w < 8; ++w) ot += *(const LAS f32x4*)(Ored + (w * 8 + t) * 256 + 4 * lane);
        const v4u px = *(const v4u*)((const bf16*)(ws + WS_PS) + ((size_t)(cs * 4 + h) * 64 + si + t) * 64 + si);
        const float pr[8] = {bf2f(px.x & 0xffffu), bf2f(px.x >> 16), bf2f(px.y & 0xffffu), bf2f(px.y >> 16), bf2f(px.z & 0xffffu), bf2f(px.z >> 16), bf2f(px.w & 0xffffu), bf2f(px.w >> 16)};
#pragma unroll
        for (int s = 0; s < 8; ++s) ot += v[s] * pr[s];
        v2u w2; w2.x = cvt_pk_bf16(ot[0], ot[1]); w2.y = cvt_pk_bf16(ot[2], ot[3]);
        *(v2u*)((bf16*)(ws + WS_OG) + (size_t)(row0 + t) * 2048 + h * 512 + vh * 256 + 4 * lane) = w2;
        const float ss = wave_sum((ot[0] * ot[0] + ot[1] * ot[1]) + (ot[2] * ot[2] + ot[3] * ot[3]));
        if (lane == 0) atomicAdd(SSQ + (size_t)(row0 + t) * 4 + h, ss); }
    __syncthreads();
}

__device__ __forceinline__ void final_norm(Frame& F, float* dst) {
    const int gw = F.vcu * NWAVES + F.wave, NGW = F.G * NWAVES, lane = F.lane; const float* SSQ2 = (const float*)(F.ctl + CW_SSQ2);
    f32x4 gv[8];
#pragma unroll
    for (int j = 0; j < 8; ++j) gv[j] = ((const f32x4*)F.inp(15))[64 * j + lane];
    for (int m = gw; m < M; m += NGW) { const float rs = __builtin_amdgcn_rsqf(SSQ2[m] * (1.f / DM) + EPS); const f32x4* xr = (const f32x4*)(F.out + OUT_Y + (size_t)m * DM) + lane; f32x4* xw = (f32x4*)(dst + (size_t)m * DM) + lane;
#pragma unroll
        for (int j = 0; j < 8; ++j) xw[64 * j] = xr[64 * j] * rs * gv[j]; }
}

struct Args { const float* in[16]; float* out; unsigned char* ws; int ph_lo, ph_hi; };
__global__ void __launch_bounds__(NWAVES * 64, 2) mk_fwd(Args args) {
    extern __shared__ __attribute__((aligned(16))) unsigned char lds[];
    Frame F;
    F.lds = (LAS unsigned char*)lds; F.MISC = (volatile LAS unsigned*)(F.lds + MISC_OFF);
    F.tid = threadIdx.x; F.lane = F.tid & 63; F.wave = __builtin_amdgcn_readfirstlane(F.tid >> 6);
    F.G = gridDim.x; { const int bx = blockIdx.x; F.vcu = (F.G % 8 == 0) ? (bx % 8) * (F.G / 8) + bx / 8 : bx; }
    F.out = args.out; F.ws = args.ws; F.ctl = (unsigned*)(args.ws + WS_CTL);
    for (int u = F.tid; u < (LDS_BYTES - LDSCTL_OFF) / 4; u += NWAVES * 64) ((LAS unsigned*)(F.lds + LDSCTL_OFF))[u] = 0u;
    __syncthreads();
    if (F.tid < 16) ((LAS unsigned long long*)(F.lds + PTAB_OFF))[F.tid] = (unsigned long long)args.in[F.tid];
    __syncthreads();
    const int lo = args.ph_lo, hi = args.ph_hi;
    const bool use_bar = (hi - lo) > 1;
    XcdBarrier bar; bar.bar = F.ctl + CW_BAR; bar.x = 0; bar.st = nullptr;
    if (use_bar) bar = xcd_barrier_post(F.ctl + CW_BAR, F.MISC + 8);
#define IN(k) (((PHMASK >> (k)) & 1) && lo <= (k) && (k) < hi)
#define SEAM(k) do { if (IN(k) && IN((k) + 1)) xcd_barrier(bar); } while (0)
    unsigned char* ws = args.ws;
    const int bx = (int)blockIdx.x;

#define REPS(k) (((PROBE_MASK >> (k)) & 1) ? 2 : 1)
#define LASTREP(k, r) ((r) == REPS(k) - 1)
#define REPBAR(k, r) do { if (!LASTREP(k, r) && use_bar) xcd_barrier(bar); } while (0)
    float* dummy = (float*)(ws + WS_DUMMY);
    if (IN(0)) for (int r = 0; r < REPS(0); ++r) { p0_prologue(F, 0, F.vcu * NWAVES + F.wave, F.G * NWAVES); REPBAR(0, r); } SEAM(0);
    if (IN(1)) for (int r = 0; r < REPS(1); ++r) { pg8::Gemm g{(const bf16*)(ws + WS_H), (const bf16*)(ws + WS_WIN), DM, DM, DM, 0}; pg8::StaticOrder S; S.init(M, NIN, F.G, bx);
        EpiIn E{ws}; pg8::gemm_phase(F.lds, g, S, E);
        if (LASTREP(1, r)) {
            const int nt_ = (M / 256) * (NIN / 256), full = nt_ / F.G, rem = nt_ - full * F.G;
            __syncthreads();
            if (rem == 0 || rem >= F.G) p0_prologue(F, 1, bx * NWAVES + F.wave, F.G * NWAVES);
            else if (bx >= rem) p0_prologue(F, 1, (bx - rem) * NWAVES + F.wave, (F.G - rem) * NWAVES); }
        REPBAR(1, r); } SEAM(1);
    if (IN(2)) for (int r = 0; r < REPS(2); ++r) { for (int it = bx; it < NCH * 4; it += F.G) gla_prep_item(F, it);
        { const int n3 = NCH * 4 - 2 * F.G;
          if (F.G == 256 && n3 > 0 && n3 < F.G) { if (bx >= n3) pool_prep(F, bx - n3, F.G - n3); } else pool_prep(F, bx, F.G); }
        REPBAR(2, r); } SEAM(2);
    if (IN(3))
#pragma unroll
    for (int r = 0; r < REPS(3); ++r) {
        float* SSQ = LASTREP(3, r) ? (float*)(F.ctl + CW_SSQ) : dummy;
        const int pv = LASTREP(3, r) ? 0 : PROBE_VAR;
        if (!(pv & 2)) {
        if (bx < 64) gla_chain(F, bx, SSQ, pv);
        }
        __syncthreads();
        if (!(pv & 1))
        for (;;) { if (F.tid == 0) F.MISC[0] = atomicAdd(F.ctl + CW_WORK + 64 * r, 1u); __syncthreads(); const int u = (int)F.MISC[0]; __syncthreads(); if (u >= 1024) break; gla_sample_unit(F, u, SSQ); }
        REPBAR(3, r);
    }
    if (IN(3) && IN(5)) xcd_barrier(bar);
    if (IN(5)) { gs::Ctx X{ws, F.inp(0), F.inp(1), F.out, F.ctl, F.inp(8), F.inp(10), F.inp(15)}; gs::gemm_stream(F.lds, X, F.G, bx); }
    if (IN(5) && IN(8) && F.G != 256) xcd_barrier(bar);
    if (IN(8) && F.G != 256) { final_norm(F, F.out + OUT_Y); }
#undef IN
#undef SEAM
#undef REPS
#undef LASTREP
#undef REPBAR
}

extern "C" void kernel_launch(void* const* d_in, const int* in_sizes, int n_in, void* d_out, int out_size, void* d_ws, size_t ws_size, hipStream_t stream) {
    static int grid = 0;
    if (grid == 0) {
        if (n_in != 16 || (size_t)out_size != OUT_END || ws_size < WS_END) { fprintf(stderr, "kernel_launch: unexpected shapes (n_in %d, out %d, ws %zu); nothing launched\n", n_in, out_size, ws_size); grid = -1; return; }
        int dev = 0, cus = 0, per_cu = 0;
        if (hipGetDevice(&dev) != hipSuccess || hipDeviceGetAttribute(&cus, hipDeviceAttributeMultiprocessorCount, dev) != hipSuccess) { grid = -1; return; }
        if (hipFuncSetAttribute((const void*)mk_fwd, hipFuncAttributeMaxDynamicSharedMemorySize, LDS_BYTES) != hipSuccess) { fprintf(stderr, "kernel_launch: hipFuncSetAttribute failed\n"); grid = -1; return; }
        if (hipOccupancyMaxActiveBlocksPerMultiprocessor(&per_cu, (const void*)mk_fwd, NWAVES * 64, LDS_BYTES) != hipSuccess || per_cu < 1) { fprintf(stderr, "kernel_launch: occupancy query says %d blocks per CU; nothing launched\n", per_cu); (void)hipGetLastError(); grid = -1; return; }
        grid = cus;
        if (grid < 72 || grid > 4096) { fprintf(stderr, "kernel_launch: unexpected CU count %d\n", cus); grid = -1; return; }
    }
    if (grid < 0) return;
    (void)hipMemsetAsync((char*)d_ws + WS_CTL, 0, CTL_ZERO_BYTES, stream);
    Args a{};
    for (int i = 0; i < 16; ++i) a.in[i] = (const float*)d_in[i];
    a.out = (float*)d_out; a.ws = (unsigned char*)d_ws;
#if MK_N_LAUNCHES == 1
    a.ph_lo = 0; a.ph_hi = NPHASES;
    hipLaunchKernelGGL(mk_fwd, dim3(grid), dim3(NWAVES * 64), LDS_BYTES, stream, a);
#else
    for (int p = 0; p < NPHASES; ++p) { a.ph_lo = p; a.ph_hi = p + 1; hipLaunchKernelGGL(mk_fwd, dim3(grid), dim3(NWAVES * 64), LDS_BYTES, stream, a); }
#endif
}
```

```cpp
#include <hip/hip_runtime.h>
#include <cstdio>
#include <cstdint>

#ifndef PHMASK
#define PHMASK 0x1ff
#endif
#ifndef PROBE_MASK
#define PROBE_MASK 0
#endif
#ifndef PROBE_VAR
#define PROBE_VAR 0
#endif
#ifndef MK_N_LAUNCHES
#define MK_N_LAUNCHES 1
#endif

#define GAS __attribute__((address_space(1)))
#define LAS __attribute__((address_space(3)))
typedef unsigned short bf16;
typedef unsigned v4u __attribute__((ext_vector_type(4)));
typedef unsigned v2u __attribute__((ext_vector_type(2)));
typedef float f32x4 __attribute__((ext_vector_type(4)));
typedef float f32x2 __attribute__((ext_vector_type(2)));
typedef short bf16x8 __attribute__((ext_vector_type(8)));
typedef GAS unsigned gu32;
#define RLX_AGENT __ATOMIC_RELAXED, __HIP_MEMORY_SCOPE_AGENT
#define LDS_WAIT() asm volatile("s_waitcnt lgkmcnt(0)" ::: "memory")
#define VM_WAIT() asm volatile("s_waitcnt vmcnt(0)" ::: "memory")

constexpr int DM = 2048, NP = 8192, NS = 1024, M = NP + NS;
constexpr int SEQ = 2048, NBS = 128, TS = 8;
constexpr int NH = 4, DK = 256, DV = 512, QW = 1024, VW = 2048, UW = 1024;
constexpr int INW = 11280, NIN = 11520, FF = 8192;
constexpr int NCH_P = 128, NCH = 144;
constexpr float EPS = 1e-6f;
constexpr size_t OUT_Y = 0, OUT_SGP = (size_t)M * DM, OUT_BUFP = OUT_SGP + 4 * 4 * 256 * 512, OUT_SGS = OUT_BUFP + 4 * 15 * 1024, OUT_BUFS = OUT_SGS + (size_t)128 * 4 * 256 * 512, OUT_END = OUT_BUFS + 128 * 15 * 1024;
constexpr size_t MiB = 1u << 20;
constexpr size_t WS_CTL = 0, CTL_ZERO_BYTES = 1 * MiB;
constexpr size_t WS_WPOOL = 1 * MiB, WS_WOUT = 2 * MiB, WS_WUP = 10 * MiB, WS_WDN = 42 * MiB, WS_WIN = 74 * MiB, WS_H = 119 * MiB;
constexpr size_t WS_Q = 155 * MiB, WS_K = 173 * MiB, WS_U = 191 * MiB, WS_V = 209 * MiB, WS_R = 245 * MiB, WS_GA = 281 * MiB, WS_GB = 317 * MiB, WS_ALR = 353 * MiB;
constexpr size_t WS_QT = 354 * MiB, WS_KTT = 372 * MiB, WS_VT = 390 * MiB, WS_PS = 422 * MiB, WS_EBP = 427 * MiB, WS_EBS = 427 * MiB + 512 * 1024;
constexpr size_t WS_PB = 428 * MiB, WS_OB = 446 * MiB, WS_OG = 482 * MiB, WS_MB = 518 * MiB, WS_X1 = 554 * MiB, WS_X1B = 626 * MiB, WS_HID = 662 * MiB, WS_DUMMY = 806 * MiB, WS_XS = 806 * MiB + 512 * 1024, WS_XS4 = 807 * MiB, WS_SLAB = 808 * MiB, WS_END = 872 * MiB;
static_assert(WS_WIN + (size_t)NIN * DM * 2 <= WS_H && WS_H + (size_t)M * DM * 2 <= WS_Q && WS_HID + (size_t)M * FF * 2 <= WS_DUMMY && WS_X1 + (size_t)M * DM * 4 <= WS_X1B, "ws map");
constexpr int CW_TMO = 0, CW_BAR = 4096, CW_WORK = 8192, CW_SSQ = 16384, CW_SSQ1 = 65536, CW_SSQ2 = 81920, CW_CNT5 = 98304, CW_CNT6 = 102400, CW_CNTS = 106496, CW_CNTP = 110592, CW_CNT7 = 114688, CW_CNT8 = 118784;
static_assert(CW_SSQ + M * 4 <= CW_SSQ1 && CW_SSQ1 + M <= CW_SSQ2 && (CW_SSQ2 + M) * 4 <= (int)CTL_ZERO_BYTES, "ctl map");
constexpr int RING_BYTES = 131072, LDSCTL_OFF = 140 * 1024, MISC_OFF = LDSCTL_OFF + 320, PTAB_OFF = LDSCTL_OFF + 1024, LDS_BYTES = 147456;
constexpr int NWAVES = 8;
constexpr int NPHASES = 9;

__device__ __forceinline__ float bf2f(unsigned b) { return __builtin_bit_cast(float, b << 16); }
__device__ __forceinline__ unsigned cvt_pk_bf16(float lo, float hi) { unsigned r; asm volatile("v_cvt_pk_bf16_f32 %0, %1, %2" : "=v"(r) : "v"(lo), "v"(hi)); return r; }
__device__ __forceinline__ unsigned f2bf(float f) { return cvt_pk_bf16(f, 0.f) & 0xffffu; }
__device__ __forceinline__ float wave_sum(float v) {
#pragma unroll
    for (int o = 1; o < 64; o <<= 1) v += __shfl_xor(v, o);
    return v;
}
__device__ __forceinline__ float sigmoidf_(float x) { return __builtin_amdgcn_rcpf(1.f + __expf(-x)); }

namespace pg8 {
constexpr int BM = 256, BK = 64, HALF = 128, HTB = HALF * BK * 2, STAGE_BYTES = 8 * HTB, NXCD = 8, WGM = 8;
__host__ __device__ __forceinline__ int lds_byte(int r, int c) { const int st = (r >> 4) * 2 + (c >> 5), rr = r & 15, cc = c & 31, ob = rr * 64 + cc * 2; return st * 1024 + (ob ^ (((ob >> 9) & 1) << 5)); }
__host__ __device__ __forceinline__ void stage_rc(int b, int& R, int& C) { const int st = b / 1024, sb = b % 1024, swz = sb ^ (((sb >> 9) & 1) << 5); R = (st >> 1) * 16 + swz / 64; C = (st & 1) * 32 + (swz % 64) / 2; }
__host__ __device__ __forceinline__ int perm32(int rho) { const int n = rho >> 4, i = rho & 15; return 8 * (i >> 2) + 4 * n + (i & 3); }

struct Unit { int pm, pn; };
struct Gemm { const bf16* A; const bf16* Bt; int lda, ldb, K, a_div; };

struct StaticOrder {
    int nM, nN, nwg, G, c;
    __device__ void init(int M_, int N_, int G_, int c_) { nM = M_ / BM; nN = N_ / BM; nwg = nM * nN; G = G_; c = c_; }
    __device__ bool next(int i, Unit& u) const {
        const long L = (long)i * G + c; if (c < 0 || L >= nwg) return false;
        int wgid = (int)L; { const int q = nwg / NXCD, r = nwg % NXCD, xcd = wgid % NXCD, off = wgid / NXCD; wgid = (xcd < r ? xcd * (q + 1) : r * (q + 1) + (xcd - r) * q) + off; }
        const int nig = WGM * nN, gid = wgid / nig, fm = gid * WGM, gsz = (nM - fm) < WGM ? (nM - fm) : WGM;
        u.pm = fm + ((wgid % nig) % gsz); u.pn = (wgid % nig) / gsz; return true;
    }
};

template <class Epi, class Sched>
__device__ __forceinline__ void gemm_phase(LAS unsigned char* lds, const Gemm g, const Sched& S, const Epi& E) {
    const int tid = threadIdx.x, wid = __builtin_amdgcn_readfirstlane(tid >> 6), lane = tid & 63, wr = wid >> 2, wc = wid & 3, fr = lane & 15, fq = lane >> 4;
    const int K = g.K, nt = K / BK;
    unsigned voffA[2], voffB[2];
#pragma unroll
    for (int i = 0; i < 2; ++i) { int R, C; stage_rc(tid * 16 + i * 8192, R, C); const int Rb = (R & ~31) + perm32(R & 31);
        voffA[i] = (unsigned)(R * g.lda + C) * 2u; voffB[i] = (unsigned)(Rb * g.ldb + C) * 2u; }
    const size_t kstep = (size_t)(BK * 2);
    const size_t hA = (size_t)HALF * g.lda * 2, hB = (size_t)HALF * g.ldb * 2;
    const unsigned ldsw = (unsigned)wid * 1024u;
    const int aoff = lds_byte(wr * 64 + fr, fq * 8), boff = lds_byte(wc * 32 + fr, fq * 8);
#define PG8_SA(b, h) (((b) * 2 + (h)) * HTB)
#define PG8_SB(b, h) ((4 + (b) * 2 + (h)) * HTB)
#define PG8_STAGE(bufoff, gbase, voff) do { _Pragma("unroll") for (int _i = 0; _i < 2; ++_i) \
        __builtin_amdgcn_global_load_lds((const unsigned*)((const char*)(gbase) + (voff)[_i]), (LAS unsigned*)(lds + (bufoff) + ldsw + _i * 8192), 16, 0, 0); } while (0)
#define PG8_LDA(dst, b, h) do { _Pragma("unroll") for (int m = 0; m < 4; ++m) _Pragma("unroll") for (int k = 0; k < 2; ++k) dst[m][k] = *(const LAS bf16x8*)(lds + PG8_SA(b, h) + aoff + m * 2048 + k * 1024); } while (0)
#define PG8_LDB(dst, b, h) do { _Pragma("unroll") for (int n = 0; n < 2; ++n) _Pragma("unroll") for (int k = 0; k < 2; ++k) dst[n][k] = *(const LAS bf16x8*)(lds + PG8_SB(b, h) + boff + n * 2048 + k * 1024); } while (0)
#define PG8_MMA(ai, bj, At, Bt) do { __builtin_amdgcn_s_setprio(1); _Pragma("unroll") for (int m = 0; m < 4; ++m) _Pragma("unroll") for (int n = 0; n < 2; ++n) _Pragma("unroll") for (int k = 0; k < 2; ++k) \
        acc[ai][bj][m][n] = __builtin_amdgcn_mfma_f32_16x16x32_bf16(Bt[n][k], At[m][k], acc[ai][bj][m][n], 0, 0, 0); __builtin_amdgcn_s_setprio(0); } while (0)
#define PG8_WAIT_V(n) asm volatile("s_waitcnt vmcnt(" #n ")" ::: "memory")
#define PG8_WAIT_L(n) asm volatile("s_waitcnt lgkmcnt(" #n ")" ::: "memory")
#define PG8_BAR __builtin_amdgcn_s_barrier()
#define PG8_SCHED __builtin_amdgcn_sched_barrier(0)
#define PG8_ACOL(u) ((size_t)(g.a_div ? ((u).pn / g.a_div) * K * 2 : 0))
    Unit cur, nxt; int ui = 0;
    if (!S.next(0, cur)) return;
    f32x4 acc[2][2][4][2];
#pragma unroll
    for (int a = 0; a < 2; ++a)
#pragma unroll
        for (int b = 0; b < 2; ++b)
#pragma unroll
            for (int m = 0; m < 4; ++m)
#pragma unroll
                for (int n = 0; n < 2; ++n) acc[a][b][m][n] = (f32x4){0.f, 0.f, 0.f, 0.f};
    bf16x8 At[4][2], B0[2][2], B1[2][2];
    const char* cA = (const char*)g.A + (size_t)cur.pm * 2 * hA + PG8_ACOL(cur); const char* cB = (const char*)g.Bt + (size_t)cur.pn * 2 * hB;
    PG8_STAGE(PG8_SB(0, 0), cB, voffB); PG8_STAGE(PG8_SB(0, 1), cB + hB, voffB); PG8_STAGE(PG8_SA(0, 0), cA, voffA); PG8_STAGE(PG8_SA(0, 1), cA + hA, voffA);
    if (wr == 1) PG8_BAR;
    PG8_WAIT_V(2); PG8_BAR;
    PG8_STAGE(PG8_SB(1, 0), cB + kstep, voffB); PG8_STAGE(PG8_SA(1, 0), cA + kstep, voffA); PG8_STAGE(PG8_SB(1, 1), cB + hB + kstep, voffB);
    PG8_WAIT_V(6); PG8_BAR;
    for (;;) {
        const bool has_next = S.next(ui + 1, nxt);
        const char* nA = has_next ? (const char*)g.A + (size_t)nxt.pm * 2 * hA + PG8_ACOL(nxt) : cA; const char* nB = has_next ? (const char*)g.Bt + (size_t)nxt.pn * 2 * hB : cB;
#pragma unroll 1
        for (int t = 0; t < nt; t += 2) {
            const bool last = (t == nt - 2);
            const char* a1 = cA + (size_t)(t + 1) * kstep;
            const char* a2 = last ? nA : cA + (size_t)(t + 2) * kstep; const char* b2 = last ? nB : cB + (size_t)(t + 2) * kstep;
            const char* a3 = a2 + kstep; const char* b3 = b2 + kstep;
            PG8_LDB(B0, 0, 0); PG8_LDB(B1, 0, 1); PG8_SCHED; PG8_LDA(At, 0, 0); PG8_STAGE(PG8_SA(1, 1), a1 + hA, voffA);
            PG8_WAIT_V(8); PG8_WAIT_L(0); PG8_BAR; PG8_MMA(0, 0, At, B0); PG8_MMA(0, 1, At, B1); PG8_BAR; PG8_SCHED;
            PG8_LDA(At, 0, 1); PG8_STAGE(PG8_SB(0, 0), b2, voffB); PG8_STAGE(PG8_SB(0, 1), b2 + hB, voffB); PG8_STAGE(PG8_SA(0, 0), a2, voffA);
            PG8_WAIT_V(8); PG8_WAIT_L(0); PG8_BAR; PG8_MMA(1, 0, At, B0); PG8_MMA(1, 1, At, B1); PG8_BAR; PG8_SCHED;
            PG8_LDB(B0, 1, 0); PG8_LDB(B1, 1, 1); PG8_SCHED; PG8_LDA(At, 1, 0); PG8_STAGE(PG8_SA(0, 1), a2 + hA, voffA);
            PG8_WAIT_V(8); PG8_WAIT_L(0); PG8_BAR; PG8_MMA(0, 0, At, B0); PG8_MMA(0, 1, At, B1); PG8_BAR; PG8_SCHED;
            PG8_LDA(At, 1, 1); PG8_STAGE(PG8_SB(1, 0), b3, voffB); PG8_STAGE(PG8_SB(1, 1), b3 + hB, voffB); PG8_STAGE(PG8_SA(1, 0), a3, voffA);
            PG8_WAIT_V(8); PG8_WAIT_L(0); PG8_BAR; PG8_MMA(1, 0, At, B0); PG8_MMA(1, 1, At, B1); PG8_BAR; PG8_SCHED;
        }
        if (wr == 0) PG8_BAR;
        E(acc, cur, wr, wc, fr, fq);
        if (!has_next) break;
#pragma unroll
        for (int a = 0; a < 2; ++a)
#pragma unroll
            for (int b = 0; b < 2; ++b)
#pragma unroll
                for (int m = 0; m < 4; ++m)
#pragma unroll
                    for (int n = 0; n < 2; ++n) acc[a][b][m][n] = (f32x4){0.f, 0.f, 0.f, 0.f};
        cur = nxt; cA = nA; cB = nB; ++ui;
        if (wr == 1) PG8_BAR;
    }
    PG8_WAIT_V(0);
    PG8_BAR;
#undef PG8_SA
#undef PG8_SB
#undef PG8_STAGE
#undef PG8_LDA
#undef PG8_LDB
#undef PG8_MMA
#undef PG8_WAIT_V
#undef PG8_WAIT_L
#undef PG8_BAR
#undef PG8_SCHED
#undef PG8_ACOL
}
}

using pg8::Unit;
__device__ __forceinline__ void st_bf16x8(bf16* p, f32x4 v0, f32x4 v1) { v4u w; w.x = cvt_pk_bf16(v0[0], v0[1]); w.y = cvt_pk_bf16(v0[2], v0[3]); w.z = cvt_pk_bf16(v1[0], v1[1]); w.w = cvt_pk_bf16(v1[2], v1[3]); *(v4u*)p = w; }

struct EpiIn {
    unsigned char* ws;
    __device__ __forceinline__ void operator()(const f32x4 (&acc)[2][2][4][2], const Unit& u, int wr, int wc, int fr, int fq) const {
        const int pn = u.pn; const int row0 = u.pm * 256 + wr * 64 + fr;
        if (pn == 44) {
            if (wc == 0 && fq < 2) { float* alr = (float*)(ws + WS_ALR);
#pragma unroll
                for (int ai = 0; ai < 2; ++ai)
#pragma unroll
                    for (int m = 0; m < 4; ++m) { float* rp = alr + (size_t)(row0 + ai * 128 + m * 16) * 16 + 8 * fq;
                        *(f32x4*)rp = acc[ai][0][m][0]; *(f32x4*)(rp + 4) = acc[ai][0][m][1]; } }
            return;
        }
        if (pn >= 16 && pn < 32) {
            bf16* G = (bf16*)(ws + WS_R); const int col0 = (pn - 16) * 128 + wc * 32 + 8 * fq;
#pragma unroll
            for (int ai = 0; ai < 2; ++ai)
#pragma unroll
                for (int m = 0; m < 4; ++m) { f32x4 g0, g1;
#pragma unroll
                    for (int j = 0; j < 4; ++j) { const float r0 = acc[ai][0][m][0][j], r1 = acc[ai][0][m][1][j], a0 = acc[ai][1][m][0][j], a1 = acc[ai][1][m][1][j];
                        g0[j] = r0 * sigmoidf_(r0) * sigmoidf_(a0); g1[j] = r1 * sigmoidf_(r1) * sigmoidf_(a1); }
                    st_bf16x8(G + (size_t)(row0 + ai * 128 + m * 16) * 2048 + col0, g0, g1); }
            return;
        }
        bf16* base; int ldc, ct; float sc = 1.f;
        if (pn < 4) { base = (bf16*)(ws + WS_Q); ldc = 1024; ct = pn; sc = 0.0625f; }
        else if (pn < 8) { base = (bf16*)(ws + WS_K); ldc = 1024; ct = pn - 4; }
        else if (pn < 16) { base = (bf16*)(ws + WS_V); ldc = 2048; ct = pn - 8; }
        else if (pn < 36) { base = (bf16*)(ws + WS_U); ldc = 1024; ct = pn - 32; }
        else { base = (bf16*)(ws + WS_GB); ldc = 2048; ct = pn - 36; }
        const int col0 = ct * 256 + wc * 32 + 8 * fq;
#pragma unroll
        for (int ai = 0; ai < 2; ++ai)
#pragma unroll
            for (int m = 0; m < 4; ++m) { bf16* rowp = base + (size_t)(row0 + ai * 128 + m * 16) * ldc + col0;
#pragma unroll
                for (int bj = 0; bj < 2; ++bj) st_bf16x8(rowp + bj * 128, acc[ai][bj][m][0] * sc, acc[ai][bj][m][1] * sc); }
    }
};
namespace gs {
using namespace pg8;
struct SUnit { int st, pm, pn, kt0, nkt, r, s, late; };
__device__ __forceinline__ bool su_next(int i, int G, int c, SUnit& u) {
    int st = 0, pm = 0, pn = 0, kt0 = 0, nkt = 32, r = 0, sp = 0, late = 0;
    if (G != 256) {
        const long LL = (long)i * G + c; if (LL >= 288 + 288 + 1152 + 288) return false;
        const int L = (int)LL; late = 1;
        if (L < 288) { st = 0; nkt = 4; pm = L >> 3; pn = L & 7; }
        else if (L < 576) { st = 1; pm = (L - 288) >> 3; pn = (L - 288) & 7; }
        else if (L < 1728) { st = 2; pm = (L - 576) >> 5; pn = (L - 576) & 31; }
        else { st = 3; nkt = 128; pm = (L - 1728) >> 3; pn = (L - 1728) & 7; }
    } else {
        const int ty = (c < 160) ? 0 : (c < 192 ? 1 : 2);
        const int last = (ty == 2) ? 7 : 8;
        if (i > last) return false;
        if (i <= 1) { const int x = c & 7, y = c >> 3; st = i; nkt = (i == 0) ? 4 : 32; late = i; pm = 8 * (x >> 1) + (y & 7); pn = 4 * (x & 1) + (y >> 3); }
        else if (i == last) { st = 4; const int x = c & 7; int y;
            if (ty == 2) { const int k = (c - 192) >> 3; y = k >> 1; sp = k & 1; } else if (ty == 1) { y = (c - 160) >> 3; sp = 2; } else { const int k = c >> 3; y = k / 5; sp = 3 + (k - 5 * y); }
            pm = 32 + y; pn = x; r = y * 8 + x;
            kt0 = (sp < 2) ? 22 * sp : (sp == 2 ? 44 : 58 + 14 * (sp - 3)); nkt = (sp < 2) ? 22 : 14; }
        else if (i == last - 1) { st = 3; nkt = 128; const int rank = (ty == 2) ? c - 192 : (ty == 1 ? c - 160 : c), P2 = (ty == 2) ? 4 : (ty == 1 ? 2 : 10), pm0 = (ty == 2) ? 0 : (ty == 1 ? 8 : 12);
            const int x = rank & 7, k = rank >> 3; pn = 2 * (x & 3) + (k & 1); pm = pm0 + (x >> 2) * P2 + (k >> 1); late = (pm >= 24) ? 1 : 0; }
        else if (ty == 1 && i <= 3) { st = i - 2; nkt = (i == 2) ? 4 : 32; late = i - 2; pm = 32 + ((c - 160) >> 3); pn = c & 7; }
        else { st = 2; int j2;
            if (i == 2) { j2 = (ty == 0) ? c : 160 + (c - 192); late = 1; } else if (i == 3) j2 = 224 + ((ty == 0) ? c : 160 + (c - 192)); else j2 = 448 + 256 * (i - 4) + c;
            const int rd = j2 >> 8, jr = j2 & 255, x = jr & 7, y = jr >> 3;
            pm = (rd < 4) ? 8 * rd + (y & 7) : 32 + (y & 3); pn = (rd < 4) ? 4 * x + (y >> 3) : 4 * x + (y >> 2); }
    }
    u.st = st; u.pm = pm; u.pn = pn; u.kt0 = kt0; u.nkt = nkt; u.r = r; u.s = sp; u.late = late;
    return true;
}
struct Ctx { unsigned char* ws; const float* xp; const float* xs; float* out; unsigned* ctl; const float* gn; const float* pscale; const float* gfin; };
__device__ __forceinline__ void st16_wt(__amdgpu_buffer_rsrc_t rs, unsigned off, v4u v) { __builtin_amdgcn_raw_buffer_store_b128(v, rs, off, 0, 16); }
__device__ __forceinline__ void st16_pl(__amdgpu_buffer_rsrc_t rs, unsigned off, v4u v) { __builtin_amdgcn_raw_buffer_store_b128(v, rs, off, 0, 0); }
#define ST16(X_, rs, off, v) st16_wt(rs, off, v)
__device__ __forceinline__ v4u pk8(f32x4 v0, f32x4 v1) { v4u w; w.x = cvt_pk_bf16(v0[0], v0[1]); w.y = cvt_pk_bf16(v0[2], v0[3]); w.z = cvt_pk_bf16(v1[0], v1[1]); w.w = cvt_pk_bf16(v1[2], v1[3]); return w; }
__device__ __forceinline__ float epi_rg(const Ctx& X, const SUnit& u, const f32x4 (&v)[2][2], int ai, int m, int wr, int wc, int fr, int fq) {
    const int row = u.pm * 256 + ai * 128 + wr * 64 + m * 16 + fr, col0 = u.pn * 256 + wc * 32 + 8 * fq;
    if (u.st == 0) {
        const float rs = __builtin_amdgcn_rsqf(((const float*)(X.ctl + CW_SSQ))[row * 4 + (u.pn >> 1)] * (1.f / DV) + EPS);
        const __amdgpu_buffer_rsrc_t rm = __builtin_amdgcn_make_buffer_rsrc((void*)(X.ws + WS_MB), (short)0, (int)((size_t)M * DM * 2), 0x00020000);
        const bf16* OG = (const bf16*)(X.ws + WS_OG); const bf16* Gt = (const bf16*)(X.ws + WS_R); const bf16* GB = (const bf16*)(X.ws + WS_GB);
#pragma unroll
        for (int bj = 0; bj < 2; ++bj) { const size_t o2 = (size_t)row * DM + col0 + bj * 128; const int cc = col0 + bj * 128;
            const v4u xo = *(const v4u*)(OG + o2), xg = *(const v4u*)(Gt + o2), xb = *(const v4u*)(GB + o2);
            const f32x4 n0 = *(const f32x4*)(X.gn + (cc & 511)), n1 = *(const f32x4*)(X.gn + (cc & 511) + 4), p0 = *(const f32x4*)(X.pscale + cc), p1 = *(const f32x4*)(X.pscale + cc + 4);
            const unsigned ao[4] = {xo.x, xo.y, xo.z, xo.w}, ag[4] = {xg.x, xg.y, xg.z, xg.w}, ab[4] = {xb.x, xb.y, xb.z, xb.w};
            f32x4 r0, r1;
#pragma unroll
            for (int j = 0; j < 2; ++j) {
                r0[2 * j] = bf2f(ag[j] & 0xffffu) * (bf2f(ao[j] & 0xffffu) * rs * n0[2 * j]) + sigmoidf_(bf2f(ab[j] & 0xffffu)) * (v[bj][0][2 * j] * p0[2 * j]);
                r0[2 * j + 1] = bf2f(ag[j] >> 16) * (bf2f(ao[j] >> 16) * rs * n0[2 * j + 1]) + sigmoidf_(bf2f(ab[j] >> 16)) * (v[bj][0][2 * j + 1] * p0[2 * j + 1]);
                r1[2 * j] = bf2f(ag[2 + j] & 0xffffu) * (bf2f(ao[2 + j] & 0xffffu) * rs * n1[2 * j]) + sigmoidf_(bf2f(ab[2 + j] & 0xffffu)) * (v[bj][1][2 * j] * p1[2 * j]);
                r1[2 * j + 1] = bf2f(ag[2 + j] >> 16) * (bf2f(ao[2 + j] >> 16) * rs * n1[2 * j + 1]) + sigmoidf_(bf2f(ab[2 + j] >> 16)) * (v[bj][1][2 * j + 1] * p1[2 * j + 1]); }
            ST16(X, rm, (unsigned)(o2 * 2), pk8(r0, r1)); }
        return 0.f;
    }
    if (u.st == 2) {
        const float rs = __builtin_amdgcn_rsqf(((const float*)(X.ctl + CW_SSQ1))[row] * (1.f / DM) + EPS);
        const __amdgpu_buffer_rsrc_t rh = __builtin_amdgcn_make_buffer_rsrc((void*)(X.ws + WS_HID), (short)0, (int)((size_t)M * FF * 2), 0x00020000);
#pragma unroll
        for (int bj = 0; bj < 2; ++bj) { f32x4 v0 = v[bj][0] * rs, v1 = v[bj][1] * rs;
#pragma unroll
            for (int j = 0; j < 4; ++j) { const float a = fmaxf(v0[j], 0.f), b = fmaxf(v1[j], 0.f); v0[j] = a * a; v1[j] = b * b; }
            ST16(X, rh, (unsigned)(((size_t)row * FF + col0 + bj * 128) * 2), pk8(v0, v1)); }
        return 0.f;
    }
    const size_t off = (size_t)row * DM + col0; float ss = 0.f;
    if (u.st == 1) {
        const float* xin = (row < NP) ? X.xp : X.xs - (size_t)NP * DM;
        const __amdgpu_buffer_rsrc_t rb = __builtin_amdgcn_make_buffer_rsrc((void*)(X.ws + WS_X1B), (short)0, (int)((size_t)M * DM * 2), 0x00020000);
#pragma unroll
        for (int bj = 0; bj < 2; ++bj) { const f32x4 a0 = *(const f32x4*)(xin + off + bj * 128), a1 = *(const f32x4*)(xin + off + bj * 128 + 4);
            const f32x4 v0 = a0 + v[bj][0], v1 = a1 + v[bj][1];
            ST16(X, rb, (unsigned)((off + bj * 128) * 2), pk8(v0, v1));
            ss += (v0[0] * v0[0] + v0[1] * v0[1]) + (v0[2] * v0[2] + v0[3] * v0[3]) + (v1[0] * v1[0] + v1[1] * v1[1]) + (v1[2] * v1[2] + v1[3] * v1[3]); }
        ss += __shfl_xor(ss, 16); ss += __shfl_xor(ss, 32);
        float old = 0.f; if (fq == 0) old = atomicAdd((float*)(X.ctl + CW_SSQ1) + row, ss);
        return old;
    } else {
        const bf16* x1 = (const bf16*)(X.ws + WS_X1B); float* xo = X.out + OUT_Y;
#pragma unroll
        for (int bj = 0; bj < 2; ++bj) { const v4u xa = *(const v4u*)(x1 + off + bj * 128);
            const f32x4 a0 = (f32x4){bf2f(xa.x & 0xffffu), bf2f(xa.x >> 16), bf2f(xa.y & 0xffffu), bf2f(xa.y >> 16)}, a1 = (f32x4){bf2f(xa.z & 0xffffu), bf2f(xa.z >> 16), bf2f(xa.w & 0xffffu), bf2f(xa.w >> 16)};
            const f32x4 v0 = a0 + v[bj][0], v1 = a1 + v[bj][1];
            *(f32x4*)(xo + off + bj * 128) = v0; *(f32x4*)(xo + off + bj * 128 + 4) = v1;
            ss += (v0[0] * v0[0] + v0[1] * v0[1]) + (v0[2] * v0[2] + v0[3] * v0[3]) + (v1[0] * v1[0] + v1[1] * v1[1]) + (v1[2] * v1[2] + v1[3] * v1[3]); }
        ss += __shfl_xor(ss, 16); ss += __shfl_xor(ss, 32);
        if (fq == 0) atomicAdd((float*)(X.ctl + CW_SSQ2) + row, ss);
    }
    return 0.f;
}
__device__ __forceinline__ void wait_count(unsigned* word, unsigned need, unsigned* tmo) {
    if (threadIdx.x < 64) {
        unsigned polls = 0;
        while ((unsigned)__builtin_amdgcn_readfirstlane(__hip_atomic_load(word, __ATOMIC_RELAXED, __HIP_MEMORY_SCOPE_AGENT)) < need) {
            if ((++polls & 1023u) == 0u) { if (__builtin_amdgcn_readfirstlane(__hip_atomic_load(tmo, __ATOMIC_RELAXED, __HIP_MEMORY_SCOPE_AGENT)) != 0u) break;
                if (polls > (1u << 22)) { if (threadIdx.x == 0) __hip_atomic_store(tmo, 1u, __ATOMIC_RELAXED, __HIP_MEMORY_SCOPE_AGENT); break; } }
            __builtin_amdgcn_s_sleep(2); }
        __builtin_amdgcn_fence(__ATOMIC_ACQUIRE, "agent");
        asm volatile("s_waitcnt vmcnt(0)" ::: "memory");
    }
    asm volatile("" ::: "memory"); __builtin_amdgcn_s_barrier(); asm volatile("" ::: "memory");
}
__device__ __forceinline__ void a_ready(const Ctx& X, const SUnit& u) {
    if (u.st == 0) return;
    unsigned* w = X.ctl + (u.st == 1 ? CW_CNTP : (u.st == 2 ? CW_CNT5 : CW_CNT6)) + 64 * u.pm;
    wait_count(w, u.st >= 3 ? 256u : 64u, X.ctl + CW_TMO);
}
__device__ __forceinline__ void epi2_comp(const Ctx& X, const SUnit& u, const f32x4 (&v)[2][2], float ssq, int ai, int m, int wr, int wc, int fr, int fq) {
    const int row = u.pm * 256 + ai * 128 + wr * 64 + m * 16 + fr, col0 = u.pn * 256 + wc * 32 + 8 * fq;
    const float rs = __builtin_amdgcn_rsqf(ssq * (1.f / DM) + EPS);
    const __amdgpu_buffer_rsrc_t rh = __builtin_amdgcn_make_buffer_rsrc((void*)(X.ws + WS_HID), (short)0, (int)((size_t)M * FF * 2), 0x00020000);
#pragma unroll
    for (int bj = 0; bj < 2; ++bj) { f32x4 v0 = v[bj][0] * rs, v1 = v[bj][1] * rs;
#pragma unroll
        for (int j = 0; j < 4; ++j) { const float a = fmaxf(v0[j], 0.f), b = fmaxf(v1[j], 0.f); v0[j] = a * a; v1[j] = b * b; }
        ST16(X, rh, (unsigned)(((size_t)row * FF + col0 + bj * 128) * 2), pk8(v0, v1)); }
}
typedef const __attribute__((address_space(1))) f32x4* gptr4;
__device__ __forceinline__ void epi0_comp(const Ctx& X, const SUnit& u, const f32x4 (&v)[2][2], float ssq, const f32x4 (&nv)[2][2], const f32x4 (&pv)[2][2], int ai, int m, int wr, int wc, int fr, int fq) {
    const int row = u.pm * 256 + ai * 128 + wr * 64 + m * 16 + fr, col0 = u.pn * 256 + wc * 32 + 8 * fq;
    const float rs = __builtin_amdgcn_rsqf(ssq * (1.f / DV) + EPS);
    const __amdgpu_buffer_rsrc_t rm = __builtin_amdgcn_make_buffer_rsrc((void*)(X.ws + WS_MB), (short)0, (int)((size_t)M * DM * 2), 0x00020000);
    const bf16* OG = (const bf16*)(X.ws + WS_OG); const bf16* Gt = (const bf16*)(X.ws + WS_R); const bf16* GB = (const bf16*)(X.ws + WS_GB);
    v4u xo[2], xg[2], xb[2];
#pragma unroll
    for (int bj = 0; bj < 2; ++bj) { const size_t o2 = (size_t)row * DM + col0 + bj * 128; xo[bj] = *(const v4u*)(OG + o2); xg[bj] = *(const v4u*)(Gt + o2); xb[bj] = *(const v4u*)(GB + o2); }
#pragma unroll
    for (int bj = 0; bj < 2; ++bj) { const size_t o2 = (size_t)row * DM + col0 + bj * 128;
        const unsigned ao[4] = {xo[bj].x, xo[bj].y, xo[bj].z, xo[bj].w}, ag[4] = {xg[bj].x, xg[bj].y, xg[bj].z, xg[bj].w}, ab[4] = {xb[bj].x, xb[bj].y, xb[bj].z, xb[bj].w};
        const f32x4 n0 = nv[bj][0] * rs, n1 = nv[bj][1] * rs, p0 = pv[bj][0], p1 = pv[bj][1];
        f32x4 r0, r1;
#pragma unroll
        for (int j = 0; j < 2; ++j) {
            r0[2 * j] = bf2f(ag[j] & 0xffffu) * (bf2f(ao[j] & 0xffffu) * n0[2 * j]) + sigmoidf_(bf2f(ab[j] & 0xffffu)) * (v[bj][0][2 * j] * p0[2 * j]);
            r0[2 * j + 1] = bf2f(ag[j] >> 16) * (bf2f(ao[j] >> 16) * n0[2 * j + 1]) + sigmoidf_(bf2f(ab[j] >> 16)) * (v[bj][0][2 * j + 1] * p0[2 * j + 1]);
            r1[2 * j] = bf2f(ag[2 + j] & 0xffffu) * (bf2f(ao[2 + j] & 0xffffu) * n1[2 * j]) + sigmoidf_(bf2f(ab[2 + j] & 0xffffu)) * (v[bj][1][2 * j] * p1[2 * j]);
            r1[2 * j + 1] = bf2f(ag[2 + j] >> 16) * (bf2f(ao[2 + j] >> 16) * n1[2 * j + 1]) + sigmoidf_(bf2f(ab[2 + j] >> 16)) * (v[bj][1][2 * j + 1] * p1[2 * j + 1]); }
        ST16(X, rm, (unsigned)(o2 * 2), pk8(r0, r1)); }
}
__device__ __forceinline__ void epi1_load(const Ctx& X, const SUnit& u, int ai, int m, int wr, int wc, int fr, int fq, f32x4 (&xa)[4]) {
    const int row = u.pm * 256 + ai * 128 + wr * 64 + m * 16 + fr, col0 = u.pn * 256 + wc * 32 + 8 * fq;
    const float* xin = ((row < NP) ? X.xp : X.xs - (size_t)NP * DM) + (size_t)row * DM + col0;
    xa[0] = *(const f32x4*)(xin); xa[1] = *(const f32x4*)(xin + 4); xa[2] = *(const f32x4*)(xin + 128); xa[3] = *(const f32x4*)(xin + 132);
}
__device__ __forceinline__ float epi1_comp(const Ctx& X, const SUnit& u, const f32x4 (&v)[2][2], const f32x4 (&xa)[4], int ai, int m, int wr, int wc, int fr, int fq) {
    const int row = u.pm * 256 + ai * 128 + wr * 64 + m * 16 + fr, col0 = u.pn * 256 + wc * 32 + 8 * fq;
    const size_t off = (size_t)row * DM + col0; float ss = 0.f;
    const __amdgpu_buffer_rsrc_t rb = __builtin_amdgcn_make_buffer_rsrc((void*)(X.ws + WS_X1B), (short)0, (int)((size_t)M * DM * 2), 0x00020000);
#pragma unroll
    for (int bj = 0; bj < 2; ++bj) { const f32x4 v0 = xa[2 * bj] + v[bj][0], v1 = xa[2 * bj + 1] + v[bj][1];
        ST16(X, rb, (unsigned)((off + bj * 128) * 2), pk8(v0, v1));
        ss += (v0[0] * v0[0] + v0[1] * v0[1]) + (v0[2] * v0[2] + v0[3] * v0[3]) + (v1[0] * v1[0] + v1[1] * v1[1]) + (v1[2] * v1[2] + v1[3] * v1[3]); }
    ss += __shfl_xor(ss, 16); ss += __shfl_xor(ss, 32);
    float old = 0.f; if (fq == 0) old = atomicAdd((float*)(X.ctl + CW_SSQ1) + row, ss);
    return old;
}
__device__ __forceinline__ void x1_load(const Ctx& X, const SUnit& u, int ai, int m, int wr, int wc, int fr, int fq, v4u (&xa)[2]) {
    const int row = u.pm * 256 + ai * 128 + wr * 64 + m * 16 + fr, col0 = u.pn * 256 + wc * 32 + 8 * fq;
    const bf16* x1 = (const bf16*)(X.ws + WS_X1B) + (size_t)row * DM + col0; xa[0] = *(const v4u*)x1; xa[1] = *(const v4u*)(x1 + 128);
}
__device__ __forceinline__ float x2_rg(f32x4 (&v)[2][2], const v4u (&xr)[2]) {
    float ss = 0.f;
#pragma unroll
    for (int bj = 0; bj < 2; ++bj) { const v4u xa = xr[bj];
        v[bj][0] += (f32x4){bf2f(xa.x & 0xffffu), bf2f(xa.x >> 16), bf2f(xa.y & 0xffffu), bf2f(xa.y >> 16)}; v[bj][1] += (f32x4){bf2f(xa.z & 0xffffu), bf2f(xa.z >> 16), bf2f(xa.w & 0xffffu), bf2f(xa.w >> 16)};
        const f32x4 v0 = v[bj][0], v1 = v[bj][1];
        ss += (v0[0] * v0[0] + v0[1] * v0[1]) + (v0[2] * v0[2] + v0[3] * v0[3]) + (v1[0] * v1[0] + v1[1] * v1[1]) + (v1[2] * v1[2] + v1[3] * v1[3]); }
    ss += __shfl_xor(ss, 16); ss += __shfl_xor(ss, 32);
    return ss;
}
__device__ __forceinline__ void y_rg(const Ctx& X, const SUnit& u, const f32x4 (&v)[2][2], float rstd, int ai, int m, int wr, int wc, int fr, int fq) {
    const int row = u.pm * 256 + ai * 128 + wr * 64 + m * 16 + fr, col0 = u.pn * 256 + wc * 32 + 8 * fq;
    float* yo = X.out + OUT_Y + (size_t)row * DM + col0;
#pragma unroll
    for (int bj = 0; bj < 2; ++bj) { const f32x4 g0 = *(gptr4)(X.gfin + col0 + bj * 128), g1 = *(gptr4)(X.gfin + col0 + bj * 128 + 4);
        *(f32x4*)(yo + bj * 128) = v[bj][0] * rstd * g0; *(f32x4*)(yo + bj * 128 + 4) = v[bj][1] * rstd * g1; }
}
__device__ __forceinline__ void gemm_stream(LAS unsigned char* lds, const Ctx X, const int G, const int c) {
    const int tid = threadIdx.x, wid = __builtin_amdgcn_readfirstlane(tid >> 6), lane = tid & 63, wr = wid >> 2, wc = wid & 3, fr = lane & 15, fq = lane >> 4;
    unsigned RA2[2], RB2[2], C2[2];
#pragma unroll
    for (int i = 0; i < 2; ++i) { int R, C; stage_rc(tid * 16 + i * 8192, R, C); RA2[i] = (unsigned)R * 2u; RB2[i] = (unsigned)((R & ~31) + perm32(R & 31)) * 2u; C2[i] = (unsigned)C * 2u; }
    const size_t kstep = (size_t)(BK * 2);
    const unsigned ldsw = (unsigned)wid * 1024u;
    const int aoff = lds_byte(wr * 64 + fr, fq * 8), boff = lds_byte(wc * 32 + fr, fq * 8);
#define GS_LDA(u) ((u).st == 0 ? 1024 : ((u).st >= 3 ? FF : DM))
#define GS_LDB(u) ((u).st == 0 ? 256 : ((u).st >= 3 ? FF : DM))
#define GS_ABASE(u) ((const char*)X.ws + ((u).st == 0 ? WS_PB : ((u).st == 1 ? WS_MB : ((u).st == 2 ? WS_X1B : WS_HID))) + ((size_t)(u).pm * 256 * GS_LDA(u) + (size_t)(u).kt0 * BK + ((u).st == 0 ? ((u).pn >> 1) * 256 : 0)) * 2)
#define GS_BBASE(u) ((const char*)X.ws + ((u).st == 0 ? WS_WPOOL : ((u).st == 1 ? WS_WOUT : ((u).st == 2 ? WS_WUP : WS_WDN))) + ((size_t)(u).pn * 256 * GS_LDB(u) + (size_t)(u).kt0 * BK) * 2)
#define PG8_SA(b, h) (((b) * 2 + (h)) * HTB)
#define PG8_SB(b, h) ((4 + (b) * 2 + (h)) * HTB)
#define PG8_STAGE(bufoff, gbase, R2, ld) do { _Pragma("unroll") for (int _i = 0; _i < 2; ++_i) \
        __builtin_amdgcn_global_load_lds((const unsigned*)((const char*)(gbase) + ((R2)[_i] * (unsigned)(ld) + C2[_i])), (LAS unsigned*)(lds + (bufoff) + ldsw + _i * 8192), 16, 0, 0); } while (0)
#define PG8_LDA(dst, b, h) do { _Pragma("unroll") for (int m = 0; m < 4; ++m) _Pragma("unroll") for (int k = 0; k < 2; ++k) dst[m][k] = *(const LAS bf16x8*)(lds + PG8_SA(b, h) + aoff + m * 2048 + k * 1024); } while (0)
#define PG8_LDB(dst, b, h) do { _Pragma("unroll") for (int n = 0; n < 2; ++n) _Pragma("unroll") for (int k = 0; k < 2; ++k) dst[n][k] = *(const LAS bf16x8*)(lds + PG8_SB(b, h) + boff + n * 2048 + k * 1024); } while (0)
#define PG8_MMA(ai, bj, At, Bt) do { __builtin_amdgcn_s_setprio(1); _Pragma("unroll") for (int m = 0; m < 4; ++m) _Pragma("unroll") for (int n = 0; n < 2; ++n) _Pragma("unroll") for (int k = 0; k < 2; ++k) \
        acc[ai][bj][m][n] = __builtin_amdgcn_mfma_f32_16x16x32_bf16(Bt[n][k], At[m][k], acc[ai][bj][m][n], 0, 0, 0); __builtin_amdgcn_s_setprio(0); } while (0)
#define PG8_WAIT_V(n) asm volatile("s_waitcnt vmcnt(" #n ")" ::: "memory")
#define PG8_WAIT_L(n) asm volatile("s_waitcnt lgkmcnt(" #n ")" ::: "memory")
#define PG8_BAR __builtin_amdgcn_s_barrier()
#define PG8_SCHED __builtin_amdgcn_sched_barrier(0)
    SUnit cur, nxt; int ui = 0, pend = -1;
    if (!su_next(0, G, c, cur)) return;
    f32x4 acc[2][2][4][2];
#pragma unroll
    for (int a = 0; a < 2; ++a)
#pragma unroll
        for (int b = 0; b < 2; ++b)
#pragma unroll
            for (int m = 0; m < 4; ++m)
#pragma unroll
                for (int n = 0; n < 2; ++n) acc[a][b][m][n] = (f32x4){0.f, 0.f, 0.f, 0.f};
    bf16x8 At[4][2], B0[2][2], B1[2][2];
    const char* cA = GS_ABASE(cur); const char* cB = GS_BBASE(cur); int clA = GS_LDA(cur), clB = GS_LDB(cur);
#define GS_PROLOGUE() do { a_ready(X, cur); const size_t hA_ = (size_t)HALF * clA * 2, hB_ = (size_t)HALF * clB * 2; \
    PG8_STAGE(PG8_SB(0, 0), cB, RB2, clB); PG8_STAGE(PG8_SB(0, 1), cB + hB_, RB2, clB); PG8_STAGE(PG8_SA(0, 0), cA, RA2, clA); PG8_STAGE(PG8_SA(0, 1), cA + hA_, RA2, clA); \
    if (wr == 1) PG8_BAR; \
    PG8_WAIT_V(2); PG8_BAR; \
    PG8_STAGE(PG8_SB(1, 0), cB + kstep, RB2, clB); PG8_STAGE(PG8_SA(1, 0), cA + kstep, RA2, clA); PG8_STAGE(PG8_SB(1, 1), cB + hB_ + kstep, RB2, clB); \
    PG8_WAIT_V(6); PG8_BAR; } while (0)
    GS_PROLOGUE();
    for (;;) {
        const bool has_next = su_next(ui + 1, G, c, nxt);
        const bool early = has_next && !nxt.late;
        const char* nA = early ? GS_ABASE(nxt) : cA; const char* nB = early ? GS_BBASE(nxt) : cB; const int nlA = early ? GS_LDA(nxt) : clA, nlB = early ? GS_LDB(nxt) : clB;
        const int nt = cur.nkt; const size_t hA = (size_t)HALF * clA * 2;
#pragma unroll 1
        for (int t = 0; t < nt; t += 2) {
            const bool last = (t == nt - 2);
            const char* a1 = cA + (size_t)(t + 1) * kstep;
            const char* a2 = last ? nA : cA + (size_t)(t + 2) * kstep; const char* b2 = last ? nB : cB + (size_t)(t + 2) * kstep;
            const char* a3 = a2 + kstep; const char* b3 = b2 + kstep;
            const int lA2 = last ? nlA : clA, lB2 = last ? nlB : clB; const size_t hA2 = (size_t)HALF * lA2 * 2, hB2 = (size_t)HALF * lB2 * 2;
            if (last && early) a_ready(X, nxt);
            PG8_LDB(B0, 0, 0); PG8_LDB(B1, 0, 1); PG8_SCHED; PG8_LDA(At, 0, 0); PG8_STAGE(PG8_SA(1, 1), a1 + hA, RA2, clA);
            PG8_WAIT_V(8); PG8_WAIT_L(0); PG8_BAR; PG8_MMA(0, 0, At, B0); PG8_MMA(0, 1, At, B1); PG8_BAR; PG8_SCHED;
            PG8_LDA(At, 0, 1); PG8_STAGE(PG8_SB(0, 0), b2, RB2, lB2); PG8_STAGE(PG8_SB(0, 1), b2 + hB2, RB2, lB2); PG8_STAGE(PG8_SA(0, 0), a2, RA2, lA2);
            PG8_WAIT_V(8); PG8_WAIT_L(0); PG8_BAR; PG8_MMA(1, 0, At, B0); PG8_MMA(1, 1, At, B1); PG8_BAR; PG8_SCHED;
            PG8_LDB(B0, 1, 0); PG8_LDB(B1, 1, 1); PG8_SCHED; PG8_LDA(At, 1, 0); PG8_STAGE(PG8_SA(0, 1), a2 + hA2, RA2, lA2);
            PG8_WAIT_V(8); PG8_WAIT_L(0); PG8_BAR; PG8_MMA(0, 0, At, B0); PG8_MMA(0, 1, At, B1); PG8_BAR; PG8_SCHED;
            PG8_LDA(At, 1, 1); PG8_STAGE(PG8_SB(1, 0), b3, RB2, lB2); PG8_STAGE(PG8_SB(1, 1), b3 + hB2, RB2, lB2); PG8_STAGE(PG8_SA(1, 0), a3, RA2, lA2);
            PG8_WAIT_V(8); PG8_WAIT_L(0); PG8_BAR; PG8_MMA(1, 0, At, B0); PG8_MMA(1, 1, At, B1);
            if (pend >= 0) { PG8_WAIT_V(0); if (lane == 0) __hip_atomic_fetch_add(X.ctl + pend, 1u, __ATOMIC_RELAXED, __HIP_MEMORY_SCOPE_AGENT); pend = -1; }
            PG8_BAR; PG8_SCHED;
        }
        if (wr == 0) PG8_BAR;
        int fr_ = fr, fq_ = fq; asm volatile("" : "+v"(fr_), "+v"(fq_));
        if (cur.st == 3 && G == 256) {
            LAS float* XP = (LAS float*)(lds + STAGE_BYTES); LAS float* XR = XP + 1024;
            { v4u xr[2][2]; x1_load(X, cur, 0, 0, wr, wc, fr_, fq_, xr[0]);
#pragma unroll
            for (int k = 0; k < 8; ++k) { const int ai = k >> 2, m = k & 3;
                    if (k < 7) x1_load(X, cur, (k + 1) >> 2, (k + 1) & 3, wr, wc, fr_, fq_, xr[(k + 1) & 1]);
                    f32x4 v[2][2] = {{acc[ai][0][m][0], acc[ai][0][m][1]}, {acc[ai][1][m][0], acc[ai][1][m][1]}};
                    const float ss = x2_rg(v, xr[k & 1]);
                    acc[ai][0][m][0] = v[0][0]; acc[ai][0][m][1] = v[0][1]; acc[ai][1][m][0] = v[1][0]; acc[ai][1][m][1] = v[1][1];
                    if (fq_ == 0) XP[(ai * 128 + wr * 64 + m * 16 + fr_) * 4 + wc] = ss; } }
            PG8_WAIT_L(0); PG8_BAR; asm volatile("" ::: "memory");
            float* xs_ = (float*)(X.ws + WS_XS) + (size_t)cur.pm * 2048;
            if (tid < 256) { const f32x4 p4 = *(const LAS f32x4*)(XP + tid * 4); __hip_atomic_store(xs_ + cur.pn * 256 + tid, (p4[0] + p4[1]) + (p4[2] + p4[3]), __ATOMIC_RELAXED, __HIP_MEMORY_SCOPE_AGENT);
                asm volatile("s_waitcnt vmcnt(0)" ::: "memory");
                if (lane == 0) __hip_atomic_fetch_add(X.ctl + CW_CNT7 + 64 * cur.pm, 1u, __ATOMIC_RELAXED, __HIP_MEMORY_SCOPE_AGENT); }
            wait_count(X.ctl + CW_CNT7 + 64 * cur.pm, 32u, X.ctl + CW_TMO);
            if (tid < 256) { float tot = 0.f;
#pragma unroll
                for (int q = 0; q < 8; ++q) tot += xs_[q * 256 + tid];
                XR[tid] = __builtin_amdgcn_rsqf(tot * (1.f / DM) + EPS); }
            PG8_WAIT_L(0); PG8_BAR; asm volatile("" ::: "memory");
#pragma unroll
            for (int ai = 0; ai < 2; ++ai)
#pragma unroll
                for (int m = 0; m < 4; ++m) { const f32x4 v[2][2] = {{acc[ai][0][m][0], acc[ai][0][m][1]}, {acc[ai][1][m][0], acc[ai][1][m][1]}};
                    y_rg(X, cur, v, XR[ai * 128 + wr * 64 + m * 16 + fr_], ai, m, wr, wc, fr_, fq_); asm volatile("" ::: "memory"); }
            PG8_WAIT_L(0); PG8_BAR; asm volatile("" ::: "memory");
        } else if (cur.st != 4) { float olds[8];
            if (cur.st == 1) { f32x4 xa[2][4]; epi1_load(X, cur, 0, 0, wr, wc, fr_, fq_, xa[0]);
#pragma unroll
                for (int k = 0; k < 8; ++k) { const int ai = k >> 2, m = k & 3;
                    if (k < 7) epi1_load(X, cur, (k + 1) >> 2, (k + 1) & 3, wr, wc, fr_, fq_, xa[(k + 1) & 1]);
                    const f32x4 v[2][2] = {{acc[ai][0][m][0], acc[ai][0][m][1]}, {acc[ai][1][m][0], acc[ai][1][m][1]}}; olds[k] = epi1_comp(X, cur, v, xa[k & 1], ai, m, wr, wc, fr_, fq_); }
                asm volatile("" :: "v"(olds[0]), "v"(olds[1]), "v"(olds[2]), "v"(olds[3]), "v"(olds[4]), "v"(olds[5]), "v"(olds[6]), "v"(olds[7]));
            } else if (cur.st == 2) { float sq[8];
#pragma unroll
                for (int k = 0; k < 8; ++k) sq[k] = ((const float*)(X.ctl + CW_SSQ1))[cur.pm * 256 + (k >> 2) * 128 + wr * 64 + (k & 3) * 16 + fr_];
#pragma unroll
                for (int k = 0; k < 8; ++k) { const int ai = k >> 2, m = k & 3;
                    const f32x4 v[2][2] = {{acc[ai][0][m][0], acc[ai][0][m][1]}, {acc[ai][1][m][0], acc[ai][1][m][1]}}; epi2_comp(X, cur, v, sq[k], ai, m, wr, wc, fr_, fq_); }
            } else if (cur.st == 0) { float sq[8]; f32x4 nv[2][2], pv[2][2];
                { const int cc = cur.pn * 256 + wc * 32 + 8 * fq_;
#pragma unroll
                for (int bj = 0; bj < 2; ++bj) { nv[bj][0] = *(gptr4)(X.gn + ((cc + bj * 128) & 511)); nv[bj][1] = *(gptr4)(X.gn + ((cc + bj * 128) & 511) + 4); pv[bj][0] = *(gptr4)(X.pscale + cc + bj * 128); pv[bj][1] = *(gptr4)(X.pscale + cc + bj * 128 + 4); } }
#pragma unroll
                for (int k = 0; k < 8; ++k) sq[k] = ((const float*)(X.ctl + CW_SSQ))[(cur.pm * 256 + (k >> 2) * 128 + wr * 64 + (k & 3) * 16 + fr_) * 4 + (cur.pn >> 1)];
#pragma unroll
                for (int k = 0; k < 8; ++k) { const int ai = k >> 2, m = k & 3;
                    const f32x4 v[2][2] = {{acc[ai][0][m][0], acc[ai][0][m][1]}, {acc[ai][1][m][0], acc[ai][1][m][1]}}; epi0_comp(X, cur, v, sq[k], nv, pv, ai, m, wr, wc, fr_, fq_); }
            } else {
#pragma unroll
            for (int ai = 0; ai < 2; ++ai)
#pragma unroll
                for (int m = 0; m < 4; ++m) { const f32x4 v[2][2] = {{acc[ai][0][m][0], acc[ai][0][m][1]}, {acc[ai][1][m][0], acc[ai][1][m][1]}}; olds[ai * 4 + m] = epi_rg(X, cur, v, ai, m, wr, wc, fr_, fq_); }
            }
            if (cur.st < 3) {
                const int widx = (cur.st == 0 ? CW_CNTP : (cur.st == 1 ? CW_CNT5 : CW_CNT6)) + 64 * cur.pm;
                if (early) pend = widx;
                else { asm volatile("s_waitcnt vmcnt(0)" ::: "memory"); if (lane == 0) __hip_atomic_fetch_add(X.ctl + widx, 1u, __ATOMIC_RELAXED, __HIP_MEMORY_SCOPE_AGENT); } }
        } else {
            const __amdgpu_buffer_rsrc_t rsl = __builtin_amdgcn_make_buffer_rsrc((void*)(X.ws + WS_SLAB + (size_t)(cur.r * 8 + cur.s) * 131072), (short)0, 131072, 0x00020000);
#pragma unroll
            for (int ai = 0; ai < 2; ++ai)
#pragma unroll
                for (int bj = 0; bj < 2; ++bj)
#pragma unroll
                    for (int m = 0; m < 4; ++m) st16_wt(rsl, (unsigned)((((ai * 2 + bj) * 4 + m)) * 8192 + tid * 16), pk8(acc[ai][bj][m][0], acc[ai][bj][m][1]));
            asm volatile("s_waitcnt vmcnt(0)" ::: "memory");
            if (lane == 0) __hip_atomic_fetch_add(X.ctl + CW_CNTS + 64 * cur.r, 1u, __ATOMIC_RELAXED, __HIP_MEMORY_SCOPE_AGENT);
            wait_count(X.ctl + CW_CNTS + 64 * cur.r, 64u, X.ctl + CW_TMO);
            const int rai = cur.s >> 2, rm = cur.s & 3;
            f32x4 v[2][2] = {{(f32x4){0.f, 0.f, 0.f, 0.f}, (f32x4){0.f, 0.f, 0.f, 0.f}}, {(f32x4){0.f, 0.f, 0.f, 0.f}, (f32x4){0.f, 0.f, 0.f, 0.f}}};
            const char* sb = (const char*)(X.ws + WS_SLAB) + (size_t)cur.r * 8 * 131072 + (size_t)((rai * 2) * 4 + rm) * 8192 + (size_t)tid * 16;
#pragma unroll
            for (int p = 0; p < 8; ++p)
#pragma unroll
                for (int bj = 0; bj < 2; ++bj) { const v4u x = *(const v4u*)(sb + (size_t)p * 131072 + (size_t)(bj * 4) * 8192);
                    v[bj][0] += (f32x4){bf2f(x.x & 0xffffu), bf2f(x.x >> 16), bf2f(x.y & 0xffffu), bf2f(x.y >> 16)};
                    v[bj][1] += (f32x4){bf2f(x.z & 0xffffu), bf2f(x.z >> 16), bf2f(x.w & 0xffffu), bf2f(x.w >> 16)}; }
            if (G != 256) (void)epi_rg(X, cur, v, rai, rm, wr, wc, fr_, fq_);
            else {
                LAS float* XP = (LAS float*)(lds + STAGE_BYTES); LAS float* XR = XP + 1024;
                v4u xr4[2]; x1_load(X, cur, rai, rm, wr, wc, fr_, fq_, xr4); const float ss = x2_rg(v, xr4);
                if (fq_ == 0) XP[(wr * 16 + fr_) * 4 + wc] = ss;
                PG8_WAIT_L(0); PG8_BAR; asm volatile("" ::: "memory");
                const int gi = (cur.pm - 32) * 8 + cur.s; float* xs4 = (float*)(X.ws + WS_XS4) + (size_t)gi * 256;
                if (tid < 32) { const f32x4 p4 = *(const LAS f32x4*)(XP + tid * 4); __hip_atomic_store(xs4 + cur.pn * 32 + tid, (p4[0] + p4[1]) + (p4[2] + p4[3]), __ATOMIC_RELAXED, __HIP_MEMORY_SCOPE_AGENT);
                    asm volatile("s_waitcnt vmcnt(0)" ::: "memory");
                    if (lane == 0) __hip_atomic_fetch_add(X.ctl + CW_CNT8 + 64 * gi, 1u, __ATOMIC_RELAXED, __HIP_MEMORY_SCOPE_AGENT); }
                wait_count(X.ctl + CW_CNT8 + 64 * gi, 8u, X.ctl + CW_TMO);
                if (tid < 32) { float tot = 0.f;
#pragma unroll
                    for (int q = 0; q < 8; ++q) tot += xs4[q * 32 + tid];
                    XR[tid] = __builtin_amdgcn_rsqf(tot * (1.f / DM) + EPS); }
                PG8_WAIT_L(0); PG8_BAR; asm volatile("" ::: "memory");
                y_rg(X, cur, v, XR[wr * 16 + fr_], rai, rm, wr, wc, fr_, fq_);
            }
        }
        if (!has_next) break;
#pragma unroll
        for (int a = 0; a < 2; ++a)
#pragma unroll
            for (int b = 0; b < 2; ++b)
#pragma unroll
                for (int m = 0; m < 4; ++m)
#pragma unroll
                    for (int n = 0; n < 2; ++n) acc[a][b][m][n] = (f32x4){0.f, 0.f, 0.f, 0.f};
        cur = nxt; ++ui;
        if (early) { cA = nA; cB = nB; clA = nlA; clB = nlB; if (wr == 1) PG8_BAR; }
        else { PG8_WAIT_V(0); PG8_BAR; cA = GS_ABASE(cur); cB = GS_BBASE(cur); clA = GS_LDA(cur); clB = GS_LDB(cur); GS_PROLOGUE(); }
    }
    PG8_WAIT_V(0);
    PG8_BAR;
#undef GS_PROLOGUE
#undef GS_LDA
#undef GS_LDB
#undef GS_ABASE
#undef GS_BBASE
#undef PG8_SA
#undef PG8_SB
#undef PG8_STAGE
#undef PG8_LDA
#undef PG8_LDB
#undef PG8_MMA
#undef PG8_WAIT_V
#undef PG8_WAIT_L
#undef PG8_BAR
#undef PG8_SCHED
}
}

#define XB_TMO      128
#define XB_XCNT(j)  (256  + 64 * (j))
#define XB_XSUB(j)  (1280 + 64 * (j))
#define XB_XGEN(j)  (2304 + 64 * (j))
#define XB_TOP      3328
#define XB_TOPGEN   3392
#define XCD_BAR_WORDS 3456
#define XB_SPIN_CAP (1u << 18)
__device__ __forceinline__ unsigned xb_ld(unsigned* p)              { return __hip_atomic_load(p, __ATOMIC_RELAXED, __HIP_MEMORY_SCOPE_AGENT); }
__device__ __forceinline__ unsigned xb_add(unsigned* p, unsigned v) { return __hip_atomic_fetch_add(p, v, __ATOMIC_RELAXED, __HIP_MEMORY_SCOPE_AGENT); }
__device__ __forceinline__ unsigned xb_xcc_id() { return (unsigned)__builtin_amdgcn_s_getreg((3 << 11) | 20) & 0xFu; }
#define XB_SPIN(cond, bar) do { unsigned _sp = 0; while (cond) { __builtin_amdgcn_s_sleep(1); \
    if ((++_sp & 255u) == 0u) { if (xb_ld(&(bar)[XB_TMO])) break; if (_sp > XB_SPIN_CAP) { atomicAdd(&(bar)[XB_TMO], 1u); break; } } } } while (0)
struct XcdBarrier { unsigned* bar; unsigned x; volatile LAS unsigned* st; };
__device__ __forceinline__ XcdBarrier xcd_barrier_post(unsigned* bar, volatile LAS unsigned* st) {
    XcdBarrier b; b.bar = bar; b.x = xb_xcc_id(); b.st = st;
    if (threadIdx.x == 0) (void)xb_add(&bar[XB_XCNT(b.x)], 1u);
    return b;
}
__device__ __forceinline__ void xcd_barrier_complete(unsigned* bar, unsigned x, unsigned& nloc, unsigned& nx) {
    const unsigned G = gridDim.x * gridDim.y * gridDim.z;
    unsigned sum, cnt, mine, sp = 0u;
    for (;;) {
        sum = 0u; cnt = 0u; mine = 0u;
#pragma unroll
        for (unsigned j = 0; j < 16; ++j) { const unsigned c = xb_ld(&bar[XB_XCNT(j)]); sum += c; cnt += (c > 0u) ? 1u : 0u; mine = (j == x) ? c : mine; }
        if (sum == G) break;
        __builtin_amdgcn_s_sleep(1);
        if ((++sp & 255u) == 0u) { if (xb_ld(&bar[XB_TMO])) break; if (sp > XB_SPIN_CAP) { atomicAdd(&bar[XB_TMO], 1u); break; } }
    }
    nloc = mine > 0u ? mine : 1u; nx = cnt > 0u ? cnt : 1u;
}
__device__ __forceinline__ void xcd_barrier(const XcdBarrier& b) {
    asm volatile("s_waitcnt vmcnt(0)" ::: "memory");
    __syncthreads();
    if (threadIdx.x == 0) {
        unsigned* bar = b.bar;
        __builtin_amdgcn_s_waitcnt(0);
        unsigned nloc = b.st[0], nx = b.st[1];
        if (nloc == 0u) { xcd_barrier_complete(bar, b.x, nloc, nx); b.st[0] = nloc; b.st[1] = nx; }
        const unsigned old = xb_add(&bar[XB_XSUB(b.x)], 1u);
        const unsigned gen = old / nloc;
        if (old + 1u == (gen + 1u) * nloc) {
            __builtin_amdgcn_fence(__ATOMIC_RELEASE, "agent");
            asm volatile("s_waitcnt vmcnt(0)" ::: "memory");
            const unsigned og = xb_add(&bar[XB_TOP], 1u);
            const unsigned tg = og / nx;
            if (og + 1u == (tg + 1u) * nx) xb_add(&bar[XB_TOPGEN], 1u);
            else XB_SPIN(xb_ld(&bar[XB_TOPGEN]) == tg, bar);
            __builtin_amdgcn_fence(__ATOMIC_ACQUIRE, "agent");
            xb_add(&bar[XB_XGEN(b.x)], 1u);
            asm volatile("s_waitcnt vmcnt(0)" ::: "memory");
        } else {
            XB_SPIN(xb_ld(&bar[XB_XGEN(b.x)]) == gen, bar);
            __builtin_amdgcn_fence(__ATOMIC_ACQUIRE, "agent");
            asm volatile("s_waitcnt vmcnt(0)" ::: "memory");
        }
    }
    __syncthreads();
}

struct Frame {
    LAS unsigned char* lds;
    volatile LAS unsigned* MISC;
    unsigned* ctl;
    int tid, lane, wave, vcu, G;
    float* out; unsigned char* ws;
    __device__ __forceinline__ const float* inp(int k) const { const LAS unsigned* t = (const LAS unsigned*)(lds + PTAB_OFF) + 2 * k;
        const unsigned lo = __builtin_amdgcn_readfirstlane(t[0]), hi = __builtin_amdgcn_readfirstlane(t[1]); return (const float*)(((unsigned long long)hi << 32) | lo); }
};

template <bool SCALE>
__device__ __forceinline__ void tr_item(const float* W, int ldw, int scol, int ncols, const float* ks, bf16* WT, int ldt, int drow, int k0, LAS float* scr, int lane) {
    const int j = lane & 31, jc = (j < ncols) ? j : 0;
    const float* src = W + (size_t)(k0 + (lane >> 5)) * ldw + scol + jc;
    float v[32];
#pragma unroll
    for (int i = 0; i < 32; ++i) v[i] = src[(size_t)(2 * i) * ldw];
    if (SCALE) {
#pragma unroll
        for (int i = 0; i < 32; ++i) v[i] *= ks[k0 + 2 * i + (lane >> 5)]; }
    const float msk = (j < ncols) ? 1.f : 0.f;
#pragma unroll
    for (int i = 0; i < 32; ++i) scr[(2 * i + (lane >> 5)) * 33 + j] = v[i] * msk;
    LDS_WAIT(); asm volatile("" ::: "memory");
    const int c = lane & 7;
#pragma unroll
    for (int jj = 0; jj < 4; ++jj) { const int n = (lane >> 3) + 8 * jj; const LAS float* s = scr + (8 * c) * 33 + n;
        v4u o; o.x = cvt_pk_bf16(s[0 * 33], s[1 * 33]); o.y = cvt_pk_bf16(s[2 * 33], s[3 * 33]); o.z = cvt_pk_bf16(s[4 * 33], s[5 * 33]); o.w = cvt_pk_bf16(s[6 * 33], s[7 * 33]);
        *(v4u*)(WT + (size_t)(drow + n) * ldt + k0 + 8 * c) = o; }
    LDS_WAIT(); asm volatile("" ::: "memory");
}
__device__ __forceinline__ void p0_prologue(Frame& F, const int part, const int gw, const int NGW) {
    LAS float* scr = (LAS float*)(F.lds + F.wave * 16384);
    const int lane = F.lane;
    constexpr int I_IN = 32 * 360, I_OUT = 32 * 64, I_UP = 32 * 256, I_DN = 128 * 64, I_PL = 4 * 64;
    constexpr int NITEMS = I_IN + I_OUT + I_UP + I_DN + I_PL;
    unsigned char* ws = F.ws;
    for (int it = (part == 0 ? 0 : I_IN) + gw; it < (part == 0 ? I_IN : NITEMS); it += NGW) {
        int r = it;
        if (r < I_IN) { const int kb = r / 360, nb = r % 360, n0 = nb * 32; int scol, nc;
            if (n0 < 4096) { scol = n0; nc = 32; }
            else if (n0 < 8192) { const int t = (n0 - 4096) >> 8, w = (n0 - 4096) & 255; scol = (w < 128) ? 4096 + 128 * t + w : 7184 + 128 * t + (w - 128); nc = 32; }
            else if (n0 < 9216) { scol = 6160 + (n0 - 8192); nc = 32; }
            else if (n0 < 11264) { scol = 9232 + (n0 - 9216); nc = 32; }
            else if (n0 == 11264) { scol = 6144; nc = 16; } else { scol = 0; nc = 0; }
            tr_item<false>(F.inp(5), INW, scol, nc, nullptr, (bf16*)(ws + WS_WIN), DM, n0, kb * 64, scr, lane); continue; } r -= I_IN;
        if (r < I_OUT) { const int kb = r / 64, nb = r % 64; tr_item<false>(F.inp(11), DM, nb * 32, 32, nullptr, (bf16*)(ws + WS_WOUT), DM, nb * 32, kb * 64, scr, lane); continue; } r -= I_OUT;
        if (r < I_UP) { const int kb = r / 256, nb = r % 256; tr_item<true>(F.inp(13), FF, nb * 32, 32, F.inp(12), (bf16*)(ws + WS_WUP), DM, nb * 32, kb * 64, scr, lane); continue; } r -= I_UP;
        if (r < I_DN) { const int kb = r / 64, nb = r % 64; tr_item<false>(F.inp(14), DM, nb * 32, 32, nullptr, (bf16*)(ws + WS_WDN), FF, nb * 32, kb * 64, scr, lane); continue; } r -= I_DN;
        { const int gi = r / 64, q = r % 64, kb = q / 16, nb = q % 16; tr_item<false>(F.inp(9) + (size_t)gi * 256 * 512, 512, nb * 32, 32, nullptr, (bf16*)(ws + WS_WPOOL), 256, gi * 512 + nb * 32, kb * 64, scr, lane); }
    }
    if (part != 0) return;
    f32x4 gv[8];
#pragma unroll
    for (int j = 0; j < 8; ++j) gv[j] = ((const f32x4*)F.inp(4))[64 * j + lane];
    bf16* Hb = (bf16*)(ws + WS_H);
    for (int m = gw; m < M; m += NGW) {
        const float* xrow = (m < NP) ? F.inp(0) + (size_t)m * DM : F.inp(1) + (size_t)(m - NP) * DM;
        const f32x4* xr = (const f32x4*)xrow + lane; f32x4 v[8]; float s = 0.f;
#pragma unroll
        for (int j = 0; j < 8; ++j) { v[j] = xr[64 * j]; s += (v[j][0] * v[j][0] + v[j][1] * v[j][1]) + (v[j][2] * v[j][2] + v[j][3] * v[j][3]); }
        const float rs = __builtin_amdgcn_rsqf(wave_sum(s) * (1.f / DM) + EPS);
        v2u* o8 = (v2u*)(Hb + (size_t)m * DM) + lane;
#pragma unroll
        for (int j = 0; j < 8; ++j) { const f32x4 y = v[j] * rs * gv[j]; v2u w; w.x = cvt_pk_bf16(y[0], y[1]); w.y = cvt_pk_bf16(y[2], y[3]); o8[64 * j] = w; }
    }
}

constexpr int QP = 264;
constexpr int VP = 520;
__device__ __forceinline__ void gla_prep_item(Frame& F, int item) {
    const int c = item >> 2, h = item & 3, tid = F.tid, lane = F.lane, wid = F.wave;
    const bool smp = c >= NCH_P; const int r0 = c * 64;
    unsigned char* ws = F.ws;
    LAS bf16* Qs = (LAS bf16*)F.lds; LAS bf16* Ks = Qs + 64 * QP; LAS float* ALRs = (LAS float*)(F.lds + 67584); LAS float* TOT = (LAS float*)(F.lds + 71680); LAS bf16* Vs = (LAS bf16*)(F.lds + 72704);
    const bf16* Qg = (const bf16*)(ws + WS_Q); const bf16* Kg = (const bf16*)(ws + WS_K); const bf16* Vg = (const bf16*)(ws + WS_V);
#pragma unroll
    for (int j = 0; j < 4; ++j) { const int p = tid + 512 * j, row = p >> 5, c16 = p & 31;
        *(LAS v4u*)(Qs + row * QP + c16 * 8) = *(const v4u*)(Qg + (size_t)(r0 + row) * 1024 + h * 256 + c16 * 8);
        *(LAS v4u*)(Ks + row * QP + c16 * 8) = *(const v4u*)(Kg + (size_t)(r0 + row) * 1024 + h * 256 + c16 * 8); }
    if (tid < 256) *(LAS v4u*)(ALRs + tid * 4) = *(const v4u*)((const float*)(ws + WS_ALR) + (size_t)r0 * 16 + tid * 4);
    if (!smp) {
#pragma unroll
        for (int j = 0; j < 8; ++j) { const int p = tid + 512 * j, row = p >> 6, c16 = p & 63;
            *(LAS v4u*)(Vs + row * VP + c16 * 8) = *(const v4u*)(Vg + (size_t)(r0 + row) * 2048 + h * 512 + c16 * 8); } }
    const int d = tid & 255, half = tid >> 8;
    float wup[16];
#pragma unroll
    for (int j = 0; j < 16; ++j) wup[j] = F.inp(6)[j * 1024 + h * 256 + d];
    const float ba = F.inp(7)[h * 256 + d];
    __syncthreads();
    float bl[32]; float run = 0.f;
#pragma unroll
    for (int i = 0; i < 32; ++i) { const int t = 32 * half + i; float a = ba;
#pragma unroll
        for (int j4 = 0; j4 < 4; ++j4) { const f32x4 al = *(const LAS f32x4*)(ALRs + t * 16 + 4 * j4); a += al[0] * wup[4 * j4] + al[1] * wup[4 * j4 + 1] + al[2] * wup[4 * j4 + 2] + al[3] * wup[4 * j4 + 3]; }
        const float la = (fminf(a, 0.f) - __logf(1.f + __expf(-fabsf(a)))) * 0.0625f;
        if (smp && (i & 7) == 0) run = 0.f;
        run += la; bl[i] = run; }
    if (half == 0) TOT[d] = run;
    __syncthreads();
    if (!smp && half == 1) { const float off = TOT[d];
#pragma unroll
        for (int i = 0; i < 32; ++i) bl[i] += off; }
    unsigned kk[16];
#pragma unroll
    for (int i = 0; i < 32; i += 2) {
        const int t = 32 * half + i;
        const float e0 = __expf(bl[i]), e1 = __expf(bl[i + 1]), n0 = __expf(-bl[i]), n1 = __expf(-bl[i + 1]);
        const float q0 = bf2f(Qs[t * QP + d]) * e0, q1 = bf2f(Qs[(t + 1) * QP + d]) * e1;
        const float k0 = bf2f(Ks[t * QP + d]) * n0, k1 = bf2f(Ks[(t + 1) * QP + d]) * n1;
        const unsigned qp = cvt_pk_bf16(q0, q1), kp = cvt_pk_bf16(k0, k1);
        Qs[t * QP + d] = (bf16)(qp & 0xffffu); Qs[(t + 1) * QP + d] = (bf16)(qp >> 16);
        Ks[t * QP + d] = (bf16)(kp & 0xffffu); Ks[(t + 1) * QP + d] = (bf16)(kp >> 16);
        kk[i >> 1] = kp; }
    { bf16* ktt = (bf16*)(ws + WS_KTT) + ((size_t)(c * 4 + h) * 256 + d) * 64 + 32 * half;
#pragma unroll
        for (int j = 0; j < 4; ++j) *(v4u*)(ktt + 8 * j) = (v4u){kk[4 * j], kk[4 * j + 1], kk[4 * j + 2], kk[4 * j + 3]}; }
    if (!smp) { if (half == 1) ((float*)(ws + WS_EBP))[(size_t)c * 1024 + h * 256 + d] = __expf(bl[31]); }
    else {
#pragma unroll
        for (int j = 0; j < 4; ++j) ((float*)(ws + WS_EBS))[(size_t)((c - NCH_P) * 8 + 4 * half + j) * 1024 + h * 256 + d] = __expf(bl[8 * j + 7]); }
    __syncthreads();
    { bf16* QTg = (bf16*)(ws + WS_QT);
#pragma unroll
        for (int j = 0; j < 4; ++j) { const int p = tid + 512 * j, row = p >> 5, c16 = p & 31;
            *(v4u*)(QTg + (size_t)(r0 + row) * 1024 + h * 256 + c16 * 8) = *(const LAS v4u*)(Qs + row * QP + c16 * 8); } }
    { const int g = lane >> 4, cc = lane & 15, mt = wid >> 1, nt0 = 2 * (wid & 1);
        f32x4 pa[2] = {(f32x4){0.f, 0.f, 0.f, 0.f}, (f32x4){0.f, 0.f, 0.f, 0.f}};
#pragma unroll
        for (int ks = 0; ks < 8; ++ks) { const bf16x8 a = *(const LAS bf16x8*)(Qs + (16 * mt + cc) * QP + 32 * ks + 8 * g);
#pragma unroll
            for (int n = 0; n < 2; ++n) { const bf16x8 b = *(const LAS bf16x8*)(Ks + (16 * (nt0 + n) + cc) * QP + 32 * ks + 8 * g);
                pa[n] = __builtin_amdgcn_mfma_f32_16x16x32_bf16(a, b, pa[n], 0, 0, 0); } }
        bf16* PSg = (bf16*)(ws + WS_PS) + (size_t)(c * 4 + h) * 4096;
#pragma unroll
        for (int n = 0; n < 2; ++n)
#pragma unroll
            for (int r = 0; r < 4; ++r) { const int t = 16 * mt + 4 * g + r, s = 16 * (nt0 + n) + cc; const bool ok = (s <= t) && (!smp || ((s >> 3) == (t >> 3)));
                PSg[t * 64 + s] = (bf16)f2bf(ok ? pa[n][r] : 0.f); } }
    if (!smp) { unsigned vv[32];
#pragma unroll
        for (int s = 0; s < 64; s += 2) vv[s >> 1] = (unsigned)Vs[s * VP + tid] | ((unsigned)Vs[(s + 1) * VP + tid] << 16);
        bf16* vt = (bf16*)(ws + WS_VT) + ((size_t)(c * 4 + h) * 512 + tid) * 64;
#pragma unroll
        for (int j = 0; j < 8; ++j) *(v4u*)(vt + 8 * j) = (v4u){vv[4 * j], vv[4 * j + 1], vv[4 * j + 2], vv[4 * j + 3]}; }
    __syncthreads();
}
__device__ __forceinline__ void pool_prep(Frame& F, const int bi, const int nb) {
    unsigned char* ws = F.ws; const bf16* U = (const bf16*)(ws + WS_U); bf16* PB = (bf16*)(ws + WS_PB); const float* sp = F.inp(3);
    const bool fast = (nb == 192);
    if (fast && bi < 128) {
        const int W = bi * 8 + F.wave, q = W & 3, w = 2 << q, lane = F.lane;
        const int seg = 2 * (W >> 2) + (lane >> 5), ch = (32 * q + (lane & 31)) * 8, row0 = seg * 16, t0 = row0 & (SEQ - 1);
        const bf16* up = U + (size_t)row0 * 1024 + ch; bf16* pp = PB + (size_t)row0 * 1024 + ch;
        float acc[8] = {0.f, 0.f, 0.f, 0.f, 0.f, 0.f, 0.f, 0.f};
#define PL_ACC(vv_, sg) do { const v4u t4_ = (vv_); const unsigned xs_[4] = {t4_.x, t4_.y, t4_.z, t4_.w}; _Pragma("unroll") for (int j = 0; j < 4; ++j) { acc[2 * j] += (sg) * bf2f(xs_[j] & 0xffffu); acc[2 * j + 1] += (sg) * bf2f(xs_[j] >> 16); } } while (0)
        for (int i0 = 1; i0 < w; i0 += 4) { v4u x[4];
#pragma unroll
            for (int k = 0; k < 4; ++k) { const int i = i0 + k; x[k] = *(const v4u*)(up - (size_t)((i < w && t0 - i >= 0) ? i : 0) * 1024); }
#pragma unroll
            for (int k = 0; k < 4; ++k) { const int i = i0 + k; PL_ACC(x[k], (i < w && t0 - i >= 0) ? 1.f : 0.f); } }
#pragma unroll 1
        for (int r0 = 0; r0 < 16; r0 += 4) { v4u xn[4], xl[4];
#pragma unroll
            for (int k = 0; k < 4; ++k) { const int r = r0 + k; xn[k] = *(const v4u*)(up + (size_t)r * 1024); xl[k] = *(const v4u*)(up + (size_t)((r > 0 && t0 + r - w >= 0) ? r - w : r) * 1024); }
#pragma unroll
            for (int k = 0; k < 4; ++k) { const int r = r0 + k, t = t0 + r; PL_ACC(xn[k], 1.f); PL_ACC(xl[k], (r > 0 && t - w >= 0) ? -1.f : 0.f);
                const float ic = __builtin_amdgcn_rcpf((float)((t + 1 < w) ? t + 1 : w)); const unsigned xs[4] = {xn[k].x, xn[k].y, xn[k].z, xn[k].w}; v4u o;
                o.x = cvt_pk_bf16(acc[0] * ic - bf2f(xs[0] & 0xffffu), acc[1] * ic - bf2f(xs[0] >> 16)); o.y = cvt_pk_bf16(acc[2] * ic - bf2f(xs[1] & 0xffffu), acc[3] * ic - bf2f(xs[1] >> 16));
                o.z = cvt_pk_bf16(acc[4] * ic - bf2f(xs[2] & 0xffffu), acc[5] * ic - bf2f(xs[2] >> 16)); o.w = cvt_pk_bf16(acc[6] * ic - bf2f(xs[3] & 0xffffu), acc[7] * ic - bf2f(xs[3] >> 16));
                *(v4u*)(pp + (size_t)r * 1024) = o; } }
#undef PL_ACC
    }
    const int sh0 = fast ? (bi < 128 ? bi : 128 + 3 * (bi - 128)) : bi, nsh = fast ? (bi < 128 ? 1 : 3) : 1, NT = (fast ? 320 : nb) * 512;
    for (int sh = sh0; sh < sh0 + nsh; ++sh)
    for (int idx = sh * 512 + F.tid + (fast ? NP * 128 : 0); idx < M * 128; idx += NT) {
        const int row = idx >> 7, cg = idx & 127, ch = cg * 8, w = 2 << (cg >> 5);
        int t, nvalid; const float* hist = sp; float cnt;
        if (row < NP) { t = row & (SEQ - 1); nvalid = (t + 1 < w) ? t + 1 : w; cnt = (float)nvalid; }
        else { const int rs = row - NP; t = rs & 7; nvalid = (t + 1 < w) ? t + 1 : w; cnt = (float)w; hist = sp + (size_t)((rs >> 3) * 15 + 15) * 1024 + ch; }
        v4u xu[16];
#pragma unroll
        for (int i = 0; i < 16; ++i) xu[i] = *(const v4u*)(U + (size_t)(row - (i < nvalid ? i : 0)) * 1024 + ch);
        float acc[8] = {0.f, 0.f, 0.f, 0.f, 0.f, 0.f, 0.f, 0.f};
        if (row >= NP && nvalid < w) {
            for (int i = nvalid; i < w; ++i) { const float* q = hist + (ptrdiff_t)(t - i) * 1024; const f32x4 a = *(const f32x4*)q, bb = *(const f32x4*)(q + 4);
#pragma unroll
                for (int j = 0; j < 4; ++j) { acc[j] += a[j]; acc[4 + j] += bb[j]; } } }
        float u0[8];
#pragma unroll
        for (int i = 0; i < 16; ++i) { const float mk = (i < nvalid) ? 1.f : 0.f; const unsigned xs[4] = {xu[i].x, xu[i].y, xu[i].z, xu[i].w};
#pragma unroll
            for (int j = 0; j < 4; ++j) { const float a = bf2f(xs[j] & 0xffffu), b = bf2f(xs[j] >> 16); acc[2 * j] += a * mk; acc[2 * j + 1] += b * mk; if (i == 0) { u0[2 * j] = a; u0[2 * j + 1] = b; } } }
        const float ic = __builtin_amdgcn_rcpf(cnt); v4u o;
        o.x = cvt_pk_bf16(acc[0] * ic - u0[0], acc[1] * ic - u0[1]); o.y = cvt_pk_bf16(acc[2] * ic - u0[2], acc[3] * ic - u0[3]);
        o.z = cvt_pk_bf16(acc[4] * ic - u0[4], acc[5] * ic - u0[5]); o.w = cvt_pk_bf16(acc[6] * ic - u0[6], acc[7] * ic - u0[7]);
        *(v4u*)(PB + (size_t)row * 1024 + ch) = o;
    }
    float* out = F.out;
    for (int sh = sh0; sh < sh0 + nsh; ++sh)
    for (int idx = sh * 512 + F.tid; idx < (4 + 128) * 15 * 128; idx += NT) {
        const int cg = idx & 127, rj = idx >> 7, ch = cg * 8; f32x4 a, b; float* dst;
        if (rj < 60) { const int bb = rj / 15, j = rj % 15; const v4u x = *(const v4u*)(U + (size_t)(bb * SEQ + SEQ - 15 + j) * 1024 + ch);
            a = (f32x4){bf2f(x.x & 0xffffu), bf2f(x.x >> 16), bf2f(x.y & 0xffffu), bf2f(x.y >> 16)}; b = (f32x4){bf2f(x.z & 0xffffu), bf2f(x.z >> 16), bf2f(x.w & 0xffffu), bf2f(x.w >> 16)};
            dst = out + OUT_BUFP + (size_t)rj * 1024 + ch; }
        else { const int r2 = rj - 60, bb = r2 / 15, j = r2 % 15;
            if (j < 7) { const float* q = sp + (size_t)(bb * 15 + j + 8) * 1024 + ch; a = *(const f32x4*)q; b = *(const f32x4*)(q + 4); }
            else { const v4u x = *(const v4u*)(U + (size_t)(NP + bb * 8 + j - 7) * 1024 + ch);
                a = (f32x4){bf2f(x.x & 0xffffu), bf2f(x.x >> 16), bf2f(x.y & 0xffffu), bf2f(x.y >> 16)}; b = (f32x4){bf2f(x.z & 0xffffu), bf2f(x.z >> 16), bf2f(x.w & 0xffffu), bf2f(x.w >> 16)}; }
            dst = out + OUT_BUFS + (size_t)r2 * 1024 + ch; }
        *(f32x4*)dst = a; *(f32x4*)(dst + 4) = b;
    }
}

constexpr int KP = 72;
__device__ __forceinline__ void gla_chain(Frame& F, int cb, float* SSQ, const int pvar) {
    int tid_ = F.tid; asm volatile("" : "+v"(tid_));
    const int b = (cb & 15) >> 2, h = cb & 3, vs = cb >> 4, tid = tid_, lane = tid_ & 63, wid = F.wave;
    const int g = lane >> 4, c = lane & 15, dh = wid >> 2, vg = wid & 3, dbase = dh * 128;
    unsigned char* ws = F.ws;
    LAS bf16* Qs = (LAS bf16*)F.lds; LAS bf16* Kt = (LAS bf16*)(F.lds + 33792); LAS bf16* Ps = (LAS bf16*)(F.lds + 70656); LAS bf16* Vt = (LAS bf16*)(F.lds + 79872);
    LAS float* EB = (LAS float*)(F.lds + 98304); LAS float* Ored = (LAS float*)(F.lds + 99328);
    const bf16* QTg = (const bf16*)(ws + WS_QT); const bf16* KTTg = (const bf16*)(ws + WS_KTT); const bf16* PSg = (const bf16*)(ws + WS_PS); const bf16* VTg = (const bf16*)(ws + WS_VT);
    const float* EBg = (const float*)(ws + WS_EBP); bf16* OG = (bf16*)(ws + WS_OG);
    f32x4 S[8][2];
#pragma unroll
    for (int i = 0; i < 8; ++i) { S[i][0] = (f32x4){0.f, 0.f, 0.f, 0.f}; S[i][1] = (f32x4){0.f, 0.f, 0.f, 0.f}; }
    v4u pq[4], pk[4], pp, pv[2]; float pe = 0.f;
    const unsigned t16 = (unsigned)tid * 16u, qoff = (unsigned)(tid >> 5) * 2048u + (unsigned)(tid & 31) * 16u;
    const unsigned lq = (unsigned)(tid >> 5) * (QP * 2) + (unsigned)(tid & 31) * 16u, lk = (unsigned)(tid >> 3) * (KP * 2) + (unsigned)(tid & 7) * 16u;
#define CH_LOAD_A(n) do { const int ci_ = b * 32 + (n); const char* qb_ = (const char*)QTg + ((size_t)ci_ * 65536 + h * 256) * 2; const char* pb_ = (const char*)PSg + (size_t)(ci_ * 4 + h) * 8192; \
        _Pragma("unroll") for (int j = 0; j < 4; ++j) pq[j] = *(const v4u*)(qb_ + j * 32768 + qoff); \
        pp = *(const v4u*)(pb_ + t16); } while (0)
#define CH_LOAD_B(n) do { const int ci_ = b * 32 + (n); const char* kb_ = (const char*)KTTg + (size_t)(ci_ * 4 + h) * 32768; const char* vb_ = (const char*)VTg + ((size_t)(ci_ * 4 + h) * 512 + vs * 128) * 128; \
        _Pragma("unroll") for (int j = 0; j < 4; ++j) pk[j] = *(const v4u*)(kb_ + j * 8192 + t16); \
        _Pragma("unroll") for (int j = 0; j < 2; ++j) pv[j] = *(const v4u*)(vb_ + j * 8192 + t16); \
        if (tid < 256) pe = *(const float*)((const char*)(EBg + (size_t)ci_ * 1024 + h * 256) + (unsigned)tid * 4u); } while (0)
#define CH_LDG(n, grp) do { const int ci_ = b * 32 + (n); const char* qb_ = (const char*)QTg + ((size_t)ci_ * 65536 + h * 256) * 2; const char* pb_ = (const char*)PSg + (size_t)(ci_ * 4 + h) * 8192; \
        const char* kb_ = (const char*)KTTg + (size_t)(ci_ * 4 + h) * 32768; const char* vb_ = (const char*)VTg + ((size_t)(ci_ * 4 + h) * 512 + vs * 128) * 128; \
        if ((grp) == 0) { pq[0] = *(const v4u*)(qb_ + qoff); pq[1] = *(const v4u*)(qb_ + 32768 + qoff); pk[0] = *(const v4u*)(kb_ + t16); } \
        if ((grp) == 1) { pq[2] = *(const v4u*)(qb_ + 2 * 32768 + qoff); pq[3] = *(const v4u*)(qb_ + 3 * 32768 + qoff); pk[1] = *(const v4u*)(kb_ + 8192 + t16); } \
        if ((grp) == 2) { pk[2] = *(const v4u*)(kb_ + 2 * 8192 + t16); pk[3] = *(const v4u*)(kb_ + 3 * 8192 + t16); pp = *(const v4u*)(pb_ + t16); } \
        if ((grp) == 3) { pv[0] = *(const v4u*)(vb_ + t16); pv[1] = *(const v4u*)(vb_ + 8192 + t16); if (tid < 256) pe = *(const float*)((const char*)(EBg + (size_t)ci_ * 1024 + h * 256) + (unsigned)tid * 4u); } \
        asm volatile("" ::: "memory"); } while (0)
#define CH_STORE() do { \
        _Pragma("unroll") for (int j = 0; j < 4; ++j) { *(LAS v4u*)((LAS char*)Qs + j * (16 * QP * 2) + lq) = pq[j]; *(LAS v4u*)((LAS char*)Kt + j * (64 * KP * 2) + lk) = pk[j]; } \
        *(LAS v4u*)((LAS char*)Ps + lk) = pp; \
        _Pragma("unroll") for (int j = 0; j < 2; ++j) *(LAS v4u*)((LAS char*)Vt + j * (64 * KP * 2) + lk) = pv[j]; \
        if (tid < 256) EB[tid] = pe; } while (0)
    CH_LOAD_A(0); CH_LOAD_B(0); CH_STORE(); __syncthreads();
    for (int n = 0; n < 32; ++n) {
        const bool ldn = (n + 1 < 32) && !(pvar & 4);
        if (ldn) CH_LDG(n + 1, 0);
        f32x4 oT[2][4];
#pragma unroll
        for (int vt = 0; vt < 2; ++vt)
#pragma unroll
            for (int tt = 0; tt < 4; ++tt) oT[vt][tt] = (f32x4){0.f, 0.f, 0.f, 0.f};
        {
            bf16x8 qf[4], va[2], pb[4];
#define CH_QLOAD(dst, ks_) do { _Pragma("unroll") for (int tt = 0; tt < 4; ++tt) { const LAS bf16* qp = Qs + (16 * tt + c) * QP + dbase + 32 * (ks_) + 4 * g; \
                const v2u q0 = *(const LAS v2u*)qp, q1 = *(const LAS v2u*)(qp + 16); dst[tt] = __builtin_bit_cast(bf16x8, ((v4u){q0.x, q0.y, q1.x, q1.y})); } } while (0)
#pragma unroll
            for (int ks = 0; ks < 4; ++ks) {
                if (ks == 2 && ldn) CH_LDG(n + 1, 1);
                CH_QLOAD(qf, ks);
                if (ks == 3) {
#pragma unroll
                    for (int vt = 0; vt < 2; ++vt) va[vt] = *(const LAS bf16x8*)(Vt + (32 * vg + 16 * vt + c) * KP + 32 * dh + 8 * g);
#pragma unroll
                    for (int tt = 0; tt < 4; ++tt) pb[tt] = *(const LAS bf16x8*)(Ps + (16 * tt + c) * KP + 32 * dh + 8 * g); }
                bf16x8 sa[2];
#pragma unroll
                for (int vt = 0; vt < 2; ++vt) { const f32x4 lo = S[2 * ks][vt], hi = S[2 * ks + 1][vt];
                    v4u w; w.x = cvt_pk_bf16(lo[0], lo[1]); w.y = cvt_pk_bf16(lo[2], lo[3]); w.z = cvt_pk_bf16(hi[0], hi[1]); w.w = cvt_pk_bf16(hi[2], hi[3]); sa[vt] = __builtin_bit_cast(bf16x8, w); }
#pragma unroll
                for (int tt = 0; tt < 4; ++tt)
#pragma unroll
                    for (int vt = 0; vt < 2; ++vt) oT[vt][tt] = __builtin_amdgcn_mfma_f32_16x16x32_bf16(sa[vt], qf[tt], oT[vt][tt], 0, 0, 0);
            }
#undef CH_QLOAD
#pragma unroll
            for (int tt = 0; tt < 4; ++tt)
#pragma unroll
                for (int vt = 0; vt < 2; ++vt) oT[vt][tt] = __builtin_amdgcn_mfma_f32_16x16x32_bf16(va[vt], pb[tt], oT[vt][tt], 0, 0, 0);
        }
        if (ldn) CH_LDG(n + 1, 2);
        {
#pragma unroll
            for (int vt = 0; vt < 2; ++vt)
#pragma unroll
                for (int t2 = 0; t2 < 2; ++t2) { const int tt = 2 * (1 - dh) + t2;
#pragma unroll
                    for (int r = 0; r < 4; ++r) Ored[((dh * 4 + vg) * 16 + (vt * 2 + t2) * 4 + r) * 64 + lane] = (dh == 0) ? oT[vt][2 + t2][r] : oT[vt][t2][r]; } }
        __syncthreads();
        if (ldn) CH_LDG(n + 1, 3);
        {
            bf16x8 vb[2][2], ka[4];
#define CH_KLOAD(dst, ks_, mg_) do { _Pragma("unroll") for (int q = 0; q < 4; ++q) dst[q] = *(const LAS bf16x8*)(Kt + (dbase + 16 * (4 * (mg_) + q) + c) * KP + 32 * (ks_) + 8 * g); } while (0)
#pragma unroll
            for (int ks = 0; ks < 2; ++ks)
#pragma unroll
                for (int vt = 0; vt < 2; ++vt) vb[ks][vt] = *(const LAS bf16x8*)(Vt + (32 * vg + 16 * vt + c) * KP + 32 * ks + 8 * g);
#pragma unroll
            for (int st = 0; st < 4; ++st) { const int ks = st >> 1, mg = st & 1;
                CH_KLOAD(ka, ks, mg);
#pragma unroll
                for (int q = 0; q < 4; ++q)
#pragma unroll
                    for (int vt = 0; vt < 2; ++vt) S[4 * mg + q][vt] = __builtin_amdgcn_mfma_f32_16x16x32_bf16(ka[q], vb[ks][vt], S[4 * mg + q][vt], 0, 0, 0); }
#undef CH_KLOAD
        }
#pragma unroll
        for (int md = 0; md < 8; ++md) { const f32x4 e = *(const LAS f32x4*)(EB + dbase + 16 * md + 4 * g); S[md][0] *= e; S[md][1] *= e; }
        {
            const int rowb = b * SEQ + n * 64;
            char* ogb = (char*)OG + ((size_t)rowb * 2048 + h * 512 + vs * 128 + 32 * vg) * 2; char* sqb = (char*)(SSQ + (size_t)rowb * 4 + h);
            const unsigned ogl = (unsigned)c * 4096u + (unsigned)g * 8u, sql = (unsigned)c * 16u;
#pragma unroll
            for (int t2 = 0; t2 < 2; ++t2) { float ss = 0.f; const int tt = 2 * dh + t2;
#pragma unroll
                for (int vt = 0; vt < 2; ++vt) { f32x4 o = (dh == 0) ? oT[vt][t2] : oT[vt][2 + t2];
#pragma unroll
                    for (int r = 0; r < 4; ++r) { o[r] += Ored[(((1 - dh) * 4 + vg) * 16 + (vt * 2 + t2) * 4 + r) * 64 + lane]; ss += o[r] * o[r]; }
                    v2u w; w.x = cvt_pk_bf16(o[0], o[1]); w.y = cvt_pk_bf16(o[2], o[3]);
                    *(v2u*)(ogb + tt * 65536 + vt * 32 + ogl) = w; }
                ss += __shfl_xor(ss, 16); ss += __shfl_xor(ss, 32);
                if (g == 0) atomicAdd((float*)(sqb + tt * 256 + sql), ss); } }
        __syncthreads();
        if (n + 1 < 32 && !(pvar & 4)) { CH_STORE(); }
        __syncthreads();
    }
#undef CH_LOAD_A
#undef CH_LOAD_B
#undef CH_STORE
    float* sg = F.out + OUT_SGP + (size_t)(b * 4 + h) * 256 * 512;
#pragma unroll
    for (int md = 0; md < 8; ++md)
#pragma unroll
        for (int vt = 0; vt < 2; ++vt)
#pragma unroll
            for (int r = 0; r < 4; ++r) sg[(size_t)(dbase + 16 * md + 4 * g + r) * 512 + vs * 128 + 32 * vg + 16 * vt + c] = S[md][vt][r];
}
__device__ __forceinline__ void gla_sample_unit(Frame& F, int u, float* SSQ) {
    const int b = u >> 3, h = (u >> 1) & 3, vh = u & 1, tid = F.tid, lane = F.lane, wid = F.wave;
    unsigned char* ws = F.ws;
    const int row0 = NP + b * 8, cs = NCH_P + (b >> 3), si = (b & 7) * 8;
    const float* Sin = F.inp(2) + (size_t)(b * 4 + h) * 256 * 512 + vh * 256 + 4 * lane;
    float* Sout = F.out + OUT_SGS + (size_t)(b * 4 + h) * 256 * 512 + vh * 256 + 4 * lane;
    f32x4 sva[4], svb[4], svc[4];
#define SMP_LOAD(dst, r_) do { _Pragma("unroll") for (int j = 0; j < 4; ++j) dst[j] = __builtin_nontemporal_load((const f32x4*)(Sin + (size_t)(wid + 8 * ((r_) + j)) * 512)); } while (0)
    SMP_LOAD(sva, 0); SMP_LOAD(svb, 4); SMP_LOAD(svc, 8);
    LAS float* QK = (LAS float*)F.lds; LAS float* EBs = (LAS float*)(F.lds + 16384); LAS float* Ored = (LAS float*)(F.lds + 17408);
    { const int d = tid & 255;
        if (tid < 256) { const bf16* qt = (const bf16*)(ws + WS_QT) + (size_t)row0 * 1024 + h * 256 + d; f32x4 a, bq;
#pragma unroll
            for (int t = 0; t < 4; ++t) { a[t] = bf2f(qt[(size_t)t * 1024]); bq[t] = bf2f(qt[(size_t)(t + 4) * 1024]); }
            *(LAS f32x4*)(QK + d * 16) = a; *(LAS f32x4*)(QK + d * 16 + 4) = bq;
            EBs[d] = ((const float*)(ws + WS_EBS))[(size_t)b * 1024 + h * 256 + d]; }
        else { const v4u x = *(const v4u*)((const bf16*)(ws + WS_KTT) + ((size_t)(cs * 4 + h) * 256 + d) * 64 + si);
            *(LAS f32x4*)(QK + d * 16 + 8) = (f32x4){bf2f(x.x & 0xffffu), bf2f(x.x >> 16), bf2f(x.y & 0xffffu), bf2f(x.y >> 16)};
            *(LAS f32x4*)(QK + d * 16 + 12) = (f32x4){bf2f(x.z & 0xffffu), bf2f(x.z >> 16), bf2f(x.w & 0xffffu), bf2f(x.w >> 16)}; } }
    f32x4 v[8], o[8];
    { const bf16* Vg = (const bf16*)(ws + WS_V) + (size_t)row0 * 2048 + h * 512 + vh * 256 + 4 * lane;
#pragma unroll
        for (int s = 0; s < 8; ++s) { const v2u x = *(const v2u*)(Vg + (size_t)s * 2048); v[s] = (f32x4){bf2f(x.x & 0xffffu), bf2f(x.x >> 16), bf2f(x.y & 0xffffu), bf2f(x.y >> 16)}; o[s] = (f32x4){0.f, 0.f, 0.f, 0.f}; } }
    __syncthreads();
#define SMP_COMP(src, r_) do { _Pragma("unroll") for (int j = 0; j < 4; ++j) { const int d = wid + 8 * ((r_) + j); \
            const f32x4 q0 = *(const LAS f32x4*)(QK + d * 16), q1 = *(const LAS f32x4*)(QK + d * 16 + 4), k0 = *(const LAS f32x4*)(QK + d * 16 + 8), k1 = *(const LAS f32x4*)(QK + d * 16 + 12); \
            const float e = EBs[d]; f32x4 sn = src[j]; \
            _Pragma("unroll") for (int s = 0; s < 4; ++s) { sn += v[s] * k0[s]; o[s] += src[j] * q0[s]; } \
            _Pragma("unroll") for (int s = 0; s < 4; ++s) { sn += v[s + 4] * k1[s]; o[s + 4] += src[j] * q1[s]; } \
            __builtin_nontemporal_store(sn * e, (f32x4*)(Sout + (size_t)d * 512)); } } while (0)
    SMP_COMP(sva, 0); SMP_LOAD(sva, 12);
    SMP_COMP(svb, 4); SMP_LOAD(svb, 16);
    SMP_COMP(svc, 8); SMP_LOAD(svc, 20);
    SMP_COMP(sva, 12); SMP_LOAD(sva, 24);
    SMP_COMP(svb, 16); SMP_LOAD(svb, 28);
    SMP_COMP(svc, 20);
    SMP_COMP(sva, 24);
    SMP_COMP(svb, 28);
#undef SMP_LOAD
#undef SMP_COMP
#pragma unroll
    for (int t = 0; t < 8; ++t) *(LAS f32x4*)(Ored + (wid * 8 + t) * 256 + 4 * lane) = o[t];
    __syncthreads();
    { const int t = wid; f32x4 ot = (f32x4){0.f, 0.f, 0.f, 0.f};
#pragma unroll
        for (int w = 0; w < 8; ++w) ot += *(const LAS f32x4*)(Ored + (w * 8 + t) * 256 + 4 * lane);
        const v4u px = *(const v4u*)((const bf16*)(ws + WS_PS) + ((size_t)(cs * 4 + h) * 64 + si + t) * 64 + si);
        const float pr[8] = {bf2f(px.x & 0xffffu), bf2f(px.x >> 16), bf2f(px.y & 0xffffu), bf2f(px.y >> 16), bf2f(px.z & 0xffffu), bf2f(px.z >> 16), bf2f(px.w & 0xffffu), bf2f(px.w >> 16)};
#pragma unroll
        for (int s = 0; s < 8; ++s) ot += v[s] * pr[s];
        v2u w2; w2.x = cvt_pk_bf16(ot[0], ot[1]); w2.y = cvt_pk_bf16(ot[2], ot[3]);
        *(v2u*)((bf16*)(ws + WS_OG) + (size_t)(row0 + t) * 2048 + h * 512 + vh * 256 + 4 * lane) = w2;
        const float ss = wave_sum((ot[0] * ot[0] + ot[1] * ot[1]) + (ot[2] * ot[2] + ot[3] * ot[3]));
        if (lane == 0) atomicAdd(SSQ + (size_t)(row0 + t) * 4 + h, ss); }
    __syncthreads();
}

__device__ __forceinline__ void final_norm(Frame& F, float* dst) {
    const int gw = F.vcu * NWAVES + F.wave, NGW = F.G * NWAVES, lane = F.lane; const float* SSQ2 = (const float*)(F.ctl + CW_SSQ2);
    f32x4 gv[8];
#pragma unroll
    for (int j = 0; j < 8; ++j) gv[j] = ((const f32x4*)F.inp(15))[64 * j + lane];
    for (int m = gw; m < M; m += NGW) { const float rs = __builtin_amdgcn_rsqf(SSQ2[m] * (1.f / DM) + EPS); const f32x4* xr = (const f32x4*)(F.out + OUT_Y + (size_t)m * DM) + lane; f32x4* xw = (f32x4*)(dst + (size_t)m * DM) + lane;
#pragma unroll
        for (int j = 0; j < 8; ++j) xw[64 * j] = xr[64 * j] * rs * gv[j]; }
}

struct Args { const float* in[16]; float* out; unsigned char* ws; int ph_lo, ph_hi; };
__global__ void __launch_bounds__(NWAVES * 64, 2) mk_fwd(Args args) {
    extern __shared__ __attribute__((aligned(16))) unsigned char lds[];
    Frame F;
    F.lds = (LAS unsigned char*)lds; F.MISC = (volatile LAS unsigned*)(F.lds + MISC_OFF);
    F.tid = threadIdx.x; F.lane = F.tid & 63; F.wave = __builtin_amdgcn_readfirstlane(F.tid >> 6);
    F.G = gridDim.x; { const int bx = blockIdx.x; F.vcu = (F.G % 8 == 0) ? (bx % 8) * (F.G / 8) + bx / 8 : bx; }
    F.out = args.out; F.ws = args.ws; F.ctl = (unsigned*)(args.ws + WS_CTL);
    for (int u = F.tid; u < (LDS_BYTES - LDSCTL_OFF) / 4; u += NWAVES * 64) ((LAS unsigned*)(F.lds + LDSCTL_OFF))[u] = 0u;
    __syncthreads();
    if (F.tid < 16) ((LAS unsigned long long*)(F.lds + PTAB_OFF))[F.tid] = (unsigned long long)args.in[F.tid];
    __syncthreads();
    const int lo = args.ph_lo, hi = args.ph_hi;
    const bool use_bar = (hi - lo) > 1;
    XcdBarrier bar; bar.bar = F.ctl + CW_BAR; bar.x = 0; bar.st = nullptr;
    if (use_bar) bar = xcd_barrier_post(F.ctl + CW_BAR, F.MISC + 8);
#define IN(k) (((PHMASK >> (k)) & 1) && lo <= (k) && (k) < hi)
#define SEAM(k) do { if (IN(k) && IN((k) + 1)) xcd_barrier(bar); } while (0)
    unsigned char* ws = args.ws;
    const int bx = (int)blockIdx.x;

#define REPS(k) (((PROBE_MASK >> (k)) & 1) ? 2 : 1)
#define LASTREP(k, r) ((r) == REPS(k) - 1)
#define REPBAR(k, r) do { if (!LASTREP(k, r) && use_bar) xcd_barrier(bar); } while (0)
    float* dummy = (float*)(ws + WS_DUMMY);
    if (IN(0)) for (int r = 0; r < REPS(0); ++r) { p0_prologue(F, 0, F.vcu * NWAVES + F.wave, F.G * NWAVES); REPBAR(0, r); } SEAM(0);
    if (IN(1)) for (int r = 0; r < REPS(1); ++r) { pg8::Gemm g{(const bf16*)(ws + WS_H), (const bf16*)(ws + WS_WIN), DM, DM, DM, 0}; pg8::StaticOrder S; S.init(M, NIN, F.G, bx);
        EpiIn E{ws}; pg8::gemm_phase(F.lds, g, S, E);
        if (LASTREP(1, r)) {
            const int nt_ = (M / 256) * (NIN / 256), full = nt_ / F.G, rem = nt_ - full * F.G;
            __syncthreads();
            if (rem == 0 || rem >= F.G) p0_prologue(F, 1, bx * NWAVES + F.wave, F.G * NWAVES);
            else if (bx >= rem) p0_prologue(F, 1, (bx - rem) * NWAVES + F.wave, (F.G - rem) * NWAVES); }
        REPBAR(1, r); } SEAM(1);
    if (IN(2)) for (int r = 0; r < REPS(2); ++r) { for (int it = bx; it < NCH * 4; it += F.G) gla_prep_item(F, it);
        { const int n3 = NCH * 4 - 2 * F.G;
          if (F.G == 256 && n3 > 0 && n3 < F.G) { if (bx >= n3) pool_prep(F, bx - n3, F.G - n3); } else pool_prep(F, bx, F.G); }
        REPBAR(2, r); } SEAM(2);
    if (IN(3))
#pragma unroll
    for (int r = 0; r < REPS(3); ++r) {
        float* SSQ = LASTREP(3, r) ? (float*)(F.ctl + CW_SSQ) : dummy;
        const int pv = LASTREP(3, r) ? 0 : PROBE_VAR;
        if (!(pv & 2)) {
        if (bx < 64) gla_chain(F, bx, SSQ, pv);
        }
        __syncthreads();
        if (!(pv & 1))
        for (;;) { if (F.tid == 0) F.MISC[0] = atomicAdd(F.ctl + CW_WORK + 64 * r, 1u); __syncthreads(); const int u = (int)F.MISC[0]; __syncthreads(); if (u >= 1024) break; gla_sample_unit(F, u, SSQ); }
        REPBAR(3, r);
    }
    if (IN(3) && IN(5)) xcd_barrier(bar);
    if (IN(5)) { gs::Ctx X{ws, F.inp(0), F.inp(1), F.out, F.ctl, F.inp(8), F.inp(10), F.inp(15)}; gs::gemm_stream(F.lds, X, F.G, bx); }
    if (IN(5) && IN(8) && F.G != 256) xcd_barrier(bar);
    if (IN(8) && F.G != 256) { final_norm(F, F.out + OUT_Y); }
#undef IN
#undef SEAM
#undef REPS
#undef LASTREP
#undef REPBAR
}

extern "C" void kernel_launch(void* const* d_in, const int* in_sizes, int n_in, void* d_out, int out_size, void* d_ws, size_t ws_size, hipStream_t stream) {
    static int grid = 0;
    if (grid == 0) {
        if (n_in != 16 || (size_t)out_size != OUT_END || ws_size < WS_END) { fprintf(stderr, "kernel_launch: unexpected shapes (n_in %d, out %d, ws %zu); nothing launched\n", n_in, out_size, ws_size); grid = -1; return; }
        int dev = 0, cus = 0, per_cu = 0;
        if (hipGetDevice(&dev) != hipSuccess || hipDeviceGetAttribute(&cus, hipDeviceAttributeMultiprocessorCount, dev) != hipSuccess) { grid = -1; return; }
        if (hipFuncSetAttribute((const void*)mk_fwd, hipFuncAttributeMaxDynamicSharedMemorySize, LDS_BYTES) != hipSuccess) { fprintf(stderr, "kernel_launch: hipFuncSetAttribute failed\n"); grid = -1; return; }
        if (hipOccupancyMaxActiveBlocksPerMultiprocessor(&per_cu, (const void*)mk_fwd, NWAVES * 64, LDS_BYTES) != hipSuccess || per_cu < 1) { fprintf(stderr, "kernel_launch: occupancy query says %d blocks per CU; nothing launched\n", per_cu); (void)hipGetLastError(); grid = -1; return; }
        grid = cus;
        if (grid < 72 || grid > 4096) { fprintf(stderr, "kernel_launch: unexpected CU count %d\n", cus); grid = -1; return; }
    }
    if (grid < 0) return;
    (void)hipMemsetAsync((char*)d_ws + WS_CTL, 0, CTL_ZERO_BYTES, stream);
    Args a{};
    for (int i = 0; i < 16; ++i) a.in[i] = (const float*)d_in[i];
    a.out = (float*)d_out; a.ws = (unsigned char*)d_ws;
#if MK_N_LAUNCHES == 1
    a.ph_lo = 0; a.ph_hi = NPHASES;
    hipLaunchKernelGGL(mk_fwd, dim3(grid), dim3(NWAVES * 64), LDS_BYTES, stream, a);
#else
    for (int p = 0; p < NPHASES; ++p) { a.ph_lo = p; a.ph_hi = p + 1; hipLaunchKernelGGL(mk_fwd, dim3(grid), dim3(NWAVES * 64), LDS_BYTES, stream, a); }
#endif
}
```

```cpp
#include <hip/hip_runtime.h>
#include <cstdio>
#include <cstdint>

#ifndef PHMASK
#define PHMASK 0x1ff
#endif
#ifndef PROBE_MASK
#define PROBE_MASK 0
#endif
#ifndef PROBE_VAR
#define PROBE_VAR 0
#endif
#ifndef MK_N_LAUNCHES
#define MK_N_LAUNCHES 1
#endif

#define GAS __attribute__((address_space(1)))
#define LAS __attribute__((address_space(3)))
typedef unsigned short bf16;
typedef unsigned v4u __attribute__((ext_vector_type(4)));
typedef unsigned v2u __attribute__((ext_vector_type(2)));
typedef float f32x4 __attribute__((ext_vector_type(4)));
typedef float f32x2 __attribute__((ext_vector_type(2)));
typedef short bf16x8 __attribute__((ext_vector_type(8)));
typedef GAS unsigned gu32;
#define RLX_AGENT __ATOMIC_RELAXED, __HIP_MEMORY_SCOPE_AGENT
#define LDS_WAIT() asm volatile("s_waitcnt lgkmcnt(0)" ::: "memory")
#define VM_WAIT() asm volatile("s_waitcnt vmcnt(0)" ::: "memory")

constexpr int DM = 2048, NP = 8192, NS = 1024, M = NP + NS;
constexpr int SEQ = 2048, NBS = 128, TS = 8;
constexpr int NH = 4, DK = 256, DV = 512, QW = 1024, VW = 2048, UW = 1024;
constexpr int INW = 11280, NIN = 11520, FF = 8192;
constexpr int NCH_P = 128, NCH = 144;
constexpr float EPS = 1e-6f;
constexpr size_t OUT_Y = 0, OUT_SGP = (size_t)M * DM, OUT_BUFP = OUT_SGP + 4 * 4 * 256 * 512, OUT_SGS = OUT_BUFP + 4 * 15 * 1024, OUT_BUFS = OUT_SGS + (size_t)128 * 4 * 256 * 512, OUT_END = OUT_BUFS + 128 * 15 * 1024;
constexpr size_t MiB = 1u << 20;
constexpr size_t WS_CTL = 0, CTL_ZERO_BYTES = 1 * MiB;
constexpr size_t WS_WPOOL = 1 * MiB, WS_WOUT = 2 * MiB, WS_WUP = 10 * MiB, WS_WDN = 42 * MiB, WS_WIN = 74 * MiB, WS_H = 119 * MiB;
constexpr size_t WS_Q = 155 * MiB, WS_K = 173 * MiB, WS_U = 191 * MiB, WS_V = 209 * MiB, WS_R = 245 * MiB, WS_GA = 281 * MiB, WS_GB = 317 * MiB, WS_ALR = 353 * MiB;
constexpr size_t WS_QT = 354 * MiB, WS_KTT = 372 * MiB, WS_VT = 390 * MiB, WS_PS = 422 * MiB, WS_EBP = 427 * MiB, WS_EBS = 427 * MiB + 512 * 1024;
constexpr size_t WS_PB = 428 * MiB, WS_OB = 446 * MiB, WS_OG = 482 * MiB, WS_MB = 518 * MiB, WS_X1 = 554 * MiB, WS_X1B = 626 * MiB, WS_HID = 662 * MiB, WS_DUMMY = 806 * MiB, WS_XS = 806 * MiB + 512 * 1024, WS_XS4 = 807 * MiB, WS_SLAB = 808 * MiB, WS_END = 872 * MiB;
static_assert(WS_WIN + (size_t)NIN * DM * 2 <= WS_H && WS_H + (size_t)M * DM * 2 <= WS_Q && WS_HID + (size_t)M * FF * 2 <= WS_DUMMY && WS_X1 + (size_t)M * DM * 4 <= WS_X1B, "ws map");
constexpr int CW_TMO = 0, CW_BAR = 4096, CW_WORK = 8192, CW_SSQ = 16384, CW_SSQ1 = 65536, CW_SSQ2 = 81920, CW_CNT5 = 98304, CW_CNT6 = 102400, CW_CNTS = 106496, CW_CNTP = 110592, CW_CNT7 = 114688, CW_CNT8 = 118784;
static_assert(CW_SSQ + M * 4 <= CW_SSQ1 && CW_SSQ1 + M <= CW_SSQ2 && (CW_SSQ2 + M) * 4 <= (int)CTL_ZERO_BYTES, "ctl map");
constexpr int RING_BYTES = 131072, LDSCTL_OFF = 140 * 1024, MISC_OFF = LDSCTL_OFF + 320, PTAB_OFF = LDSCTL_OFF + 1024, LDS_BYTES = 147456;
constexpr int NWAVES = 8;
constexpr int NPHASES = 9;

__device__ __forceinline__ float bf2f(unsigned b) { return __builtin_bit_cast(float, b << 16); }
__device__ __forceinline__ unsigned cvt_pk_bf16(float lo, float hi) { unsigned r; asm volatile("v_cvt_pk_bf16_f32 %0, %1, %2" : "=v"(r) : "v"(lo), "v"(hi)); return r; }
__device__ __forceinline__ unsigned f2bf(float f) { return cvt_pk_bf16(f, 0.f) & 0xffffu; }
__device__ __forceinline__ float wave_sum(float v) {
#pragma unroll
    for (int o = 1; o < 64; o <<= 1) v += __shfl_xor(v, o);
    return v;
}
__device__ __forceinline__ float sigmoidf_(float x) { return __builtin_amdgcn_rcpf(1.f + __expf(-x)); }

namespace pg8 {
constexpr int BM = 256, BK = 64, HALF = 128, HTB = HALF * BK * 2, STAGE_BYTES = 8 * HTB, NXCD = 8, WGM = 8;
__host__ __device__ __forceinline__ int lds_byte(int r, int c) { const int st = (r >> 4) * 2 + (c >> 5), rr = r & 15, cc = c & 31, ob = rr * 64 + cc * 2; return st * 1024 + (ob ^ (((ob >> 9) & 1) << 5)); }
__host__ __device__ __forceinline__ void stage_rc(int b, int& R, int& C) { const int st = b / 1024, sb = b % 1024, swz = sb ^ (((sb >> 9) & 1) << 5); R = (st >> 1) * 16 + swz / 64; C = (st & 1) * 32 + (swz % 64) / 2; }
__host__ __device__ __forceinline__ int perm32(int rho) { const int n = rho >> 4, i = rho & 15; return 8 * (i >> 2) + 4 * n + (i & 3); }

struct Unit { int pm, pn; };
struct Gemm { const bf16* A; const bf16* Bt; int lda, ldb, K, a_div; };

struct StaticOrder {
    int nM, nN, nwg, G, c;
    __device__ void init(int M_, int N_, int G_, int c_) { nM = M_ / BM; nN = N_ / BM; nwg = nM * nN; G = G_; c = c_; }
    __device__ bool next(int i, Unit& u) const {
        const long L = (long)i * G + c; if (c < 0 || L >= nwg) return false;
        int wgid = (int)L; { const int q = nwg / NXCD, r = nwg % NXCD, xcd = wgid % NXCD, off = wgid / NXCD; wgid = (xcd < r ? xcd * (q + 1) : r * (q + 1) + (xcd - r) * q) + off; }
        const int nig = WGM * nN, gid = wgid / nig, fm = gid * WGM, gsz = (nM - fm) < WGM ? (nM - fm) : WGM;
        u.pm = fm + ((wgid % nig) % gsz); u.pn = (wgid % nig) / gsz; return true;
    }
};

template <class Epi, class Sched>
__device__ __forceinline__ void gemm_phase(LAS unsigned char* lds, const Gemm g, const Sched& S, const Epi& E) {
    const int tid = threadIdx.x, wid = __builtin_amdgcn_readfirstlane(tid >> 6), lane = tid & 63, wr = wid >> 2, wc = wid & 3, fr = lane & 15, fq = lane >> 4;
    const int K = g.K, nt = K / BK;
    unsigned voffA[2], voffB[2];
#pragma unroll
    for (int i = 0; i < 2; ++i) { int R, C; stage_rc(tid * 16 + i * 8192, R, C); const int Rb = (R & ~31) + perm32(R & 31);
        voffA[i] = (unsigned)(R * g.lda + C) * 2u; voffB[i] = (unsigned)(Rb * g.ldb + C) * 2u; }
    const size_t kstep = (size_t)(BK * 2);
    const size_t hA = (size_t)HALF * g.lda * 2, hB = (size_t)HALF * g.ldb * 2;
    const unsigned ldsw = (unsigned)wid * 1024u;
    const int aoff = lds_byte(wr * 64 + fr, fq * 8), boff = lds_byte(wc * 32 + fr, fq * 8);
#define PG8_SA(b, h) (((b) * 2 + (h)) * HTB)
#define PG8_SB(b, h) ((4 + (b) * 2 + (h)) * HTB)
#define PG8_STAGE(bufoff, gbase, voff) do { _Pragma("unroll") for (int _i = 0; _i < 2; ++_i) \
        __builtin_amdgcn_global_load_lds((const unsigned*)((const char*)(gbase) + (voff)[_i]), (LAS unsigned*)(lds + (bufoff) + ldsw + _i * 8192), 16, 0, 0); } while (0)
#define PG8_LDA(dst, b, h) do { _Pragma("unroll") for (int m = 0; m < 4; ++m) _Pragma("unroll") for (int k = 0; k < 2; ++k) dst[m][k] = *(const LAS bf16x8*)(lds + PG8_SA(b, h) + aoff + m * 2048 + k * 1024); } while (0)
#define PG8_LDB(dst, b, h) do { _Pragma("unroll") for (int n = 0; n < 2; ++n) _Pragma("unroll") for (int k = 0; k < 2; ++k) dst[n][k] = *(const LAS bf16x8*)(lds + PG8_SB(b, h) + boff + n * 2048 + k * 1024); } while (0)
#define PG8_MMA(ai, bj, At, Bt) do { __builtin_amdgcn_s_setprio(1); _Pragma("unroll") for (int m = 0; m < 4; ++m) _Pragma("unroll") for (int n = 0; n < 2; ++n) _Pragma("unroll") for (int k = 0; k < 2; ++k) \
        acc[ai][bj][m][n] = __builtin_amdgcn_mfma_f32_16x16x32_bf16(Bt[n][k], At[m][k], acc[ai][bj][m][n], 0, 0, 0); __builtin_amdgcn_s_setprio(0); } while (0)
#define PG8_WAIT_V(n) asm volatile("s_waitcnt vmcnt(" #n ")" ::: "memory")
#define PG8_WAIT_L(n) asm volatile("s_waitcnt lgkmcnt(" #n ")" ::: "memory")
#define PG8_BAR __builtin_amdgcn_s_barrier()
#define PG8_SCHED __builtin_amdgcn_sched_barrier(0)
#define PG8_ACOL(u) ((size_t)(g.a_div ? ((u).pn / g.a_div) * K * 2 : 0))
    Unit cur, nxt; int ui = 0;
    if (!S.next(0, cur)) return;
    f32x4 acc[2][2][4][2];
#pragma unroll
    for (int a = 0; a < 2; ++a)
#pragma unroll
        for (int b = 0; b < 2; ++b)
#pragma unroll
            for (int m = 0; m < 4; ++m)
#pragma unroll
                for (int n = 0; n < 2; ++n) acc[a][b][m][n] = (f32x4){0.f, 0.f, 0.f, 0.f};
    bf16x8 At[4][2], B0[2][2], B1[2][2];
    const char* cA = (const char*)g.A + (size_t)cur.pm * 2 * hA + PG8_ACOL(cur); const char* cB = (const char*)g.Bt + (size_t)cur.pn * 2 * hB;
    PG8_STAGE(PG8_SB(0, 0), cB, voffB); PG8_STAGE(PG8_SB(0, 1), cB + hB, voffB); PG8_STAGE(PG8_SA(0, 0), cA, voffA); PG8_STAGE(PG8_SA(0, 1), cA + hA, voffA);
    if (wr == 1) PG8_BAR;
    PG8_WAIT_V(2); PG8_BAR;
    PG8_STAGE(PG8_SB(1, 0), cB + kstep, voffB); PG8_STAGE(PG8_SA(1, 0), cA + kstep, voffA); PG8_STAGE(PG8_SB(1, 1), cB + hB + kstep, voffB);
    PG8_WAIT_V(6); PG8_BAR;
    for (;;) {
        const bool has_next = S.next(ui + 1, nxt);
        const char* nA = has_next ? (const char*)g.A + (size_t)nxt.pm * 2 * hA + PG8_ACOL(nxt) : cA; const char* nB = has_next ? (const char*)g.Bt + (size_t)nxt.pn * 2 * hB : cB;
#pragma unroll 1
        for (int t = 0; t < nt; t += 2) {
            const bool last = (t == nt - 2);
            const char* a1 = cA + (size_t)(t + 1) * kstep;
            const char* a2 = last ? nA : cA + (size_t)(t + 2) * kstep; const char* b2 = last ? nB : cB + (size_t)(t + 2) * kstep;
            const char* a3 = a2 + kstep; const char* b3 = b2 + kstep;
            PG8_LDB(B0, 0, 0); PG8_LDB(B1, 0, 1); PG8_SCHED; PG8_LDA(At, 0, 0); PG8_STAGE(PG8_SA(1, 1), a1 + hA, voffA);
            PG8_WAIT_V(8); PG8_WAIT_L(0); PG8_BAR; PG8_MMA(0, 0, At, B0); PG8_MMA(0, 1, At, B1); PG8_BAR; PG8_SCHED;
            PG8_LDA(At, 0, 1); PG8_STAGE(PG8_SB(0, 0), b2, voffB); PG8_STAGE(PG8_SB(0, 1), b2 + hB, voffB); PG8_STAGE(PG8_SA(0, 0), a2, voffA);
            PG8_WAIT_V(8); PG8_WAIT_L(0); PG8_BAR; PG8_MMA(1, 0, At, B0); PG8_MMA(1, 1, At, B1); PG8_BAR; PG8_SCHED;
            PG8_LDB(B0, 1, 0); PG8_LDB(B1, 1, 1); PG8_SCHED; PG8_LDA(At, 1, 0); PG8_STAGE(PG8_SA(0, 1), a2 + hA, voffA);
            PG8_WAIT_V(8); PG8_WAIT_L(0); PG8_BAR; PG8_MMA(0, 0, At, B0); PG8_MMA(0, 1, At, B1); PG8_BAR; PG8_SCHED;
            PG8_LDA(At, 1, 1); PG8_STAGE(PG8_SB(1, 0), b3, voffB); PG8_STAGE(PG8_SB(1, 1), b3 + hB, voffB); PG8_STAGE(PG8_SA(1, 0), a3, voffA);
            PG8_WAIT_V(8); PG8_WAIT_L(0); PG8_BAR; PG8_MMA(1, 0, At, B0); PG8_MMA(1, 1, At, B1); PG8_BAR; PG8_SCHED;
        }
        if (wr == 0) PG8_BAR;
        E(acc, cur, wr, wc, fr, fq);
        if (!has_next) break;
#pragma unroll
        for (int a = 0; a < 2; ++a)
#pragma unroll
            for (int b = 0; b < 2; ++b)
#pragma unroll
                for (int m = 0; m < 4; ++m)
#pragma unroll
                    for (int n = 0; n < 2; ++n) acc[a][b][m][n] = (f32x4){0.f, 0.f, 0.f, 0.f};
        cur = nxt; cA = nA; cB = nB; ++ui;
        if (wr == 1) PG8_BAR;
    }
    PG8_WAIT_V(0);
    PG8_BAR;
#undef PG8_SA
#undef PG8_SB
#undef PG8_STAGE
#undef PG8_LDA
#undef PG8_LDB
#undef PG8_MMA
#undef PG8_WAIT_V
#undef PG8_WAIT_L
#undef PG8_BAR
#undef PG8_SCHED
#undef PG8_ACOL
}
}

using pg8::Unit;
__device__ __forceinline__ void st_bf16x8(bf16* p, f32x4 v0, f32x4 v1) { v4u w; w.x = cvt_pk_bf16(v0[0], v0[1]); w.y = cvt_pk_bf16(v0[2], v0[3]); w.z = cvt_pk_bf16(v1[0], v1[1]); w.w = cvt_pk_bf16(v1[2], v1[3]); *(v4u*)p = w; }

struct EpiIn {
    unsigned char* ws;
    __device__ __forceinline__ void operator()(const f32x4 (&acc)[2][2][4][2], const Unit& u, int wr, int wc, int fr, int fq) const {
        const int pn = u.pn; const int row0 = u.pm * 256 + wr * 64 + fr;
        if (pn == 44) {
            if (wc == 0 && fq < 2) { float* alr = (float*)(ws + WS_ALR);
#pragma unroll
                for (int ai = 0; ai < 2; ++ai)
#pragma unroll
                    for (int m = 0; m < 4; ++m) { float* rp = alr + (size_t)(row0 + ai * 128 + m * 16) * 16 + 8 * fq;
                        *(f32x4*)rp = acc[ai][0][m][0]; *(f32x4*)(rp + 4) = acc[ai][0][m][1]; } }
            return;
        }
        if (pn >= 16 && pn < 32) {
            bf16* G = (bf16*)(ws + WS_R); const int col0 = (pn - 16) * 128 + wc * 32 + 8 * fq;
#pragma unroll
            for (int ai = 0; ai < 2; ++ai)
#pragma unroll
                for (int m = 0; m < 4; ++m) { f32x4 g0, g1;
#pragma unroll
                    for (int j = 0; j < 4; ++j) { const float r0 = acc[ai][0][m][0][j], r1 = acc[ai][0][m][1][j], a0 = acc[ai][1][m][0][j], a1 = acc[ai][1][m][1][j];
                        g0[j] = r0 * sigmoidf_(r0) * sigmoidf_(a0); g1[j] = r1 * sigmoidf_(r1) * sigmoidf_(a1); }
                    st_bf16x8(G + (size_t)(row0 + ai * 128 + m * 16) * 2048 + col0, g0, g1); }
            return;
        }
        bf16* base; int ldc, ct; float sc = 1.f;
        if (pn < 4) { base = (bf16*)(ws + WS_Q); ldc = 1024; ct = pn; sc = 0.0625f; }
        else if (pn < 8) { base = (bf16*)(ws + WS_K); ldc = 1024; ct = pn - 4; }
        else if (pn < 16) { base = (bf16*)(ws + WS_V); ldc = 2048; ct = pn - 8; }
        else if (pn < 36) { base = (bf16*)(ws + WS_U); ldc = 1024; ct = pn - 32; }
        else { base = (bf16*)(ws + WS_GB); ldc = 2048; ct = pn - 36; }
        const int col0 = ct * 256 + wc * 32 + 8 * fq;
#pragma unroll
        for (int ai = 0; ai < 2; ++ai)
#pragma unroll
            for (int m = 0; m < 4; ++m) { bf16* rowp = base + (size_t)(row0 + ai * 128 + m * 16) * ldc + col0;
#pragma unroll
                for (int bj = 0; bj < 2; ++bj) st_bf16x8(rowp + bj * 128, acc[ai][bj][m][0] * sc, acc[ai][bj][m][1] * sc); }
    }
};
namespace gs {
using namespace pg8;
struct SUnit { int st, pm, pn, kt0, nkt, r, s, late; };
__device__ __forceinline__ bool su_next(int i, int G, int c, SUnit& u) {
    int st = 0, pm = 0, pn = 0, kt0 = 0, nkt = 32, r = 0, sp = 0, late = 0;
    if (G != 256) {
        const long LL = (long)i * G + c; if (LL >= 288 + 288 + 1152 + 288) return false;
        const int L = (int)LL; late = 1;
        if (L < 288) { st = 0; nkt = 4; pm = L >> 3; pn = L & 7; }
        else if (L < 576) { st = 1; pm = (L - 288) >> 3; pn = (L - 288) & 7; }
        else if (L < 1728) { st = 2; pm = (L - 576) >> 5; pn = (L - 576) & 31; }
        else { st = 3; nkt = 128; pm = (L - 1728) >> 3; pn = (L - 1728) & 7; }
    } else {
        const int ty = (c < 160) ? 0 : (c < 192 ? 1 : 2);
        const int last = (ty == 2) ? 7 : 8;
        if (i > last) return false;
        if (i <= 1) { const int x = c & 7, y = c >> 3; st = i; nkt = (i == 0) ? 4 : 32; late = i; pm = 8 * (x >> 1) + (y & 7); pn = 4 * (x & 1) + (y >> 3); }
        else if (i == last) { st = 4; const int x = c & 7; int y;
            if (ty == 2) { const int k = (c - 192) >> 3; y = k >> 1; sp = k & 1; } else if (ty == 1) { y = (c - 160) >> 3; sp = 2; } else { const int k = c >> 3; y = k / 5; sp = 3 + (k - 5 * y); }
            pm = 32 + y; pn = x; r = y * 8 + x;
            kt0 = (sp < 2) ? 22 * sp : (sp == 2 ? 44 : 58 + 14 * (sp - 3)); nkt = (sp < 2) ? 22 : 14; }
        else if (i == last - 1) { st = 3; nkt = 128; const int rank = (ty == 2) ? c - 192 : (ty == 1 ? c - 160 : c), P2 = (ty == 2) ? 4 : (ty == 1 ? 2 : 10), pm0 = (ty == 2) ? 0 : (ty == 1 ? 8 : 12);
            const int x = rank & 7, k = rank >> 3; pn = 2 * (x & 3) + (k & 1); pm = pm0 + (x >> 2) * P2 + (k >> 1); late = (pm >= 30) ? 1 : 0; }
        else if (ty == 1 && i <= 3) { st = i - 2; nkt = (i == 2) ? 4 : 32; late = i - 2; pm = 32 + ((c - 160) >> 3); pn = c & 7; }
        else { st = 2; int j2;
            if (i == 2) { j2 = (ty == 0) ? c : 160 + (c - 192); late = 1; } else if (i == 3) j2 = 224 + ((ty == 0) ? c : 160 + (c - 192)); else j2 = 448 + 256 * (i - 4) + c;
            const int rd = j2 >> 8, jr = j2 & 255, x = jr & 7, y = jr >> 3;
            pm = (rd < 4) ? 8 * rd + (y & 7) : 32 + (y & 3); pn = (rd < 4) ? 4 * x + (y >> 3) : 4 * x + (y >> 2);
            if (rd == 3) { if (y < 24) { pm = 24 + y % 6; pn = 4 * x + y / 6; } else { pm = 30 + (y & 1); pn = 4 * x + ((y - 24) >> 1); } } }
    }
    u.st = st; u.pm = pm; u.pn = pn; u.kt0 = kt0; u.nkt = nkt; u.r = r; u.s = sp; u.late = late;
    return true;
}
struct Ctx { unsigned char* ws; const float* xp; const float* xs; float* out; unsigned* ctl; const float* gn; const float* pscale; const float* gfin; };
__device__ __forceinline__ void st16_wt(__amdgpu_buffer_rsrc_t rs, unsigned off, v4u v) { __builtin_amdgcn_raw_buffer_store_b128(v, rs, off, 0, 16); }
__device__ __forceinline__ void st16_pl(__amdgpu_buffer_rsrc_t rs, unsigned off, v4u v) { __builtin_amdgcn_raw_buffer_store_b128(v, rs, off, 0, 0); }
#define ST16(X_, rs, off, v) st16_wt(rs, off, v)
__device__ __forceinline__ v4u pk8(f32x4 v0, f32x4 v1) { v4u w; w.x = cvt_pk_bf16(v0[0], v0[1]); w.y = cvt_pk_bf16(v0[2], v0[3]); w.z = cvt_pk_bf16(v1[0], v1[1]); w.w = cvt_pk_bf16(v1[2], v1[3]); return w; }
__device__ __forceinline__ float epi_rg(const Ctx& X, const SUnit& u, const f32x4 (&v)[2][2], int ai, int m, int wr, int wc, int fr, int fq) {
    const int row = u.pm * 256 + ai * 128 + wr * 64 + m * 16 + fr, col0 = u.pn * 256 + wc * 32 + 8 * fq;
    if (u.st == 0) {
        const float rs = __builtin_amdgcn_rsqf(((const float*)(X.ctl + CW_SSQ))[row * 4 + (u.pn >> 1)] * (1.f / DV) + EPS);
        const __amdgpu_buffer_rsrc_t rm = __builtin_amdgcn_make_buffer_rsrc((void*)(X.ws + WS_MB), (short)0, (int)((size_t)M * DM * 2), 0x00020000);
        const bf16* OG = (const bf16*)(X.ws + WS_OG); const bf16* Gt = (const bf16*)(X.ws + WS_R); const bf16* GB = (const bf16*)(X.ws + WS_GB);
#pragma unroll
        for (int bj = 0; bj < 2; ++bj) { const size_t o2 = (size_t)row * DM + col0 + bj * 128; const int cc = col0 + bj * 128;
            const v4u xo = *(const v4u*)(OG + o2), xg = *(const v4u*)(Gt + o2), xb = *(const v4u*)(GB + o2);
            const f32x4 n0 = *(const f32x4*)(X.gn + (cc & 511)), n1 = *(const f32x4*)(X.gn + (cc & 511) + 4), p0 = *(const f32x4*)(X.pscale + cc), p1 = *(const f32x4*)(X.pscale + cc + 4);
            const unsigned ao[4] = {xo.x, xo.y, xo.z, xo.w}, ag[4] = {xg.x, xg.y, xg.z, xg.w}, ab[4] = {xb.x, xb.y, xb.z, xb.w};
            f32x4 r0, r1;
#pragma unroll
            for (int j = 0; j < 2; ++j) {
                r0[2 * j] = bf2f(ag[j] & 0xffffu) * (bf2f(ao[j] & 0xffffu) * rs * n0[2 * j]) + sigmoidf_(bf2f(ab[j] & 0xffffu)) * (v[bj][0][2 * j] * p0[2 * j]);
                r0[2 * j + 1] = bf2f(ag[j] >> 16) * (bf2f(ao[j] >> 16) * rs * n0[2 * j + 1]) + sigmoidf_(bf2f(ab[j] >> 16)) * (v[bj][0][2 * j + 1] * p0[2 * j + 1]);
                r1[2 * j] = bf2f(ag[2 + j] & 0xffffu) * (bf2f(ao[2 + j] & 0xffffu) * rs * n1[2 * j]) + sigmoidf_(bf2f(ab[2 + j] & 0xffffu)) * (v[bj][1][2 * j] * p1[2 * j]);
                r1[2 * j + 1] = bf2f(ag[2 + j] >> 16) * (bf2f(ao[2 + j] >> 16) * rs * n1[2 * j + 1]) + sigmoidf_(bf2f(ab[2 + j] >> 16)) * (v[bj][1][2 * j + 1] * p1[2 * j + 1]); }
            ST16(X, rm, (unsigned)(o2 * 2), pk8(r0, r1)); }
        return 0.f;
    }
    if (u.st == 2) {
        const float rs = __builtin_amdgcn_rsqf(((const float*)(X.ctl + CW_SSQ1))[row] * (1.f / DM) + EPS);
        const __amdgpu_buffer_rsrc_t rh = __builtin_amdgcn_make_buffer_rsrc((void*)(X.ws + WS_HID), (short)0, (int)((size_t)M * FF * 2), 0x00020000);
#pragma unroll
        for (int bj = 0; bj < 2; ++bj) { f32x4 v0 = v[bj][0] * rs, v1 = v[bj][1] * rs;
#pragma unroll
            for (int j = 0; j < 4; ++j) { const float a = fmaxf(v0[j], 0.f), b = fmaxf(v1[j], 0.f); v0[j] = a * a; v1[j] = b * b; }
            ST16(X, rh, (unsigned)(((size_t)row * FF + col0 + bj * 128) * 2), pk8(v0, v1)); }
        return 0.f;
    }
    const size_t off = (size_t)row * DM + col0; float ss = 0.f;
    if (u.st == 1) {
        const float* xin = (row < NP) ? X.xp : X.xs - (size_t)NP * DM;
        const __amdgpu_buffer_rsrc_t rb = __builtin_amdgcn_make_buffer_rsrc((void*)(X.ws + WS_X1B), (short)0, (int)((size_t)M * DM * 2), 0x00020000);
#pragma unroll
        for (int bj = 0; bj < 2; ++bj) { const f32x4 a0 = *(const f32x4*)(xin + off + bj * 128), a1 = *(const f32x4*)(xin + off + bj * 128 + 4);
            const f32x4 v0 = a0 + v[bj][0], v1 = a1 + v[bj][1];
            ST16(X, rb, (unsigned)((off + bj * 128) * 2), pk8(v0, v1));
            ss += (v0[0] * v0[0] + v0[1] * v0[1]) + (v0[2] * v0[2] + v0[3] * v0[3]) + (v1[0] * v1[0] + v1[1] * v1[1]) + (v1[2] * v1[2] + v1[3] * v1[3]); }
        ss += __shfl_xor(ss, 16); ss += __shfl_xor(ss, 32);
        float old = 0.f; if (fq == 0) old = atomicAdd((float*)(X.ctl + CW_SSQ1) + row, ss);
        return old;
    } else {
        const bf16* x1 = (const bf16*)(X.ws + WS_X1B); float* xo = X.out + OUT_Y;
#pragma unroll
        for (int bj = 0; bj < 2; ++bj) { const v4u xa = *(const v4u*)(x1 + off + bj * 128);
            const f32x4 a0 = (f32x4){bf2f(xa.x & 0xffffu), bf2f(xa.x >> 16), bf2f(xa.y & 0xffffu), bf2f(xa.y >> 16)}, a1 = (f32x4){bf2f(xa.z & 0xffffu), bf2f(xa.z >> 16), bf2f(xa.w & 0xffffu), bf2f(xa.w >> 16)};
            const f32x4 v0 = a0 + v[bj][0], v1 = a1 + v[bj][1];
            *(f32x4*)(xo + off + bj * 128) = v0; *(f32x4*)(xo + off + bj * 128 + 4) = v1;
            ss += (v0[0] * v0[0] + v0[1] * v0[1]) + (v0[2] * v0[2] + v0[3] * v0[3]) + (v1[0] * v1[0] + v1[1] * v1[1]) + (v1[2] * v1[2] + v1[3] * v1[3]); }
        ss += __shfl_xor(ss, 16); ss += __shfl_xor(ss, 32);
        if (fq == 0) atomicAdd((float*)(X.ctl + CW_SSQ2) + row, ss);
    }
    return 0.f;
}
__device__ __forceinline__ void wait_count(unsigned* word, unsigned need, unsigned* tmo) {
    if (threadIdx.x < 64) {
        unsigned polls = 0;
        while ((unsigned)__builtin_amdgcn_readfirstlane(__hip_atomic_load(word, __ATOMIC_RELAXED, __HIP_MEMORY_SCOPE_AGENT)) < need) {
            if ((++polls & 1023u) == 0u) { if (__builtin_amdgcn_readfirstlane(__hip_atomic_load(tmo, __ATOMIC_RELAXED, __HIP_MEMORY_SCOPE_AGENT)) != 0u) break;
                if (polls > (1u << 22)) { if (threadIdx.x == 0) __hip_atomic_store(tmo, 1u, __ATOMIC_RELAXED, __HIP_MEMORY_SCOPE_AGENT); break; } }
            __builtin_amdgcn_s_sleep(2); }
        __builtin_amdgcn_fence(__ATOMIC_ACQUIRE, "agent");
        asm volatile("s_waitcnt vmcnt(0)" ::: "memory");
    }
    asm volatile("" ::: "memory"); __builtin_amdgcn_s_barrier(); asm volatile("" ::: "memory");
}
__device__ __forceinline__ void a_ready(const Ctx& X, const SUnit& u) {
    if (u.st == 0) return;
    unsigned* w = X.ctl + (u.st == 1 ? CW_CNTP : (u.st == 2 ? CW_CNT5 : CW_CNT6)) + 64 * u.pm;
    wait_count(w, u.st >= 3 ? 256u : 64u, X.ctl + CW_TMO);
}
__device__ __forceinline__ void epi2_comp(const Ctx& X, const SUnit& u, const f32x4 (&v)[2][2], float ssq, int ai, int m, int wr, int wc, int fr, int fq) {
    const int row = u.pm * 256 + ai * 128 + wr * 64 + m * 16 + fr, col0 = u.pn * 256 + wc * 32 + 8 * fq;
    const float rs = __builtin_amdgcn_rsqf(ssq * (1.f / DM) + EPS);
    const __amdgpu_buffer_rsrc_t rh = __builtin_amdgcn_make_buffer_rsrc((void*)(X.ws + WS_HID), (short)0, (int)((size_t)M * FF * 2), 0x00020000);
#pragma unroll
    for (int bj = 0; bj < 2; ++bj) { f32x4 v0 = v[bj][0] * rs, v1 = v[bj][1] * rs;
#pragma unroll
        for (int j = 0; j < 4; ++j) { const float a = fmaxf(v0[j], 0.f), b = fmaxf(v1[j], 0.f); v0[j] = a * a; v1[j] = b * b; }
        ST16(X, rh, (unsigned)(((size_t)row * FF + col0 + bj * 128) * 2), pk8(v0, v1)); }
}
typedef const __attribute__((address_space(1))) f32x4* gptr4;
__device__ __forceinline__ void epi0_comp(const Ctx& X, const SUnit& u, const f32x4 (&v)[2][2], float ssq, const f32x4 (&nv)[2][2], const f32x4 (&pv)[2][2], int ai, int m, int wr, int wc, int fr, int fq) {
    const int row = u.pm * 256 + ai * 128 + wr * 64 + m * 16 + fr, col0 = u.pn * 256 + wc * 32 + 8 * fq;
    const float rs = __builtin_amdgcn_rsqf(ssq * (1.f / DV) + EPS);
    const __amdgpu_buffer_rsrc_t rm = __builtin_amdgcn_make_buffer_rsrc((void*)(X.ws + WS_MB), (short)0, (int)((size_t)M * DM * 2), 0x00020000);
    const bf16* OG = (const bf16*)(X.ws + WS_OG); const bf16* Gt = (const bf16*)(X.ws + WS_R); const bf16* GB = (const bf16*)(X.ws + WS_GB);
    v4u xo[2], xg[2], xb[2];
#pragma unroll
    for (int bj = 0; bj < 2; ++bj) { const size_t o2 = (size_t)row * DM + col0 + bj * 128; xo[bj] = *(const v4u*)(OG + o2); xg[bj] = *(const v4u*)(Gt + o2); xb[bj] = *(const v4u*)(GB + o2); }
#pragma unroll
    for (int bj = 0; bj < 2; ++bj) { const size_t o2 = (size_t)row * DM + col0 + bj * 128;
        const unsigned ao[4] = {xo[bj].x, xo[bj].y, xo[bj].z, xo[bj].w}, ag[4] = {xg[bj].x, xg[bj].y, xg[bj].z, xg[bj].w}, ab[4] = {xb[bj].x, xb[bj].y, xb[bj].z, xb[bj].w};
        const f32x4 n0 = nv[bj][0] * rs, n1 = nv[bj][1] * rs, p0 = pv[bj][0], p1 = pv[bj][1];
        f32x4 r0, r1;
#pragma unroll
        for (int j = 0; j < 2; ++j) {
            r0[2 * j] = bf2f(ag[j] & 0xffffu) * (bf2f(ao[j] & 0xffffu) * n0[2 * j]) + sigmoidf_(bf2f(ab[j] & 0xffffu)) * (v[bj][0][2 * j] * p0[2 * j]);
            r0[2 * j + 1] = bf2f(ag[j] >> 16) * (bf2f(ao[j] >> 16) * n0[2 * j + 1]) + sigmoidf_(bf2f(ab[j] >> 16)) * (v[bj][0][2 * j + 1] * p0[2 * j + 1]);
            r1[2 * j] = bf2f(ag[2 + j] & 0xffffu) * (bf2f(ao[2 + j] & 0xffffu) * n1[2 * j]) + sigmoidf_(bf2f(ab[2 + j] & 0xffffu)) * (v[bj][1][2 * j] * p1[2 * j]);
            r1[2 * j + 1] = bf2f(ag[2 + j] >> 16) * (bf2f(ao[2 + j] >> 16) * n1[2 * j + 1]) + sigmoidf_(bf2f(ab[2 + j] >> 16)) * (v[bj][1][2 * j + 1] * p1[2 * j + 1]); }
        ST16(X, rm, (unsigned)(o2 * 2), pk8(r0, r1)); }
}
__device__ __forceinline__ void epi1_load(const Ctx& X, const SUnit& u, int ai, int m, int wr, int wc, int fr, int fq, f32x4 (&xa)[4]) {
    const int row = u.pm * 256 + ai * 128 + wr * 64 + m * 16 + fr, col0 = u.pn * 256 + wc * 32 + 8 * fq;
    const float* xin = ((row < NP) ? X.xp : X.xs - (size_t)NP * DM) + (size_t)row * DM + col0;
    xa[0] = *(const f32x4*)(xin); xa[1] = *(const f32x4*)(xin + 4); xa[2] = *(const f32x4*)(xin + 128); xa[3] = *(const f32x4*)(xin + 132);
}
__device__ __forceinline__ float epi1_comp(const Ctx& X, const SUnit& u, const f32x4 (&v)[2][2], const f32x4 (&xa)[4], int ai, int m, int wr, int wc, int fr, int fq) {
    const int row = u.pm * 256 + ai * 128 + wr * 64 + m * 16 + fr, col0 = u.pn * 256 + wc * 32 + 8 * fq;
    const size_t off = (size_t)row * DM + col0; float ss = 0.f;
    const __amdgpu_buffer_rsrc_t rb = __builtin_amdgcn_make_buffer_rsrc((void*)(X.ws + WS_X1B), (short)0, (int)((size_t)M * DM * 2), 0x00020000);
#pragma unroll
    for (int bj = 0; bj < 2; ++bj) { const f32x4 v0 = xa[2 * bj] + v[bj][0], v1 = xa[2 * bj + 1] + v[bj][1];
        ST16(X, rb, (unsigned)((off + bj * 128) * 2), pk8(v0, v1));
        ss += (v0[0] * v0[0] + v0[1] * v0[1]) + (v0[2] * v0[2] + v0[3] * v0[3]) + (v1[0] * v1[0] + v1[1] * v1[1]) + (v1[2] * v1[2] + v1[3] * v1[3]); }
    ss += __shfl_xor(ss, 16); ss += __shfl_xor(ss, 32);
    float old = 0.f; if (fq == 0) old = atomicAdd((float*)(X.ctl + CW_SSQ1) + row, ss);
    return old;
}
__device__ __forceinline__ void x1_load(const Ctx& X, const SUnit& u, int ai, int m, int wr, int wc, int fr, int fq, v4u (&xa)[2]) {
    const int row = u.pm * 256 + ai * 128 + wr * 64 + m * 16 + fr, col0 = u.pn * 256 + wc * 32 + 8 * fq;
    const bf16* x1 = (const bf16*)(X.ws + WS_X1B) + (size_t)row * DM + col0; xa[0] = *(const v4u*)x1; xa[1] = *(const v4u*)(x1 + 128);
}
__device__ __forceinline__ float x2_rg(f32x4 (&v)[2][2], const v4u (&xr)[2]) {
    float ss = 0.f;
#pragma unroll
    for (int bj = 0; bj < 2; ++bj) { const v4u xa = xr[bj];
        v[bj][0] += (f32x4){bf2f(xa.x & 0xffffu), bf2f(xa.x >> 16), bf2f(xa.y & 0xffffu), bf2f(xa.y >> 16)}; v[bj][1] += (f32x4){bf2f(xa.z & 0xffffu), bf2f(xa.z >> 16), bf2f(xa.w & 0xffffu), bf2f(xa.w >> 16)};
        const f32x4 v0 = v[bj][0], v1 = v[bj][1];
        ss += (v0[0] * v0[0] + v0[1] * v0[1]) + (v0[2] * v0[2] + v0[3] * v0[3]) + (v1[0] * v1[0] + v1[1] * v1[1]) + (v1[2] * v1[2] + v1[3] * v1[3]); }
    ss += __shfl_xor(ss, 16); ss += __shfl_xor(ss, 32);
    return ss;
}
__device__ __forceinline__ void y_rg(const Ctx& X, const SUnit& u, const f32x4 (&v)[2][2], float rstd, int ai, int m, int wr, int wc, int fr, int fq) {
    const int row = u.pm * 256 + ai * 128 + wr * 64 + m * 16 + fr, col0 = u.pn * 256 + wc * 32 + 8 * fq;
    float* yo = X.out + OUT_Y + (size_t)row * DM + col0;
#pragma unroll
    for (int bj = 0; bj < 2; ++bj) { const f32x4 g0 = *(gptr4)(X.gfin + col0 + bj * 128), g1 = *(gptr4)(X.gfin + col0 + bj * 128 + 4);
        *(f32x4*)(yo + bj * 128) = v[bj][0] * rstd * g0; *(f32x4*)(yo + bj * 128 + 4) = v[bj][1] * rstd * g1; }
}
__device__ __forceinline__ void gemm_stream(LAS unsigned char* lds, const Ctx X, const int G, const int c) {
    const int tid = threadIdx.x, wid = __builtin_amdgcn_readfirstlane(tid >> 6), lane = tid & 63, wr = wid >> 2, wc = wid & 3, fr = lane & 15, fq = lane >> 4;
    unsigned RA2[2], RB2[2], C2[2];
#pragma unroll
    for (int i = 0; i < 2; ++i) { int R, C; stage_rc(tid * 16 + i * 8192, R, C); RA2[i] = (unsigned)R * 2u; RB2[i] = (unsigned)((R & ~31) + perm32(R & 31)) * 2u; C2[i] = (unsigned)C * 2u; }
    const size_t kstep = (size_t)(BK * 2);
    const unsigned ldsw = (unsigned)wid * 1024u;
    const int aoff = lds_byte(wr * 64 + fr, fq * 8), boff = lds_byte(wc * 32 + fr, fq * 8);
#define GS_LDA(u) ((u).st == 0 ? 1024 : ((u).st >= 3 ? FF : DM))
#define GS_LDB(u) ((u).st == 0 ? 256 : ((u).st >= 3 ? FF : DM))
#define GS_ABASE(u) ((const char*)X.ws + ((u).st == 0 ? WS_PB : ((u).st == 1 ? WS_MB : ((u).st == 2 ? WS_X1B : WS_HID))) + ((size_t)(u).pm * 256 * GS_LDA(u) + (size_t)(u).kt0 * BK + ((u).st == 0 ? ((u).pn >> 1) * 256 : 0)) * 2)
#define GS_BBASE(u) ((const char*)X.ws + ((u).st == 0 ? WS_WPOOL : ((u).st == 1 ? WS_WOUT : ((u).st == 2 ? WS_WUP : WS_WDN))) + ((size_t)(u).pn * 256 * GS_LDB(u) + (size_t)(u).kt0 * BK) * 2)
#define PG8_SA(b, h) (((b) * 2 + (h)) * HTB)
#define PG8_SB(b, h) ((4 + (b) * 2 + (h)) * HTB)
#define PG8_STAGE(bufoff, gbase, R2, ld) do { _Pragma("unroll") for (int _i = 0; _i < 2; ++_i) \
        __builtin_amdgcn_global_load_lds((const unsigned*)((const char*)(gbase) + ((R2)[_i] * (unsigned)(ld) + C2[_i])), (LAS unsigned*)(lds + (bufoff) + ldsw + _i * 8192), 16, 0, 0); } while (0)
#define PG8_LDA(dst, b, h) do { _Pragma("unroll") for (int m = 0; m < 4; ++m) _Pragma("unroll") for (int k = 0; k < 2; ++k) dst[m][k] = *(const LAS bf16x8*)(lds + PG8_SA(b, h) + aoff + m * 2048 + k * 1024); } while (0)
#define PG8_LDB(dst, b, h) do { _Pragma("unroll") for (int n = 0; n < 2; ++n) _Pragma("unroll") for (int k = 0; k < 2; ++k) dst[n][k] = *(const LAS bf16x8*)(lds + PG8_SB(b, h) + boff + n * 2048 + k * 1024); } while (0)
#define PG8_MMA(ai, bj, At, Bt) do { __builtin_amdgcn_s_setprio(1); _Pragma("unroll") for (int m = 0; m < 4; ++m) _Pragma("unroll") for (int n = 0; n < 2; ++n) _Pragma("unroll") for (int k = 0; k < 2; ++k) \
        acc[ai][bj][m][n] = __builtin_amdgcn_mfma_f32_16x16x32_bf16(Bt[n][k], At[m][k], acc[ai][bj][m][n], 0, 0, 0); __builtin_amdgcn_s_setprio(0); } while (0)
#define PG8_WAIT_V(n) asm volatile("s_waitcnt vmcnt(" #n ")" ::: "memory")
#define PG8_WAIT_L(n) asm volatile("s_waitcnt lgkmcnt(" #n ")" ::: "memory")
#define PG8_BAR __builtin_amdgcn_s_barrier()
#define PG8_SCHED __builtin_amdgcn_sched_barrier(0)
    SUnit cur, nxt; int ui = 0, pend = -1;
    if (!su_next(0, G, c, cur)) return;
    f32x4 acc[2][2][4][2];
#pragma unroll
    for (int a = 0; a < 2; ++a)
#pragma unroll
        for (int b = 0; b < 2; ++b)
#pragma unroll
            for (int m = 0; m < 4; ++m)
#pragma unroll
                for (int n = 0; n < 2; ++n) acc[a][b][m][n] = (f32x4){0.f, 0.f, 0.f, 0.f};
    bf16x8 At[4][2], B0[2][2], B1[2][2];
    const char* cA = GS_ABASE(cur); const char* cB = GS_BBASE(cur); int clA = GS_LDA(cur), clB = GS_LDB(cur);
#define GS_PROLOGUE() do { a_ready(X, cur); const size_t hA_ = (size_t)HALF * clA * 2, hB_ = (size_t)HALF * clB * 2; \
    PG8_STAGE(PG8_SB(0, 0), cB, RB2, clB); PG8_STAGE(PG8_SB(0, 1), cB + hB_, RB2, clB); PG8_STAGE(PG8_SA(0, 0), cA, RA2, clA); PG8_STAGE(PG8_SA(0, 1), cA + hA_, RA2, clA); \
    if (wr == 1) PG8_BAR; \
    PG8_WAIT_V(2); PG8_BAR; \
    PG8_STAGE(PG8_SB(1, 0), cB + kstep, RB2, clB); PG8_STAGE(PG8_SA(1, 0), cA + kstep, RA2, clA); PG8_STAGE(PG8_SB(1, 1), cB + hB_ + kstep, RB2, clB); \
    PG8_WAIT_V(6); PG8_BAR; } while (0)
    GS_PROLOGUE();
    for (;;) {
        const bool has_next = su_next(ui + 1, G, c, nxt);
        const bool early = has_next && !nxt.late;
        const char* nA = early ? GS_ABASE(nxt) : cA; const char* nB = early ? GS_BBASE(nxt) : cB; const int nlA = early ? GS_LDA(nxt) : clA, nlB = early ? GS_LDB(nxt) : clB;
        const int nt = cur.nkt; const size_t hA = (size_t)HALF * clA * 2;
#pragma unroll 1
        for (int t = 0; t < nt; t += 2) {
            const bool last = (t == nt - 2);
            const char* a1 = cA + (size_t)(t + 1) * kstep;
            const char* a2 = last ? nA : cA + (size_t)(t + 2) * kstep; const char* b2 = last ? nB : cB + (size_t)(t + 2) * kstep;
            const char* a3 = a2 + kstep; const char* b3 = b2 + kstep;
            const int lA2 = last ? nlA : clA, lB2 = last ? nlB : clB; const size_t hA2 = (size_t)HALF * lA2 * 2, hB2 = (size_t)HALF * lB2 * 2;
            if (last && early) a_ready(X, nxt);
            PG8_LDB(B0, 0, 0); PG8_LDB(B1, 0, 1); PG8_SCHED; PG8_LDA(At, 0, 0); PG8_STAGE(PG8_SA(1, 1), a1 + hA, RA2, clA);
            PG8_WAIT_V(8); PG8_WAIT_L(0); PG8_BAR; PG8_MMA(0, 0, At, B0); PG8_MMA(0, 1, At, B1); PG8_BAR; PG8_SCHED;
            PG8_LDA(At, 0, 1); PG8_STAGE(PG8_SB(0, 0), b2, RB2, lB2); PG8_STAGE(PG8_SB(0, 1), b2 + hB2, RB2, lB2); PG8_STAGE(PG8_SA(0, 0), a2, RA2, lA2);
            PG8_WAIT_V(8); PG8_WAIT_L(0); PG8_BAR; PG8_MMA(1, 0, At, B0); PG8_MMA(1, 1, At, B1); PG8_BAR; PG8_SCHED;
            PG8_LDB(B0, 1, 0); PG8_LDB(B1, 1, 1); PG8_SCHED; PG8_LDA(At, 1, 0); PG8_STAGE(PG8_SA(0, 1), a2 + hA2, RA2, lA2);
            PG8_WAIT_V(8); PG8_WAIT_L(0); PG8_BAR; PG8_MMA(0, 0, At, B0); PG8_MMA(0, 1, At, B1); PG8_BAR; PG8_SCHED;
            PG8_LDA(At, 1, 1); PG8_STAGE(PG8_SB(1, 0), b3, RB2, lB2); PG8_STAGE(PG8_SB(1, 1), b3 + hB2, RB2, lB2); PG8_STAGE(PG8_SA(1, 0), a3, RA2, lA2);
            PG8_WAIT_V(8); PG8_WAIT_L(0); PG8_BAR; PG8_MMA(1, 0, At, B0); PG8_MMA(1, 1, At, B1);
            if (pend >= 0) { PG8_WAIT_V(0); if (lane == 0) __hip_atomic_fetch_add(X.ctl + pend, 1u, __ATOMIC_RELAXED, __HIP_MEMORY_SCOPE_AGENT); pend = -1; }
            PG8_BAR; PG8_SCHED;
        }
        if (wr == 0) PG8_BAR;
        int fr_ = fr, fq_ = fq; asm volatile("" : "+v"(fr_), "+v"(fq_));
        if (cur.st == 3 && G == 256) {
            LAS float* XP = (LAS float*)(lds + STAGE_BYTES); LAS float* XR = XP + 1024;
            { v4u xr[8][2];
#pragma unroll
            for (int k = 0; k < 8; ++k) x1_load(X, cur, k >> 2, k & 3, wr, wc, fr_, fq_, xr[k]);
#pragma unroll
            for (int k = 0; k < 8; ++k) { const int ai = k >> 2, m = k & 3;
                    f32x4 v[2][2] = {{acc[ai][0][m][0], acc[ai][0][m][1]}, {acc[ai][1][m][0], acc[ai][1][m][1]}};
                    const float ss = x2_rg(v, xr[k]);
                    acc[ai][0][m][0] = v[0][0]; acc[ai][0][m][1] = v[0][1]; acc[ai][1][m][0] = v[1][0]; acc[ai][1][m][1] = v[1][1];
                    if (fq_ == 0) XP[(ai * 128 + wr * 64 + m * 16 + fr_) * 4 + wc] = ss; } }
            PG8_WAIT_L(0); PG8_BAR; asm volatile("" ::: "memory");
            float* xs_ = (float*)(X.ws + WS_XS) + (size_t)cur.pm * 2048;
            if (tid < 256) { const f32x4 p4 = *(const LAS f32x4*)(XP + tid * 4); __hip_atomic_store(xs_ + cur.pn * 256 + tid, (p4[0] + p4[1]) + (p4[2] + p4[3]), __ATOMIC_RELAXED, __HIP_MEMORY_SCOPE_AGENT);
                asm volatile("s_waitcnt vmcnt(0)" ::: "memory");
                if (lane == 0) __hip_atomic_fetch_add(X.ctl + CW_CNT7 + 64 * cur.pm, 1u, __ATOMIC_RELAXED, __HIP_MEMORY_SCOPE_AGENT); }
            wait_count(X.ctl + CW_CNT7 + 64 * cur.pm, 32u, X.ctl + CW_TMO);
            if (tid < 256) { float tot = 0.f;
#pragma unroll
                for (int q = 0; q < 8; ++q) tot += xs_[q * 256 + tid];
                XR[tid] = __builtin_amdgcn_rsqf(tot * (1.f / DM) + EPS); }
            PG8_WAIT_L(0); PG8_BAR; asm volatile("" ::: "memory");
#pragma unroll
            for (int ai = 0; ai < 2; ++ai)
#pragma unroll
                for (int m = 0; m < 4; ++m) { const f32x4 v[2][2] = {{acc[ai][0][m][0], acc[ai][0][m][1]}, {acc[ai][1][m][0], acc[ai][1][m][1]}};
                    y_rg(X, cur, v, XR[ai * 128 + wr * 64 + m * 16 + fr_], ai, m, wr, wc, fr_, fq_); asm volatile("" ::: "memory"); }
            PG8_WAIT_L(0); PG8_BAR; asm volatile("" ::: "memory");
        } else if (cur.st != 4) { float olds[8];
            if (cur.st == 1) { f32x4 xa[2][4]; epi1_load(X, cur, 0, 0, wr, wc, fr_, fq_, xa[0]);
#pragma unroll
                for (int k = 0; k < 8; ++k) { const int ai = k >> 2, m = k & 3;
                    if (k < 7) epi1_load(X, cur, (k + 1) >> 2, (k + 1) & 3, wr, wc, fr_, fq_, xa[(k + 1) & 1]);
                    const f32x4 v[2][2] = {{acc[ai][0][m][0], acc[ai][0][m][1]}, {acc[ai][1][m][0], acc[ai][1][m][1]}}; olds[k] = epi1_comp(X, cur, v, xa[k & 1], ai, m, wr, wc, fr_, fq_); }
                asm volatile("" :: "v"(olds[0]), "v"(olds[1]), "v"(olds[2]), "v"(olds[3]), "v"(olds[4]), "v"(olds[5]), "v"(olds[6]), "v"(olds[7]));
            } else if (cur.st == 2) { float sq[8];
#pragma unroll
                for (int k = 0; k < 8; ++k) sq[k] = ((const float*)(X.ctl + CW_SSQ1))[cur.pm * 256 + (k >> 2) * 128 + wr * 64 + (k & 3) * 16 + fr_];
#pragma unroll
                for (int k = 0; k < 8; ++k) { const int ai = k >> 2, m = k & 3;
                    const f32x4 v[2][2] = {{acc[ai][0][m][0], acc[ai][0][m][1]}, {acc[ai][1][m][0], acc[ai][1][m][1]}}; epi2_comp(X, cur, v, sq[k], ai, m, wr, wc, fr_, fq_); }
            } else if (cur.st == 0) { float sq[8]; f32x4 nv[2][2], pv[2][2];
                { const int cc = cur.pn * 256 + wc * 32 + 8 * fq_;
#pragma unroll
                for (int bj = 0; bj < 2; ++bj) { nv[bj][0] = *(gptr4)(X.gn + ((cc + bj * 128) & 511)); nv[bj][1] = *(gptr4)(X.gn + ((cc + bj * 128) & 511) + 4); pv[bj][0] = *(gptr4)(X.pscale + cc + bj * 128); pv[bj][1] = *(gptr4)(X.pscale + cc + bj * 128 + 4); } }
#pragma unroll
                for (int k = 0; k < 8; ++k) sq[k] = ((const float*)(X.ctl + CW_SSQ))[(cur.pm * 256 + (k >> 2) * 128 + wr * 64 + (k & 3) * 16 + fr_) * 4 + (cur.pn >> 1)];
#pragma unroll
                for (int k = 0; k < 8; ++k) { const int ai = k >> 2, m = k & 3;
                    const f32x4 v[2][2] = {{acc[ai][0][m][0], acc[ai][0][m][1]}, {acc[ai][1][m][0], acc[ai][1][m][1]}}; epi0_comp(X, cur, v, sq[k], nv, pv, ai, m, wr, wc, fr_, fq_); }
            } else {
#pragma unroll
            for (int ai = 0; ai < 2; ++ai)
#pragma unroll
                for (int m = 0; m < 4; ++m) { const f32x4 v[2][2] = {{acc[ai][0][m][0], acc[ai][0][m][1]}, {acc[ai][1][m][0], acc[ai][1][m][1]}}; olds[ai * 4 + m] = epi_rg(X, cur, v, ai, m, wr, wc, fr_, fq_); }
            }
            if (cur.st < 3) {
                const int widx = (cur.st == 0 ? CW_CNTP : (cur.st == 1 ? CW_CNT5 : CW_CNT6)) + 64 * cur.pm;
                if (early) pend = widx;
                else { asm volatile("s_waitcnt vmcnt(0)" ::: "memory"); if (lane == 0) __hip_atomic_fetch_add(X.ctl + widx, 1u, __ATOMIC_RELAXED, __HIP_MEMORY_SCOPE_AGENT); } }
        } else {
            const __amdgpu_buffer_rsrc_t rsl = __builtin_amdgcn_make_buffer_rsrc((void*)(X.ws + WS_SLAB + (size_t)(cur.r * 8 + cur.s) * 131072), (short)0, 131072, 0x00020000);
#pragma unroll
            for (int ai = 0; ai < 2; ++ai)
#pragma unroll
                for (int bj = 0; bj < 2; ++bj)
#pragma unroll
                    for (int m = 0; m < 4; ++m) st16_wt(rsl, (unsigned)((((ai * 2 + bj) * 4 + m)) * 8192 + tid * 16), pk8(acc[ai][bj][m][0], acc[ai][bj][m][1]));
            asm volatile("s_waitcnt vmcnt(0)" ::: "memory");
            if (lane == 0) __hip_atomic_fetch_add(X.ctl + CW_CNTS + 64 * cur.r, 1u, __ATOMIC_RELAXED, __HIP_MEMORY_SCOPE_AGENT);
            wait_count(X.ctl + CW_CNTS + 64 * cur.r, 64u, X.ctl + CW_TMO);
            const int rai = cur.s >> 2, rm = cur.s & 3;
            f32x4 v[2][2] = {{(f32x4){0.f, 0.f, 0.f, 0.f}, (f32x4){0.f, 0.f, 0.f, 0.f}}, {(f32x4){0.f, 0.f, 0.f, 0.f}, (f32x4){0.f, 0.f, 0.f, 0.f}}};
            const char* sb = (const char*)(X.ws + WS_SLAB) + (size_t)cur.r * 8 * 131072 + (size_t)((rai * 2) * 4 + rm) * 8192 + (size_t)tid * 16;
#pragma unroll
            for (int p = 0; p < 8; ++p)
#pragma unroll
                for (int bj = 0; bj < 2; ++bj) { const v4u x = *(const v4u*)(sb + (size_t)p * 131072 + (size_t)(bj * 4) * 8192);
                    v[bj][0] += (f32x4){bf2f(x.x & 0xffffu), bf2f(x.x >> 16), bf2f(x.y & 0xffffu), bf2f(x.y >> 16)};
                    v[bj][1] += (f32x4){bf2f(x.z & 0xffffu), bf2f(x.z >> 16), bf2f(x.w & 0xffffu), bf2f(x.w >> 16)}; }
            if (G != 256) (void)epi_rg(X, cur, v, rai, rm, wr, wc, fr_, fq_);
            else {
                LAS float* XP = (LAS float*)(lds + STAGE_BYTES); LAS float* XR = XP + 1024;
                v4u xr4[2]; x1_load(X, cur, rai, rm, wr, wc, fr_, fq_, xr4); const float ss = x2_rg(v, xr4);
                if (fq_ == 0) XP[(wr * 16 + fr_) * 4 + wc] = ss;
                PG8_WAIT_L(0); PG8_BAR; asm volatile("" ::: "memory");
                const int gi = (cur.pm - 32) * 8 + cur.s; float* xs4 = (float*)(X.ws + WS_XS4) + (size_t)gi * 256;
                if (tid < 32) { const f32x4 p4 = *(const LAS f32x4*)(XP + tid * 4); __hip_atomic_store(xs4 + cur.pn * 32 + tid, (p4[0] + p4[1]) + (p4[2] + p4[3]), __ATOMIC_RELAXED, __HIP_MEMORY_SCOPE_AGENT);
                    asm volatile("s_waitcnt vmcnt(0)" ::: "memory");
                    if (lane == 0) __hip_atomic_fetch_add(X.ctl + CW_CNT8 + 64 * gi, 1u, __ATOMIC_RELAXED, __HIP_MEMORY_SCOPE_AGENT); }
                wait_count(X.ctl + CW_CNT8 + 64 * gi, 8u, X.ctl + CW_TMO);
                if (tid < 32) { float tot = 0.f;
#pragma unroll
                    for (int q = 0; q < 8; ++q) tot += xs4[q * 32 + tid];
                    XR[tid] = __builtin_amdgcn_rsqf(tot * (1.f / DM) + EPS); }
                PG8_WAIT_L(0); PG8_BAR; asm volatile("" ::: "memory");
                y_rg(X, cur, v, XR[wr * 16 + fr_], rai, rm, wr, wc, fr_, fq_);
            }
        }
        if (!has_next) break;
#pragma unroll
        for (int a = 0; a < 2; ++a)
#pragma unroll
            for (int b = 0; b < 2; ++b)
#pragma unroll
                for (int m = 0; m < 4; ++m)
#pragma unroll
                    for (int n = 0; n < 2; ++n) acc[a][b][m][n] = (f32x4){0.f, 0.f, 0.f, 0.f};
        cur = nxt; ++ui;
        if (early) { cA = nA; cB = nB; clA = nlA; clB = nlB; if (wr == 1) PG8_BAR; }
        else { PG8_WAIT_V(0); PG8_BAR; cA = GS_ABASE(cur); cB = GS_BBASE(cur); clA = GS_LDA(cur); clB = GS_LDB(cur); GS_PROLOGUE(); }
    }
    PG8_WAIT_V(0);
    PG8_BAR;
#undef GS_PROLOGUE
#undef GS_LDA
#undef GS_LDB
#undef GS_ABASE
#undef GS_BBASE
#undef PG8_SA
#undef PG8_SB
#undef PG8_STAGE
#undef PG8_LDA
#undef PG8_LDB
#undef PG8_MMA
#undef PG8_WAIT_V
#undef PG8_WAIT_L
#undef PG8_BAR
#undef PG8_SCHED
}
}

#define XB_TMO      128
#define XB_XCNT(j)  (256  + 64 * (j))
#define XB_XSUB(j)  (1280 + 64 * (j))
#define XB_XGEN(j)  (2304 + 64 * (j))
#define XB_TOP      3328
#define XB_TOPGEN   3392
#define XCD_BAR_WORDS 3456
#define XB_SPIN_CAP (1u << 18)
__device__ __forceinline__ unsigned xb_ld(unsigned* p)              { return __hip_atomic_load(p, __ATOMIC_RELAXED, __HIP_MEMORY_SCOPE_AGENT); }
__device__ __forceinline__ unsigned xb_add(unsigned* p, unsigned v) { return __hip_atomic_fetch_add(p, v, __ATOMIC_RELAXED, __HIP_MEMORY_SCOPE_AGENT); }
__device__ __forceinline__ unsigned xb_xcc_id() { return (unsigned)__builtin_amdgcn_s_getreg((3 << 11) | 20) & 0xFu; }
#define XB_SPIN(cond, bar) do { unsigned _sp = 0; while (cond) { __builtin_amdgcn_s_sleep(1); \
    if ((++_sp & 255u) == 0u) { if (xb_ld(&(bar)[XB_TMO])) break; if (_sp > XB_SPIN_CAP) { atomicAdd(&(bar)[XB_TMO], 1u); break; } } } } while (0)
struct XcdBarrier { unsigned* bar; unsigned x; volatile LAS unsigned* st; };
__device__ __forceinline__ XcdBarrier xcd_barrier_post(unsigned* bar, volatile LAS unsigned* st) {
    XcdBarrier b; b.bar = bar; b.x = xb_xcc_id(); b.st = st;
    if (threadIdx.x == 0) (void)xb_add(&bar[XB_XCNT(b.x)], 1u);
    return b;
}
__device__ __forceinline__ void xcd_barrier_complete(unsigned* bar, unsigned x, unsigned& nloc, unsigned& nx) {
    const unsigned G = gridDim.x * gridDim.y * gridDim.z;
    unsigned sum, cnt, mine, sp = 0u;
    for (;;) {
        sum = 0u; cnt = 0u; mine = 0u;
#pragma unroll
        for (unsigned j = 0; j < 16; ++j) { const unsigned c = xb_ld(&bar[XB_XCNT(j)]); sum += c; cnt += (c > 0u) ? 1u : 0u; mine = (j == x) ? c : mine; }
        if (sum == G) break;
        __builtin_amdgcn_s_sleep(1);
        if ((++sp & 255u) == 0u) { if (xb_ld(&bar[XB_TMO])) break; if (sp > XB_SPIN_CAP) { atomicAdd(&bar[XB_TMO], 1u); break; } }
    }
    nloc = mine > 0u ? mine : 1u; nx = cnt > 0u ? cnt : 1u;
}
__device__ __forceinline__ void xcd_barrier(const XcdBarrier& b) {
    asm volatile("s_waitcnt vmcnt(0)" ::: "memory");
    __syncthreads();
    if (threadIdx.x == 0) {
        unsigned* bar = b.bar;
        __builtin_amdgcn_s_waitcnt(0);
        unsigned nloc = b.st[0], nx = b.st[1];
        if (nloc == 0u) { xcd_barrier_complete(bar, b.x, nloc, nx); b.st[0] = nloc; b.st[1] = nx; }
        const unsigned old = xb_add(&bar[XB_XSUB(b.x)], 1u);
        const unsigned gen = old / nloc;
        if (old + 1u == (gen + 1u) * nloc) {
            __builtin_amdgcn_fence(__ATOMIC_RELEASE, "agent");
            asm volatile("s_waitcnt vmcnt(0)" ::: "memory");
            const unsigned og = xb_add(&bar[XB_TOP], 1u);
            const unsigned tg = og / nx;
            if (og + 1u == (tg + 1u) * nx) xb_add(&bar[XB_TOPGEN], 1u);
            else XB_SPIN(xb_ld(&bar[XB_TOPGEN]) == tg, bar);
            __builtin_amdgcn_fence(__ATOMIC_ACQUIRE, "agent");
            xb_add(&bar[XB_XGEN(b.x)], 1u);
            asm volatile("s_waitcnt vmcnt(0)" ::: "memory");
        } else {
            XB_SPIN(xb_ld(&bar[XB_XGEN(b.x)]) == gen, bar);
            __builtin_amdgcn_fence(__ATOMIC_ACQUIRE, "agent");
            asm volatile("s_waitcnt vmcnt(0)" ::: "memory");
        }
    }
    __syncthreads();
}

struct Frame {
    LAS unsigned char* lds;
    volatile LAS unsigned* MISC;
    unsigned* ctl;
    int tid, lane, wave, vcu, G;
    float* out; unsigned char* ws;
    __device__ __forceinline__ const float* inp(int k) const { const LAS unsigned* t = (const LAS unsigned*)(lds + PTAB_OFF) + 2 * k;
        const unsigned lo = __builtin_amdgcn_readfirstlane(t[0]), hi = __builtin_amdgcn_readfirstlane(t[1]); return (const float*)(((unsigned long long)hi << 32) | lo); }
};

template <bool SCALE>
__device__ __forceinline__ void tr_item(const float* W, int ldw, int scol, int ncols, const float* ks, bf16* WT, int ldt, int drow, int k0, LAS float* scr, int lane) {
    const int j = lane & 31, jc = (j < ncols) ? j : 0;
    const float* src = W + (size_t)(k0 + (lane >> 5)) * ldw + scol + jc;
    float v[32];
#pragma unroll
    for (int i = 0; i < 32; ++i) v[i] = src[(size_t)(2 * i) * ldw];
    if (SCALE) {
#pragma unroll
        for (int i = 0; i < 32; ++i) v[i] *= ks[k0 + 2 * i + (lane >> 5)]; }
    const float msk = (j < ncols) ? 1.f : 0.f;
#pragma unroll
    for (int i = 0; i < 32; ++i) scr[(2 * i + (lane >> 5)) * 33 + j] = v[i] * msk;
    LDS_WAIT(); asm volatile("" ::: "memory");
    const int c = lane & 7;
#pragma unroll
    for (int jj = 0; jj < 4; ++jj) { const int n = (lane >> 3) + 8 * jj; const LAS float* s = scr + (8 * c) * 33 + n;
        v4u o; o.x = cvt_pk_bf16(s[0 * 33], s[1 * 33]); o.y = cvt_pk_bf16(s[2 * 33], s[3 * 33]); o.z = cvt_pk_bf16(s[4 * 33], s[5 * 33]); o.w = cvt_pk_bf16(s[6 * 33], s[7 * 33]);
        *(v4u*)(WT + (size_t)(drow + n) * ldt + k0 + 8 * c) = o; }
    LDS_WAIT(); asm volatile("" ::: "memory");
}
__device__ __forceinline__ void p0_prologue(Frame& F, const int part, const int gw, const int NGW) {
    LAS float* scr = (LAS float*)(F.lds + F.wave * 16384);
    const int lane = F.lane;
    constexpr int I_IN = 32 * 360, I_OUT = 32 * 64, I_UP = 32 * 256, I_DN = 128 * 64, I_PL = 4 * 64;
    constexpr int NITEMS = I_IN + I_OUT + I_UP + I_DN + I_PL;
    unsigned char* ws = F.ws;
    for (int it = (part == 0 ? 0 : I_IN) + gw; it < (part == 0 ? I_IN : NITEMS); it += NGW) {
        int r = it;
        if (r < I_IN) { const int kb = r / 360, nb = r % 360, n0 = nb * 32; int scol, nc;
            if (n0 < 4096) { scol = n0; nc = 32; }
            else if (n0 < 8192) { const int t = (n0 - 4096) >> 8, w = (n0 - 4096) & 255; scol = (w < 128) ? 4096 + 128 * t + w : 7184 + 128 * t + (w - 128); nc = 32; }
            else if (n0 < 9216) { scol = 6160 + (n0 - 8192); nc = 32; }
            else if (n0 < 11264) { scol = 9232 + (n0 - 9216); nc = 32; }
            else if (n0 == 11264) { scol = 6144; nc = 16; } else { scol = 0; nc = 0; }
            tr_item<false>(F.inp(5), INW, scol, nc, nullptr, (bf16*)(ws + WS_WIN), DM, n0, kb * 64, scr, lane); continue; } r -= I_IN;
        if (r < I_OUT) { const int kb = r / 64, nb = r % 64; tr_item<false>(F.inp(11), DM, nb * 32, 32, nullptr, (bf16*)(ws + WS_WOUT), DM, nb * 32, kb * 64, scr, lane); continue; } r -= I_OUT;
        if (r < I_UP) { const int kb = r / 256, nb = r % 256; tr_item<true>(F.inp(13), FF, nb * 32, 32, F.inp(12), (bf16*)(ws + WS_WUP), DM, nb * 32, kb * 64, scr, lane); continue; } r -= I_UP;
        if (r < I_DN) { const int kb = r / 64, nb = r % 64; tr_item<false>(F.inp(14), DM, nb * 32, 32, nullptr, (bf16*)(ws + WS_WDN), FF, nb * 32, kb * 64, scr, lane); continue; } r -= I_DN;
        { const int gi = r / 64, q = r % 64, kb = q / 16, nb = q % 16; tr_item<false>(F.inp(9) + (size_t)gi * 256 * 512, 512, nb * 32, 32, nullptr, (bf16*)(ws + WS_WPOOL), 256, gi * 512 + nb * 32, kb * 64, scr, lane); }
    }
    if (part != 0) return;
    f32x4 gv[8];
#pragma unroll
    for (int j = 0; j < 8; ++j) gv[j] = ((const f32x4*)F.inp(4))[64 * j + lane];
    bf16* Hb = (bf16*)(ws + WS_H);
    for (int m = gw; m < M; m += NGW) {
        const float* xrow = (m < NP) ? F.inp(0) + (size_t)m * DM : F.inp(1) + (size_t)(m - NP) * DM;
        const f32x4* xr = (const f32x4*)xrow + lane; f32x4 v[8]; float s = 0.f;
#pragma unroll
        for (int j = 0; j < 8; ++j) { v[j] = xr[64 * j]; s += (v[j][0] * v[j][0] + v[j][1] * v[j][1]) + (v[j][2] * v[j][2] + v[j][3] * v[j][3]); }
        const float rs = __builtin_amdgcn_rsqf(wave_sum(s) * (1.f / DM) + EPS);
        v2u* o8 = (v2u*)(Hb + (size_t)m * DM) + lane;
#pragma unroll
        for (int j = 0; j < 8; ++j) { const f32x4 y = v[j] * rs * gv[j]; v2u w; w.x = cvt_pk_bf16(y[0], y[1]); w.y = cvt_pk_bf16(y[2], y[3]); o8[64 * j] = w; }
    }
}

constexpr int QP = 264;
constexpr int VP = 520;
__device__ __forceinline__ void gla_prep_item(Frame& F, int item) {
    const int c = item >> 2, h = item & 3, tid = F.tid, lane = F.lane, wid = F.wave;
    const bool smp = c >= NCH_P; const int r0 = c * 64;
    unsigned char* ws = F.ws;
    LAS bf16* Qs = (LAS bf16*)F.lds; LAS bf16* Ks = Qs + 64 * QP; LAS float* ALRs = (LAS float*)(F.lds + 67584); LAS float* TOT = (LAS float*)(F.lds + 71680); LAS bf16* Vs = (LAS bf16*)(F.lds + 72704);
    const bf16* Qg = (const bf16*)(ws + WS_Q); const bf16* Kg = (const bf16*)(ws + WS_K); const bf16* Vg = (const bf16*)(ws + WS_V);
    const int d = tid & 255, half = tid >> 8;
    typedef const __attribute__((address_space(1))) float* gfp;
    const gfp wp = (gfp)F.inp(6), bp = (gfp)F.inp(7);
    float wup[16];
#pragma unroll
    for (int j = 0; j < 16; ++j) wup[j] = wp[j * 1024 + h * 256 + d];
    const float ba = bp[h * 256 + d];
    v4u xq[4], xk[4], xv[8], xa = (v4u){0u, 0u, 0u, 0u};
#pragma unroll
    for (int j = 0; j < 4; ++j) { const int p = tid + 512 * j, row = p >> 5, c16 = p & 31;
        xq[j] = *(const v4u*)(Qg + (size_t)(r0 + row) * 1024 + h * 256 + c16 * 8); xk[j] = *(const v4u*)(Kg + (size_t)(r0 + row) * 1024 + h * 256 + c16 * 8); }
    if (tid < 256) xa = *(const v4u*)((const float*)(ws + WS_ALR) + (size_t)r0 * 16 + tid * 4);
    if (!smp) {
#pragma unroll
        for (int j = 0; j < 8; ++j) { const int p = tid + 512 * j, row = p >> 6, c16 = p & 63; xv[j] = *(const v4u*)(Vg + (size_t)(r0 + row) * 2048 + h * 512 + c16 * 8); } }
    asm volatile("" ::: "memory");
#pragma unroll
    for (int j = 0; j < 4; ++j) { const int p = tid + 512 * j, row = p >> 5, c16 = p & 31;
        *(LAS v4u*)(Qs + row * QP + c16 * 8) = xq[j]; *(LAS v4u*)(Ks + row * QP + c16 * 8) = xk[j]; }
    if (tid < 256) *(LAS v4u*)(ALRs + tid * 4) = xa;
    if (!smp) {
#pragma unroll
        for (int j = 0; j < 8; ++j) { const int p = tid + 512 * j, row = p >> 6, c16 = p & 63; *(LAS v4u*)(Vs + row * VP + c16 * 8) = xv[j]; } }
    __syncthreads();
    float bl[32]; float run = 0.f;
#pragma unroll
    for (int i = 0; i < 32; ++i) { const int t = 32 * half + i; float a = ba;
#pragma unroll
        for (int j4 = 0; j4 < 4; ++j4) { const f32x4 al = *(const LAS f32x4*)(ALRs + t * 16 + 4 * j4); a += al[0] * wup[4 * j4] + al[1] * wup[4 * j4 + 1] + al[2] * wup[4 * j4 + 2] + al[3] * wup[4 * j4 + 3]; }
        const float la = (fminf(a, 0.f) - __logf(1.f + __expf(-fabsf(a)))) * 0.0625f;
        if (smp && (i & 7) == 0) run = 0.f;
        run += la; bl[i] = run; }
    if (half == 0) TOT[d] = run;
    __syncthreads();
    if (!smp && half == 1) { const float off = TOT[d];
#pragma unroll
        for (int i = 0; i < 32; ++i) bl[i] += off; }
    unsigned kk[16];
#pragma unroll
    for (int i = 0; i < 32; i += 2) {
        const int t = 32 * half + i;
        const float e0 = __expf(bl[i]), e1 = __expf(bl[i + 1]), n0 = __expf(-bl[i]), n1 = __expf(-bl[i + 1]);
        const float q0 = bf2f(Qs[t * QP + d]) * e0, q1 = bf2f(Qs[(t + 1) * QP + d]) * e1;
        const float k0 = bf2f(Ks[t * QP + d]) * n0, k1 = bf2f(Ks[(t + 1) * QP + d]) * n1;
        const unsigned qp = cvt_pk_bf16(q0, q1), kp = cvt_pk_bf16(k0, k1);
        Qs[t * QP + d] = (bf16)(qp & 0xffffu); Qs[(t + 1) * QP + d] = (bf16)(qp >> 16);
        Ks[t * QP + d] = (bf16)(kp & 0xffffu); Ks[(t + 1) * QP + d] = (bf16)(kp >> 16);
        kk[i >> 1] = kp; }
    { bf16* ktt = (bf16*)(ws + WS_KTT) + ((size_t)(c * 4 + h) * 256 + d) * 64 + 32 * half;
#pragma unroll
        for (int j = 0; j < 4; ++j) *(v4u*)(ktt + 8 * j) = (v4u){kk[4 * j], kk[4 * j + 1], kk[4 * j + 2], kk[4 * j + 3]}; }
    if (!smp) { if (half == 1) ((float*)(ws + WS_EBP))[(size_t)c * 1024 + h * 256 + d] = __expf(bl[31]); }
    else {
#pragma unroll
        for (int j = 0; j < 4; ++j) ((float*)(ws + WS_EBS))[(size_t)((c - NCH_P) * 8 + 4 * half + j) * 1024 + h * 256 + d] = __expf(bl[8 * j + 7]); }
    __syncthreads();
    { bf16* QTg = (bf16*)(ws + WS_QT);
#pragma unroll
        for (int j = 0; j < 4; ++j) { const int p = tid + 512 * j, row = p >> 5, c16 = p & 31;
            *(v4u*)(QTg + (size_t)(r0 + row) * 1024 + h * 256 + c16 * 8) = *(const LAS v4u*)(Qs + row * QP + c16 * 8); } }
    { const int g = lane >> 4, cc = lane & 15, mt = wid >> 1, nt0 = 2 * (wid & 1);
        f32x4 pa[2] = {(f32x4){0.f, 0.f, 0.f, 0.f}, (f32x4){0.f, 0.f, 0.f, 0.f}};
#pragma unroll
        for (int ks = 0; ks < 8; ++ks) { const bf16x8 a = *(const LAS bf16x8*)(Qs + (16 * mt + cc) * QP + 32 * ks + 8 * g);
#pragma unroll
            for (int n = 0; n < 2; ++n) { const bf16x8 b = *(const LAS bf16x8*)(Ks + (16 * (nt0 + n) + cc) * QP + 32 * ks + 8 * g);
                pa[n] = __builtin_amdgcn_mfma_f32_16x16x32_bf16(a, b, pa[n], 0, 0, 0); } }
        bf16* PSg = (bf16*)(ws + WS_PS) + (size_t)(c * 4 + h) * 4096;
#pragma unroll
        for (int n = 0; n < 2; ++n)
#pragma unroll
            for (int r = 0; r < 4; ++r) { const int t = 16 * mt + 4 * g + r, s = 16 * (nt0 + n) + cc; const bool ok = (s <= t) && (!smp || ((s >> 3) == (t >> 3)));
                PSg[t * 64 + s] = (bf16)f2bf(ok ? pa[n][r] : 0.f); } }
    if (!smp) { unsigned vv[32];
#pragma unroll
        for (int s = 0; s < 64; s += 2) vv[s >> 1] = (unsigned)Vs[s * VP + tid] | ((unsigned)Vs[(s + 1) * VP + tid] << 16);
        bf16* vt = (bf16*)(ws + WS_VT) + ((size_t)(c * 4 + h) * 512 + tid) * 64;
#pragma unroll
        for (int j = 0; j < 8; ++j) *(v4u*)(vt + 8 * j) = (v4u){vv[4 * j], vv[4 * j + 1], vv[4 * j + 2], vv[4 * j + 3]}; }
    __syncthreads();
}
__device__ __forceinline__ void pool_prep(Frame& F, const int bi, const int nb) {
    unsigned char* ws = F.ws; const bf16* U = (const bf16*)(ws + WS_U); bf16* PB = (bf16*)(ws + WS_PB); const float* sp = F.inp(3);
    const bool fast = (nb == 192);
    if (fast && bi < 128) {
        const int W = bi * 8 + F.wave, q = W & 3, w = 2 << q, lane = F.lane;
        const int seg = 2 * (W >> 2) + (lane >> 5), ch = (32 * q + (lane & 31)) * 8, row0 = seg * 16, t0 = row0 & (SEQ - 1);
        const bf16* up = U + (size_t)row0 * 1024 + ch; bf16* pp = PB + (size_t)row0 * 1024 + ch;
        float acc[8] = {0.f, 0.f, 0.f, 0.f, 0.f, 0.f, 0.f, 0.f};
#define PL_ACC(vv_, sg) do { const v4u t4_ = (vv_); const unsigned xs_[4] = {t4_.x, t4_.y, t4_.z, t4_.w}; _Pragma("unroll") for (int j = 0; j < 4; ++j) { acc[2 * j] += (sg) * bf2f(xs_[j] & 0xffffu); acc[2 * j + 1] += (sg) * bf2f(xs_[j] >> 16); } } while (0)
        for (int i0 = 1; i0 < w; i0 += 4) { v4u x[4];
#pragma unroll
            for (int k = 0; k < 4; ++k) { const int i = i0 + k; x[k] = *(const v4u*)(up - (size_t)((i < w && t0 - i >= 0) ? i : 0) * 1024); }
#pragma unroll
            for (int k = 0; k < 4; ++k) { const int i = i0 + k; PL_ACC(x[k], (i < w && t0 - i >= 0) ? 1.f : 0.f); } }
#pragma unroll 1
        for (int r0 = 0; r0 < 16; r0 += 4) { v4u xn[4], xl[4];
#pragma unroll
            for (int k = 0; k < 4; ++k) { const int r = r0 + k; xn[k] = *(const v4u*)(up + (size_t)r * 1024); xl[k] = *(const v4u*)(up + (size_t)((r > 0 && t0 + r - w >= 0) ? r - w : r) * 1024); }
#pragma unroll
            for (int k = 0; k < 4; ++k) { const int r = r0 + k, t = t0 + r; PL_ACC(xn[k], 1.f); PL_ACC(xl[k], (r > 0 && t - w >= 0) ? -1.f : 0.f);
                const float ic = __builtin_amdgcn_rcpf((float)((t + 1 < w) ? t + 1 : w)); const unsigned xs[4] = {xn[k].x, xn[k].y, xn[k].z, xn[k].w}; v4u o;
                o.x = cvt_pk_bf16(acc[0] * ic - bf2f(xs[0] & 0xffffu), acc[1] * ic - bf2f(xs[0] >> 16)); o.y = cvt_pk_bf16(acc[2] * ic - bf2f(xs[1] & 0xffffu), acc[3] * ic - bf2f(xs[1] >> 16));
                o.z = cvt_pk_bf16(acc[4] * ic - bf2f(xs[2] & 0xffffu), acc[5] * ic - bf2f(xs[2] >> 16)); o.w = cvt_pk_bf16(acc[6] * ic - bf2f(xs[3] & 0xffffu), acc[7] * ic - bf2f(xs[3] >> 16));
                *(v4u*)(pp + (size_t)r * 1024) = o; } }
    }
    if (fast && bi >= 128) {
        if (F.wave < 4) { const int pair = (F.wave * 64 + (bi - 128)) * 64 + F.lane, sb = pair >> 7, cg = pair & 127, ch = cg * 8, w = 2 << (cg >> 5);
            const bf16* up = U + (size_t)(NP + sb * 8) * 1024 + ch; bf16* pp = PB + (size_t)(NP + sb * 8) * 1024 + ch; const float* hist = sp + (size_t)(sb * 15 + 15) * 1024 + ch;
            float acc[8] = {0.f, 0.f, 0.f, 0.f, 0.f, 0.f, 0.f, 0.f};
            for (int i = 1; i < w; ++i) { const float* q = hist - (ptrdiff_t)i * 1024; const f32x4 a = *(const f32x4*)q, bb = *(const f32x4*)(q + 4);
#pragma unroll
                for (int j = 0; j < 4; ++j) { acc[j] += a[j]; acc[4 + j] += bb[j]; } }
            const float ic = __builtin_amdgcn_rcpf((float)w);
#pragma unroll
            for (int t = 0; t < 8; ++t) { const v4u x = *(const v4u*)(up + (size_t)t * 1024); PL_ACC(x, 1.f);
                if (t > 0) { if (t - w >= 0) { const v4u y = *(const v4u*)(up + (size_t)(t - w) * 1024); PL_ACC(y, -1.f); }
                    else { const float* q = hist + (ptrdiff_t)(t - w) * 1024; const f32x4 a = *(const f32x4*)q, bb = *(const f32x4*)(q + 4);
#pragma unroll
                        for (int j = 0; j < 4; ++j) { acc[j] -= a[j]; acc[4 + j] -= bb[j]; } } }
                const unsigned xs[4] = {x.x, x.y, x.z, x.w}; v4u o;
                o.x = cvt_pk_bf16(acc[0] * ic - bf2f(xs[0] & 0xffffu), acc[1] * ic - bf2f(xs[0] >> 16)); o.y = cvt_pk_bf16(acc[2] * ic - bf2f(xs[1] & 0xffffu), acc[3] * ic - bf2f(xs[1] >> 16));
                o.z = cvt_pk_bf16(acc[4] * ic - bf2f(xs[2] & 0xffffu), acc[5] * ic - bf2f(xs[2] >> 16)); o.w = cvt_pk_bf16(acc[6] * ic - bf2f(xs[3] & 0xffffu), acc[7] * ic - bf2f(xs[3] >> 16));
                *(v4u*)(pp + (size_t)t * 1024) = o; } }
    }
#undef PL_ACC
    const int sh0 = fast ? (bi < 128 ? bi : 128 + 3 * (bi - 128)) : bi, nsh = fast ? (bi < 128 ? 1 : 3) : 1, NT = (fast ? 320 : nb) * 512;
    if (!fast)
    for (int sh = sh0; sh < sh0 + nsh; ++sh)
    for (int idx = sh * 512 + F.tid; idx < M * 128; idx += NT) {
        const int row = idx >> 7, cg = idx & 127, ch = cg * 8, w = 2 << (cg >> 5);
        int t, nvalid; const float* hist = sp; float cnt;
        if (row < NP) { t = row & (SEQ - 1); nvalid = (t + 1 < w) ? t + 1 : w; cnt = (float)nvalid; }
        else { const int rs = row - NP; t = rs & 7; nvalid = (t + 1 < w) ? t + 1 : w; cnt = (float)w; hist = sp + (size_t)((rs >> 3) * 15 + 15) * 1024 + ch; }
        v4u xu[16];
#pragma unroll
        for (int i = 0; i < 16; ++i) xu[i] = *(const v4u*)(U + (size_t)(row - (i < nvalid ? i : 0)) * 1024 + ch);
        float acc[8] = {0.f, 0.f, 0.f, 0.f, 0.f, 0.f, 0.f, 0.f};
        if (row >= NP && nvalid < w) {
            for (int i = nvalid; i < w; ++i) { const float* q = hist + (ptrdiff_t)(t - i) * 1024; const f32x4 a = *(const f32x4*)q, bb = *(const f32x4*)(q + 4);
#pragma unroll
                for (int j = 0; j < 4; ++j) { acc[j] += a[j]; acc[4 + j] += bb[j]; } } }
        float u0[8];
#pragma unroll
        for (int i = 0; i < 16; ++i) { const float mk = (i < nvalid) ? 1.f : 0.f; const unsigned xs[4] = {xu[i].x, xu[i].y, xu[i].z, xu[i].w};
#pragma unroll
            for (int j = 0; j < 4; ++j) { const float a = bf2f(xs[j] & 0xffffu), b = bf2f(xs[j] >> 16); acc[2 * j] += a * mk; acc[2 * j + 1] += b * mk; if (i == 0) { u0[2 * j] = a; u0[2 * j + 1] = b; } } }
        const float ic = __builtin_amdgcn_rcpf(cnt); v4u o;
        o.x = cvt_pk_bf16(acc[0] * ic - u0[0], acc[1] * ic - u0[1]); o.y = cvt_pk_bf16(acc[2] * ic - u0[2], acc[3] * ic - u0[3]);
        o.z = cvt_pk_bf16(acc[4] * ic - u0[4], acc[5] * ic - u0[5]); o.w = cvt_pk_bf16(acc[6] * ic - u0[6], acc[7] * ic - u0[7]);
        *(v4u*)(PB + (size_t)row * 1024 + ch) = o;
    }
    float* out = F.out;
    for (int sh = sh0; sh < sh0 + nsh; ++sh)
    for (int idx = sh * 512 + F.tid; idx < (4 + 128) * 15 * 128; idx += NT) {
        const int cg = idx & 127, rj = idx >> 7, ch = cg * 8; f32x4 a, b; float* dst;
        if (rj < 60) { const int bb = rj / 15, j = rj % 15; const v4u x = *(const v4u*)(U + (size_t)(bb * SEQ + SEQ - 15 + j) * 1024 + ch);
            a = (f32x4){bf2f(x.x & 0xffffu), bf2f(x.x >> 16), bf2f(x.y & 0xffffu), bf2f(x.y >> 16)}; b = (f32x4){bf2f(x.z & 0xffffu), bf2f(x.z >> 16), bf2f(x.w & 0xffffu), bf2f(x.w >> 16)};
            dst = out + OUT_BUFP + (size_t)rj * 1024 + ch; }
        else { const int r2 = rj - 60, bb = r2 / 15, j = r2 % 15;
            if (j < 7) { const float* q = sp + (size_t)(bb * 15 + j + 8) * 1024 + ch; a = *(const f32x4*)q; b = *(const f32x4*)(q + 4); }
            else { const v4u x = *(const v4u*)(U + (size_t)(NP + bb * 8 + j - 7) * 1024 + ch);
                a = (f32x4){bf2f(x.x & 0xffffu), bf2f(x.x >> 16), bf2f(x.y & 0xffffu), bf2f(x.y >> 16)}; b = (f32x4){bf2f(x.z & 0xffffu), bf2f(x.z >> 16), bf2f(x.w & 0xffffu), bf2f(x.w >> 16)}; }
            dst = out + OUT_BUFS + (size_t)r2 * 1024 + ch; }
        *(f32x4*)dst = a; *(f32x4*)(dst + 4) = b;
    }
}

constexpr int KP = 72;
__device__ __forceinline__ void gla_chain(Frame& F, int cb, float* SSQ, const int pvar) {
    int tid_ = F.tid; asm volatile("" : "+v"(tid_));
    const int b = (cb & 15) >> 2, h = cb & 3, vs = cb >> 4, tid = tid_, lane = tid_ & 63, wid = F.wave;
    const int g = lane >> 4, c = lane & 15, dh = wid >> 2, vg = wid & 3, dbase = dh * 128;
    unsigned char* ws = F.ws;
    LAS bf16* Qs = (LAS bf16*)F.lds; LAS bf16* Kt = (LAS bf16*)(F.lds + 33792); LAS bf16* Ps = (LAS bf16*)(F.lds + 70656); LAS bf16* Vt = (LAS bf16*)(F.lds + 79872);
    LAS float* EB = (LAS float*)(F.lds + 98304); LAS float* Ored = (LAS float*)(F.lds + 99328);
    const bf16* QTg = (const bf16*)(ws + WS_QT); const bf16* KTTg = (const bf16*)(ws + WS_KTT); const bf16* PSg = (const bf16*)(ws + WS_PS); const bf16* VTg = (const bf16*)(ws + WS_VT);
    const float* EBg = (const float*)(ws + WS_EBP); bf16* OG = (bf16*)(ws + WS_OG);
    f32x4 S[8][2];
#pragma unroll
    for (int i = 0; i < 8; ++i) { S[i][0] = (f32x4){0.f, 0.f, 0.f, 0.f}; S[i][1] = (f32x4){0.f, 0.f, 0.f, 0.f}; }
    v4u pq[4], pk[4], pp, pv[2]; float pe = 0.f;
    const unsigned t16 = (unsigned)tid * 16u, qoff = (unsigned)(tid >> 5) * 2048u + (unsigned)(tid & 31) * 16u;
    const unsigned lq = (unsigned)(tid >> 5) * (QP * 2) + (unsigned)(tid & 31) * 16u, lk = (unsigned)(tid >> 3) * (KP * 2) + (unsigned)(tid & 7) * 16u;
#define CH_LOAD_A(n) do { const int ci_ = b * 32 + (n); const char* qb_ = (const char*)QTg + ((size_t)ci_ * 65536 + h * 256) * 2; const char* pb_ = (const char*)PSg + (size_t)(ci_ * 4 + h) * 8192; \
        _Pragma("unroll") for (int j = 0; j < 4; ++j) pq[j] = *(const v4u*)(qb_ + j * 32768 + qoff); \
        pp = *(const v4u*)(pb_ + t16); } while (0)
#define CH_LOAD_B(n) do { const int ci_ = b * 32 + (n); const char* kb_ = (const char*)KTTg + (size_t)(ci_ * 4 + h) * 32768; const char* vb_ = (const char*)VTg + ((size_t)(ci_ * 4 + h) * 512 + vs * 128) * 128; \
        _Pragma("unroll") for (int j = 0; j < 4; ++j) pk[j] = *(const v4u*)(kb_ + j * 8192 + t16); \
        _Pragma("unroll") for (int j = 0; j < 2; ++j) pv[j] = *(const v4u*)(vb_ + j * 8192 + t16); \
        if (tid < 256) pe = *(const float*)((const char*)(EBg + (size_t)ci_ * 1024 + h * 256) + (unsigned)tid * 4u); } while (0)
#define CH_LDG(n, grp) do { const int ci_ = b * 32 + (n); const char* qb_ = (const char*)QTg + ((size_t)ci_ * 65536 + h * 256) * 2; const char* pb_ = (const char*)PSg + (size_t)(ci_ * 4 + h) * 8192; \
        const char* kb_ = (const char*)KTTg + (size_t)(ci_ * 4 + h) * 32768; const char* vb_ = (const char*)VTg + ((size_t)(ci_ * 4 + h) * 512 + vs * 128) * 128; \
        if ((grp) == 0) { pq[0] = *(const v4u*)(qb_ + qoff); pq[1] = *(const v4u*)(qb_ + 32768 + qoff); pk[0] = *(const v4u*)(kb_ + t16); } \
        if ((grp) == 1) { pq[2] = *(const v4u*)(qb_ + 2 * 32768 + qoff); pq[3] = *(const v4u*)(qb_ + 3 * 32768 + qoff); pk[1] = *(const v4u*)(kb_ + 8192 + t16); } \
        if ((grp) == 2) { pk[2] = *(const v4u*)(kb_ + 2 * 8192 + t16); pk[3] = *(const v4u*)(kb_ + 3 * 8192 + t16); pp = *(const v4u*)(pb_ + t16); } \
        if ((grp) == 3) { pv[0] = *(const v4u*)(vb_ + t16); pv[1] = *(const v4u*)(vb_ + 8192 + t16); if (tid < 256) pe = *(const float*)((const char*)(EBg + (size_t)ci_ * 1024 + h * 256) + (unsigned)tid * 4u); } \
        asm volatile("" ::: "memory"); } while (0)
#define CH_STORE() do { \
        _Pragma("unroll") for (int j = 0; j < 4; ++j) { *(LAS v4u*)((LAS char*)Qs + j * (16 * QP * 2) + lq) = pq[j]; *(LAS v4u*)((LAS char*)Kt + j * (64 * KP * 2) + lk) = pk[j]; } \
        *(LAS v4u*)((LAS char*)Ps + lk) = pp; \
        _Pragma("unroll") for (int j = 0; j < 2; ++j) *(LAS v4u*)((LAS char*)Vt + j * (64 * KP * 2) + lk) = pv[j]; \
        if (tid < 256) EB[tid] = pe; } while (0)
#define CH_STORE_Q() do { _Pragma("unroll") for (int j = 0; j < 4; ++j) *(LAS v4u*)((LAS char*)Qs + j * (16 * QP * 2) + lq) = pq[j]; } while (0)
#define CH_STORE_QP() do { *(LAS v4u*)((LAS char*)Ps + lk) = pp; } while (0)
#define CH_STORE_KV() do { \
        _Pragma("unroll") for (int j = 0; j < 4; ++j) *(LAS v4u*)((LAS char*)Kt + j * (64 * KP * 2) + lk) = pk[j]; \
        _Pragma("unroll") for (int j = 0; j < 2; ++j) *(LAS v4u*)((LAS char*)Vt + j * (64 * KP * 2) + lk) = pv[j]; \
        if (tid < 256) EB[tid] = pe; } while (0)
    CH_LOAD_A(0); CH_LOAD_B(0); CH_STORE(); __syncthreads();
    for (int n = 0; n < 32; ++n) {
        const bool ldn = (n + 1 < 32) && !(pvar & 4);
        if (ldn) CH_LDG(n + 1, 0);
        f32x4 oT[2][4];
#pragma unroll
        for (int vt = 0; vt < 2; ++vt)
#pragma unroll
            for (int tt = 0; tt < 4; ++tt) oT[vt][tt] = (f32x4){0.f, 0.f, 0.f, 0.f};
        {
            bf16x8 qf[4], va[2], pb[4];
#define CH_QLOAD(dst, ks_) do { _Pragma("unroll") for (int tt = 0; tt < 4; ++tt) { const LAS bf16* qp = Qs + (16 * tt + c) * QP + dbase + 32 * (ks_) + 4 * g; \
                const v2u q0 = *(const LAS v2u*)qp, q1 = *(const LAS v2u*)(qp + 16); dst[tt] = __builtin_bit_cast(bf16x8, ((v4u){q0.x, q0.y, q1.x, q1.y})); } } while (0)
#pragma unroll
            for (int ks = 0; ks < 4; ++ks) {
                if (ks == 2 && ldn) CH_LDG(n + 1, 1);
                CH_QLOAD(qf, ks);
                if (ks == 3) {
#pragma unroll
                    for (int vt = 0; vt < 2; ++vt) va[vt] = *(const LAS bf16x8*)(Vt + (32 * vg + 16 * vt + c) * KP + 32 * dh + 8 * g);
#pragma unroll
                    for (int tt = 0; tt < 4; ++tt) pb[tt] = *(const LAS bf16x8*)(Ps + (16 * tt + c) * KP + 32 * dh + 8 * g); }
                bf16x8 sa[2];
#pragma unroll
                for (int vt = 0; vt < 2; ++vt) { const f32x4 lo = S[2 * ks][vt], hi = S[2 * ks + 1][vt];
                    v4u w; w.x = cvt_pk_bf16(lo[0], lo[1]); w.y = cvt_pk_bf16(lo[2], lo[3]); w.z = cvt_pk_bf16(hi[0], hi[1]); w.w = cvt_pk_bf16(hi[2], hi[3]); sa[vt] = __builtin_bit_cast(bf16x8, w); }
#pragma unroll
                for (int tt = 0; tt < 4; ++tt)
#pragma unroll
                    for (int vt = 0; vt < 2; ++vt) oT[vt][tt] = __builtin_amdgcn_mfma_f32_16x16x32_bf16(sa[vt], qf[tt], oT[vt][tt], 0, 0, 0);
            }
#undef CH_QLOAD
#pragma unroll
            for (int tt = 0; tt < 4; ++tt)
#pragma unroll
                for (int vt = 0; vt < 2; ++vt) oT[vt][tt] = __builtin_amdgcn_mfma_f32_16x16x32_bf16(va[vt], pb[tt], oT[vt][tt], 0, 0, 0);
        }
        if (ldn) CH_LDG(n + 1, 2);
        {
#pragma unroll
            for (int vt = 0; vt < 2; ++vt)
#pragma unroll
                for (int t2 = 0; t2 < 2; ++t2) { const int tt = 2 * (1 - dh) + t2;
#pragma unroll
                    for (int r = 0; r < 4; ++r) Ored[((dh * 4 + vg) * 16 + (vt * 2 + t2) * 4 + r) * 64 + lane] = (dh == 0) ? oT[vt][2 + t2][r] : oT[vt][t2][r]; } }
        __syncthreads();
        if (ldn) CH_LDG(n + 1, 3);
        if (n + 1 < 32 && !(pvar & 4)) { CH_STORE_Q(); }
        {
            bf16x8 vb[2][2], ka[4];
#define CH_KLOAD(dst, ks_, mg_) do { _Pragma("unroll") for (int q = 0; q < 4; ++q) dst[q] = *(const LAS bf16x8*)(Kt + (dbase + 16 * (4 * (mg_) + q) + c) * KP + 32 * (ks_) + 8 * g); } while (0)
#pragma unroll
            for (int ks = 0; ks < 2; ++ks)
#pragma unroll
                for (int vt = 0; vt < 2; ++vt) vb[ks][vt] = *(const LAS bf16x8*)(Vt + (32 * vg + 16 * vt + c) * KP + 32 * ks + 8 * g);
#pragma unroll
            for (int st = 0; st < 4; ++st) { const int ks = st >> 1, mg = st & 1;
                CH_KLOAD(ka, ks, mg);
#pragma unroll
                for (int q = 0; q < 4; ++q)
#pragma unroll
                    for (int vt = 0; vt < 2; ++vt) S[4 * mg + q][vt] = __builtin_amdgcn_mfma_f32_16x16x32_bf16(ka[q], vb[ks][vt], S[4 * mg + q][vt], 0, 0, 0); }
#undef CH_KLOAD
        }
#pragma unroll
        for (int md = 0; md < 8; ++md) { const f32x4 e = *(const LAS f32x4*)(EB + dbase + 16 * md + 4 * g); S[md][0] *= e; S[md][1] *= e; }
        if (n + 1 < 32 && !(pvar & 4)) { CH_STORE_QP(); }
        {
            const int rowb = b * SEQ + n * 64;
            char* ogb = (char*)OG + ((size_t)rowb * 2048 + h * 512 + vs * 128 + 32 * vg) * 2; char* sqb = (char*)(SSQ + (size_t)rowb * 4 + h);
            const unsigned ogl = (unsigned)c * 4096u + (unsigned)g * 8u, sql = (unsigned)c * 16u;
            float ssv[2];
#pragma unroll
            for (int t2 = 0; t2 < 2; ++t2) { float ss = 0.f; const int tt = 2 * dh + t2;
#pragma unroll
                for (int vt = 0; vt < 2; ++vt) { f32x4 o = (dh == 0) ? oT[vt][t2] : oT[vt][2 + t2];
#pragma unroll
                    for (int r = 0; r < 4; ++r) { o[r] += Ored[(((1 - dh) * 4 + vg) * 16 + (vt * 2 + t2) * 4 + r) * 64 + lane]; ss += o[r] * o[r]; }
                    v2u w; w.x = cvt_pk_bf16(o[0], o[1]); w.y = cvt_pk_bf16(o[2], o[3]);
                    *(v2u*)(ogb + tt * 65536 + vt * 32 + ogl) = w; }
                ss += __shfl_xor(ss, 16); ss += __shfl_xor(ss, 32); ssv[t2] = ss; }
            if (g < 2) atomicAdd((float*)(sqb + (2 * dh + g) * 256 + sql), g == 0 ? ssv[0] : ssv[1]); }
        __syncthreads();
        if (n + 1 < 32 && !(pvar & 4)) { CH_STORE_KV(); }
        __syncthreads();
    }
#undef CH_LOAD_A
#undef CH_LOAD_B
#undef CH_STORE
#undef CH_STORE_QP
#undef CH_STORE_Q
#undef CH_STORE_KV
    float* sg = F.out + OUT_SGP + (size_t)(b * 4 + h) * 256 * 512;
#pragma unroll
    for (int md = 0; md < 8; ++md)
#pragma unroll
        for (int vt = 0; vt < 2; ++vt)
#pragma unroll
            for (int r = 0; r < 4; ++r) sg[(size_t)(dbase + 16 * md + 4 * g + r) * 512 + vs * 128 + 32 * vg + 16 * vt + c] = S[md][vt][r];
}
__device__ __forceinline__ void gla_sample_unit(Frame& F, int u, float* SSQ) {
    const int b = u >> 3, h = (u >> 1) & 3, vh = u & 1, tid = F.tid, lane = F.lane, wid = F.wave;
    unsigned char* ws = F.ws;
    const int row0 = NP + b * 8, cs = NCH_P + (b >> 3), si = (b & 7) * 8;
    const float* Sin = F.inp(2) + (size_t)(b * 4 + h) * 256 * 512 + vh * 256 + 4 * lane;
    float* Sout = F.out + OUT_SGS + (size_t)(b * 4 + h) * 256 * 512 + vh * 256 + 4 * lane;
    f32x4 sva[4], svb[4], svc[4];
#define SMP_LOAD(dst, r_) do { _Pragma("unroll") for (int j = 0; j < 4; ++j) dst[j] = __builtin_nontemporal_load((const f32x4*)(Sin + (size_t)(wid + 8 * ((r_) + j)) * 512)); } while (0)
    SMP_LOAD(sva, 0); SMP_LOAD(svb, 4); SMP_LOAD(svc, 8);
    LAS float* QK = (LAS float*)F.lds; LAS float* EBs = (LAS float*)(F.lds + 16384); LAS float* Ored = (LAS float*)(F.lds + 17408);
    { const int d = tid & 255;
        if (tid < 256) { const bf16* qt = (const bf16*)(ws + WS_QT) + (size_t)row0 * 1024 + h * 256 + d; f32x4 a, bq;
#pragma unroll
            for (int t = 0; t < 4; ++t) { a[t] = bf2f(qt[(size_t)t * 1024]); bq[t] = bf2f(qt[(size_t)(t + 4) * 1024]); }
            *(LAS f32x4*)(QK + d * 16) = a; *(LAS f32x4*)(QK + d * 16 + 4) = bq;
            EBs[d] = ((const float*)(ws + WS_EBS))[(size_t)b * 1024 + h * 256 + d]; }
        else { const v4u x = *(const v4u*)((const bf16*)(ws + WS_KTT) + ((size_t)(cs * 4 + h) * 256 + d) * 64 + si);
            *(LAS f32x4*)(QK + d * 16 + 8) = (f32x4){bf2f(x.x & 0xffffu), bf2f(x.x >> 16), bf2f(x.y & 0xffffu), bf2f(x.y >> 16)};
            *(LAS f32x4*)(QK + d * 16 + 12) = (f32x4){bf2f(x.z & 0xffffu), bf2f(x.z >> 16), bf2f(x.w & 0xffffu), bf2f(x.w >> 16)}; } }
    f32x4 v[8], o[8];
    { const bf16* Vg = (const bf16*)(ws + WS_V) + (size_t)row0 * 2048 + h * 512 + vh * 256 + 4 * lane;
#pragma unroll
        for (int s = 0; s < 8; ++s) { const v2u x = *(const v2u*)(Vg + (size_t)s * 2048); v[s] = (f32x4){bf2f(x.x & 0xffffu), bf2f(x.x >> 16), bf2f(x.y & 0xffffu), bf2f(x.y >> 16)}; o[s] = (f32x4){0.f, 0.f, 0.f, 0.f}; } }
    __syncthreads();
#define SMP_COMP(src, r_) do { _Pragma("unroll") for (int j = 0; j < 4; ++j) { const int d = wid + 8 * ((r_) + j); \
            const f32x4 q0 = *(const LAS f32x4*)(QK + d * 16), q1 = *(const LAS f32x4*)(QK + d * 16 + 4), k0 = *(const LAS f32x4*)(QK + d * 16 + 8), k1 = *(const LAS f32x4*)(QK + d * 16 + 12); \
            const float e = EBs[d]; f32x4 sn = src[j]; \
            _Pragma("unroll") for (int s = 0; s < 4; ++s) { sn += v[s] * k0[s]; o[s] += src[j] * q0[s]; } \
            _Pragma("unroll") for (int s = 0; s < 4; ++s) { sn += v[s + 4] * k1[s]; o[s + 4] += src[j] * q1[s]; } \
            __builtin_nontemporal_store(sn * e, (f32x4*)(Sout + (size_t)d * 512)); } } while (0)
    SMP_COMP(sva, 0); SMP_LOAD(sva, 12);
    SMP_COMP(svb, 4); SMP_LOAD(svb, 16);
    SMP_COMP(svc, 8); SMP_LOAD(svc, 20);
    SMP_COMP(sva, 12); SMP_LOAD(sva, 24);
    SMP_COMP(svb, 16); SMP_LOAD(svb, 28);
    SMP_COMP(svc, 20);
    SMP_COMP(sva, 24);
    SMP_COMP(svb, 28);
#undef SMP_LOAD
#undef SMP_COMP
#pragma unroll
    for (int t = 0; t < 8; ++t) *(LAS f32x4*)(Ored + (wid * 8 + t) * 256 + 4 * lane) = o[t];
    __syncthreads();
    { const int t = wid; f32x4 ot = (f32x4){0.f, 0.f, 0.f, 0.f};
#pragma unroll
        for (int w = 0; w < 8; ++w) ot += *(const LAS f32x4*)(Ored + (w * 8 + t) * 256 + 4 * lane);
        const v4u px = *(const v4u*)((const bf16*)(ws + WS_PS) + ((size_t)(cs * 4 + h) * 64 + si + t) * 64 + si);
        const float pr[8] = {bf2f(px.x & 0xffffu), bf2f(px.x >> 16), bf2f(px.y & 0xffffu), bf2f(px.y >> 16), bf2f(px.z & 0xffffu), bf2f(px.z >> 16), bf2f(px.w & 0xffffu), bf2f(px.w >> 16)};
#pragma unroll
        for (int s = 0; s < 8; ++s) ot += v[s] * pr[s];
        v2u w2; w2.x = cvt_pk_bf16(ot[0], ot[1]); w2.y = cvt_pk_bf16(ot[2], ot[3]);
        *(v2u*)((bf16*)(ws + WS_OG) + (size_t)(row0 + t) * 2048 + h * 512 + vh * 256 + 4 * lane) = w2;
        const float ss = wave_sum((ot[0] * ot[0] + ot[1] * ot[1]) + (ot[2] * ot[2] + ot[3] * ot[3]));
        if (lane == 0) atomicAdd(SSQ + (size_t)(row0 + t) * 4 + h, ss); }
}

__device__ __forceinline__ void final_norm(Frame& F, float* dst) {
    const int gw = F.vcu * NWAVES + F.wave, NGW = F.G * NWAVES, lane = F.lane; const float* SSQ2 = (const float*)(F.ctl + CW_SSQ2);
    f32x4 gv[8];
#pragma unroll
    for (int j = 0; j < 8; ++j) gv[j] = ((const f32x4*)F.inp(15))[64 * j + lane];
    for (int m = gw; m < M; m += NGW) { const float rs = __builtin_amdgcn_rsqf(SSQ2[m] * (1.f / DM) + EPS); const f32x4* xr = (const f32x4*)(F.out + OUT_Y + (size_t)m * DM) + lane; f32x4* xw = (f32x4*)(dst + (size_t)m * DM) + lane;
#pragma unroll
        for (int j = 0; j < 8; ++j) xw[64 * j] = xr[64 * j] * rs * gv[j]; }
}

struct Args { const float* in[16]; float* out; unsigned char* ws; int ph_lo, ph_hi; };
__global__ void __launch_bounds__(NWAVES * 64, 2) mk_fwd(Args args) {
    extern __shared__ __attribute__((aligned(16))) unsigned char lds[];
    Frame F;
    F.lds = (LAS unsigned char*)lds; F.MISC = (volatile LAS unsigned*)(F.lds + MISC_OFF);
    F.tid = threadIdx.x; F.lane = F.tid & 63; F.wave = __builtin_amdgcn_readfirstlane(F.tid >> 6);
    F.G = gridDim.x; { const int bx = blockIdx.x; F.vcu = (F.G % 8 == 0) ? (bx % 8) * (F.G / 8) + bx / 8 : bx; }
    F.out = args.out; F.ws = args.ws; F.ctl = (unsigned*)(args.ws + WS_CTL);
    for (int u = F.tid; u < (LDS_BYTES - LDSCTL_OFF) / 4; u += NWAVES * 64) ((LAS unsigned*)(F.lds + LDSCTL_OFF))[u] = 0u;
    __syncthreads();
    if (F.tid < 16) ((LAS unsigned long long*)(F.lds + PTAB_OFF))[F.tid] = (unsigned long long)args.in[F.tid];
    __syncthreads();
    const int lo = args.ph_lo, hi = args.ph_hi;
    const bool use_bar = (hi - lo) > 1;
    XcdBarrier bar; bar.bar = F.ctl + CW_BAR; bar.x = 0; bar.st = nullptr;
    if (use_bar) bar = xcd_barrier_post(F.ctl + CW_BAR, F.MISC + 8);
#define IN(k) (((PHMASK >> (k)) & 1) && lo <= (k) && (k) < hi)
#define SEAM(k) do { if (IN(k) && IN((k) + 1)) xcd_barrier(bar); } while (0)
    unsigned char* ws = args.ws;
    const int bx = (int)blockIdx.x;

#define REPS(k) (((PROBE_MASK >> (k)) & 1) ? 2 : 1)
#define LASTREP(k, r) ((r) == REPS(k) - 1)
#define REPBAR(k, r) do { if (!LASTREP(k, r) && use_bar) xcd_barrier(bar); } while (0)
    float* dummy = (float*)(ws + WS_DUMMY);
    if (IN(0)) for (int r = 0; r < REPS(0); ++r) { p0_prologue(F, 0, F.vcu * NWAVES + F.wave, F.G * NWAVES); REPBAR(0, r); } SEAM(0);
    if (IN(1)) for (int r = 0; r < REPS(1); ++r) { pg8::Gemm g{(const bf16*)(ws + WS_H), (const bf16*)(ws + WS_WIN), DM, DM, DM, 0}; pg8::StaticOrder S; S.init(M, NIN, F.G, bx);
        EpiIn E{ws}; pg8::gemm_phase(F.lds, g, S, E);
        if (LASTREP(1, r)) {
            const int nt_ = (M / 256) * (NIN / 256), full = nt_ / F.G, rem = nt_ - full * F.G;
            __syncthreads();
            if (rem == 0 || rem >= F.G) p0_prologue(F, 1, bx * NWAVES + F.wave, F.G * NWAVES);
            else if (bx >= rem) p0_prologue(F, 1, (bx - rem) * NWAVES + F.wave, (F.G - rem) * NWAVES); }
        REPBAR(1, r); } SEAM(1);
    if (IN(2)) for (int r = 0; r < REPS(2); ++r) { for (int it = bx; it < NCH * 4; it += F.G) gla_prep_item(F, it);
        { const int n3 = NCH * 4 - 2 * F.G;
          if (F.G == 256 && n3 > 0 && n3 < F.G) { if (bx >= n3) pool_prep(F, bx - n3, F.G - n3); } else pool_prep(F, bx, F.G); }
        REPBAR(2, r); } SEAM(2);
    if (IN(3))
#pragma unroll
    for (int r = 0; r < REPS(3); ++r) {
        float* SSQ = LASTREP(3, r) ? (float*)(F.ctl + CW_SSQ) : dummy;
        const int pv = LASTREP(3, r) ? 0 : PROBE_VAR;
        if (!(pv & 2)) {
        if (bx < 64) gla_chain(F, bx, SSQ, pv);
        }
        __syncthreads();
        if (!(pv & 1))
        { unsigned nxtu = 0u; if (F.tid == 0) nxtu = atomicAdd(F.ctl + CW_WORK + 64 * r, 1u);
        for (;;) { if (F.tid == 0) F.MISC[0] = nxtu; __syncthreads(); const int u = (int)F.MISC[0]; if (u >= 1024) break;
            if (F.tid == 0) nxtu = atomicAdd(F.ctl + CW_WORK + 64 * r, 1u);
            gla_sample_unit(F, u, SSQ); } }
        REPBAR(3, r);
    }
    if (IN(3) && IN(5)) xcd_barrier(bar);
    if (IN(5)) { gs::Ctx X{ws, F.inp(0), F.inp(1), F.out, F.ctl, F.inp(8), F.inp(10), F.inp(15)}; gs::gemm_stream(F.lds, X, F.G, bx); }
    if (IN(5) && IN(8) && F.G != 256) xcd_barrier(bar);
    if (IN(8) && F.G != 256) { final_norm(F, F.out + OUT_Y); }
#undef IN
#undef SEAM
#undef REPS
#undef LASTREP
#undef REPBAR
}

extern "C" void kernel_launch(void* const* d_in, const int* in_sizes, int n_in, void* d_out, int out_size, void* d_ws, size_t ws_size, hipStream_t stream) {
    static int grid = 0;
    if (grid == 0) {
        if (n_in != 16 || (size_t)out_size != OUT_END || ws_size < WS_END) { fprintf(stderr, "kernel_launch: unexpected shapes (n_in %d, out %d, ws %zu); nothing launched\n", n_in, out_size, ws_size); grid = -1; return; }
        int dev = 0, cus = 0, per_cu = 0;
        if (hipGetDevice(&dev) != hipSuccess || hipDeviceGetAttribute(&cus, hipDeviceAttributeMultiprocessorCount, dev) != hipSuccess) { grid = -1; return; }
        if (hipFuncSetAttribute((const void*)mk_fwd, hipFuncAttributeMaxDynamicSharedMemorySize, LDS_BYTES) != hipSuccess) { fprintf(stderr, "kernel_launch: hipFuncSetAttribute failed\n"); grid = -1; return; }
        if (hipOccupancyMaxActiveBlocksPerMultiprocessor(&per_cu, (const void*)mk_fwd, NWAVES * 64, LDS_BYTES) != hipSuccess || per_cu < 1) { fprintf(stderr, "kernel_launch: occupancy query says %d blocks per CU; nothing launched\n", per_cu); (void)hipGetLastError(); grid = -1; return; }
        grid = cus;
        if (grid < 72 || grid > 4096) { fprintf(stderr, "kernel_launch: unexpected CU count %d\n", cus); grid = -1; return; }
    }
    if (grid < 0) return;
    (void)hipMemsetAsync((char*)d_ws + WS_CTL, 0, CTL_ZERO_BYTES, stream);
    Args a{};
    for (int i = 0; i < 16; ++i) a.in[i] = (const float*)d_in[i];
    a.out = (float*)d_out; a.ws = (unsigned char*)d_ws;
#if MK_N_LAUNCHES == 1
    a.ph_lo = 0; a.ph_hi = NPHASES;
    hipLaunchKernelGGL(mk_fwd, dim3(grid), dim3(NWAVES * 64), LDS_BYTES, stream, a);
#else
    for (int p = 0; p < NPHASES; ++p) { a.ph_lo = p; a.ph_hi = p + 1; hipLaunchKernelGGL(mk_fwd, dim3(grid), dim3(NWAVES * 64), LDS_BYTES, stream, a); }
#endif
}
```
